# Optimizing an MI355X kernel written in HIP

```python
import math
import jax, jax.numpy as jnp
from jax import lax
import numpy as np

D_MODEL = 2048
BATCH = 1
SEQ = 8192
DEPTH = 4

CHUNK = 64
QBLOCK = 128
DA_HEADS = 8
DA_QK = 64
DA_V = 2 * DA_QK
MLA_HEADS = 8
MLA_Q_LORA = 512
MLA_KV_LORA = 256
MLA_NOPE = 128
MLA_ROPE = 64
MLA_V = 128
ROPE_BASE = 10000.0
SB_HEADS = 8
SB_DIM = 128
BRANCH_WIDTH = 1024
N_BRANCHES = 3
T5_BUCKETS = 32
T5_MAX_DIST = 128
D_FF = 4 * D_MODEL
N_MOD = 6
EPS = 1e-6
NEG_INF = -1e30

IN_SIZES = (
    DA_HEADS * 2 * DA_QK,
    DA_HEADS * 2 * DA_QK,
    DA_HEADS * DA_V,
    MLA_Q_LORA,
    MLA_KV_LORA,
    MLA_ROPE,
    SB_HEADS * SB_DIM,
    SB_HEADS * SB_DIM,
    SB_HEADS * SB_DIM,
    N_BRANCHES * D_MODEL,
)
IN_COLS = sum(IN_SIZES)

kernel_name = "hybrid_gated_diffattn_mla_stickbreak_block"


def _rms(x, g):
    xf = x.astype(jnp.float32)
    y = xf * lax.rsqrt(jnp.mean(xf * xf, axis=-1, keepdims=True) + EPS)
    return (y * g.astype(jnp.float32)).astype(x.dtype)


def _split_cols(proj):
    parts, o = [], 0
    for n in IN_SIZES:
        parts.append(proj[..., o:o + n])
        o += n
    return parts


def _sweep(block_fn, seq):
    out = lax.map(block_fn, jnp.arange(seq // QBLOCK))
    nb, b, q, h, e = out.shape
    return jnp.moveaxis(out, 0, 1).reshape(b, nb * q, h, e)


def _chunk_mask(qpos, kpos):
    return (kpos[None, :] // CHUNK) <= (qpos[:, None] // CHUNK)


def _t5_bucket(rel):
    nb = T5_BUCKETS // 2
    max_exact = nb // 2
    n = jnp.abs(rel)
    large = max_exact + (jnp.log(jnp.maximum(n, 1).astype(jnp.float32) / max_exact)
                         / math.log(T5_MAX_DIST / max_exact) * (nb - max_exact)).astype(jnp.int32)
    large = jnp.minimum(large, nb - 1)
    return jnp.where(rel > 0, nb, 0) + jnp.where(n < max_exact, n, large)


def _rope(x, pos):
    half = x.shape[-1] // 2
    inv = ROPE_BASE ** (-jnp.arange(half, dtype=jnp.float32) / half)
    ang = pos.astype(jnp.float32)[:, None] * inv[None, :]
    cos = jnp.cos(ang)[None, :, None, :]
    sin = jnp.sin(ang)[None, :, None, :]
    xf = x.astype(jnp.float32)
    x1, x2 = xf[..., :half], xf[..., half:]
    return jnp.concatenate([x1 * cos - x2 * sin, x1 * sin + x2 * cos], axis=-1).astype(x.dtype)


def _diff_attention(q, k, v, t5_bias, lam, lam_init, sub_g):
    seq = q.shape[1]
    kpos = jnp.arange(seq)
    scale = DA_QK ** -0.5
    table = t5_bias.astype(jnp.float32)

    def block(i):
        start = i * QBLOCK
        qb = lax.dynamic_slice_in_dim(q, start, QBLOCK, axis=1)
        qpos = start + jnp.arange(QBLOCK)
        logits = jnp.einsum('bqhcd,bkhcd->bhcqk', qb, k).astype(jnp.float32) * scale
        bias = table[_t5_bucket(kpos[None, :] - qpos[:, None])]
        logits = logits + jnp.transpose(bias, (2, 0, 1))[None, :, None]
        p = jax.nn.softmax(jnp.where(_chunk_mask(qpos, kpos), logits, NEG_INF), axis=-1)
        a = p[:, :, 0] - lam * p[:, :, 1]
        return jnp.einsum('bhqk,bkhe->bqhe', a.astype(v.dtype), v)

    o = _sweep(block, seq)
    return _rms(o, sub_g) * (1.0 - lam_init)


def _chunk_softmax_attention(q, k, v, scale):
    seq = q.shape[1]
    kpos = jnp.arange(seq)

    def block(i):
        start = i * QBLOCK
        qb = lax.dynamic_slice_in_dim(q, start, QBLOCK, axis=1)
        qpos = start + jnp.arange(QBLOCK)
        logits = jnp.einsum('bqhd,bkhd->bhqk', qb, k).astype(jnp.float32) * scale
        p = jax.nn.softmax(jnp.where(_chunk_mask(qpos, kpos), logits, NEG_INF), axis=-1)
        return jnp.einsum('bhqk,bkhe->bqhe', p.astype(v.dtype), v)

    return _sweep(block, seq)


def _mla(c_q, c_kv, k_pe, q_norm_g, kv_norm_g, w_q_up, w_kv_up, qk_g):
    b, s, _ = c_q.shape
    pos = jnp.arange(s)
    q = (_rms(c_q, q_norm_g) @ w_q_up).reshape(b, s, MLA_HEADS, MLA_NOPE + MLA_ROPE)
    kv = (_rms(c_kv, kv_norm_g) @ w_kv_up).reshape(b, s, MLA_HEADS, MLA_NOPE + MLA_V)
    v = kv[..., MLA_NOPE:]
    q_nope = _rms(q[..., :MLA_NOPE], qk_g[0, :MLA_NOPE])
    q_pe = _rope(_rms(q[..., MLA_NOPE:], qk_g[0, MLA_NOPE:]), pos)
    k_nope = _rms(kv[..., :MLA_NOPE], qk_g[1, :MLA_NOPE])
    k_pe = _rope(_rms(k_pe.reshape(b, s, 1, MLA_ROPE), qk_g[1, MLA_NOPE:]), pos)
    qh = jnp.concatenate([q_nope, q_pe], axis=-1)
    kh = jnp.concatenate([k_nope, jnp.broadcast_to(k_pe, (b, s, MLA_HEADS, MLA_ROPE))], axis=-1)
    return _chunk_softmax_attention(qh, kh, v, (MLA_NOPE + MLA_ROPE) ** -0.5)


def _stick_breaking(q, k, v):
    seq = q.shape[1]
    kpos = jnp.arange(seq)
    scale = SB_DIM ** -0.5

    def block(i):
        start = i * QBLOCK
        qb = lax.dynamic_slice_in_dim(q, start, QBLOCK, axis=1)
        qpos = start + jnp.arange(QBLOCK)
        z = jnp.einsum('bqhd,bkhd->bhqk', qb, k).astype(jnp.float32) * scale
        mask = kpos[None, :] < qpos[:, None]
        log_1m = jnp.where(mask, jax.nn.log_sigmoid(-z), 0.0)
        between = lax.cumsum(log_1m, axis=3, reverse=True) - log_1m
        w = jnp.where(mask, jnp.exp(jax.nn.log_sigmoid(z) + between), 0.0)
        return jnp.einsum('bhqk,bkhd->bqhd', w.astype(v.dtype), v)

    return _sweep(block, seq)


def setup_inputs(seed: int = 0) -> dict:
    key = jax.random.key(seed)
    ks = jax.random.split(key, 24)
    f32 = jnp.float32

    def nrm(k, shape, std):
        return jax.random.normal(k, shape, f32) * std

    def gain(k, shape):
        return 1.0 + 0.02 * jax.random.normal(k, shape, f32)

    return {
        "x": nrm(ks[0], (BATCH, SEQ, D_MODEL), 1.0),
        "c": nrm(ks[1], (BATCH, D_MODEL), 1.0),
        "w_ada": nrm(ks[2], (DEPTH, D_MODEL, N_MOD * D_MODEL), 0.3 * D_MODEL ** -0.5),
        "b_ada": nrm(ks[3], (DEPTH, N_MOD * D_MODEL), 0.02),
        "norm_mix_g": gain(ks[4], (DEPTH, D_MODEL)),
        "norm_mlp_g": gain(ks[5], (DEPTH, D_MODEL)),
        "w_in": nrm(ks[6], (DEPTH, D_MODEL, IN_COLS), D_MODEL ** -0.5),
        "diff_qk_g": gain(ks[7], (DEPTH, 2, DA_QK)),
        "diff_lambda": nrm(ks[8], (DEPTH, 4, DA_QK), 0.1),
        "diff_subln_g": gain(ks[9], (DEPTH, DA_V)),
        "t5_bias": nrm(ks[10], (T5_BUCKETS, DA_HEADS), 0.5),
        "mla_q_norm_g": gain(ks[11], (DEPTH, MLA_Q_LORA)),
        "mla_kv_norm_g": gain(ks[12], (DEPTH, MLA_KV_LORA)),
        "w_q_up": nrm(ks[13], (DEPTH, MLA_Q_LORA, MLA_HEADS * (MLA_NOPE + MLA_ROPE)), MLA_Q_LORA ** -0.5),
        "w_kv_up": nrm(ks[14], (DEPTH, MLA_KV_LORA, MLA_HEADS * (MLA_NOPE + MLA_V)), MLA_KV_LORA ** -0.5),
        "mla_qk_g": gain(ks[15], (DEPTH, 2, MLA_NOPE + MLA_ROPE)),
        "w_branch": nrm(ks[16], (DEPTH, N_BRANCHES, BRANCH_WIDTH, D_MODEL), BRANCH_WIDTH ** -0.5),
        "w_out": nrm(ks[17], (DEPTH, D_MODEL, D_MODEL), D_MODEL ** -0.5),
        "w_mlp_in": nrm(ks[18], (DEPTH, D_MODEL, D_FF), D_MODEL ** -0.5),
        "w_mlp_out": nrm(ks[19], (DEPTH, D_FF, D_MODEL), D_FF ** -0.5),
    }


def reference(x, c, w_ada, b_ada, norm_mix_g, norm_mlp_g, w_in, diff_qk_g, diff_lambda,
              diff_subln_g, t5_bias, mla_q_norm_g, mla_kv_norm_g, w_q_up, w_kv_up, mla_qk_g,
              w_branch, w_out, w_mlp_in, w_mlp_out):
    b, s, d = x.shape
    for l in range(DEPTH):
        mod = c @ w_ada[l] + b_ada[l]
        sh1, sc1, g1, sh2, sc2, g2 = jnp.split(mod, N_MOD, axis=-1)

        h = _rms(x, norm_mix_g[l]) * (1.0 + sc1[:, None]) + sh1[:, None]
        (da_q, da_k, da_v, mla_cq, mla_ckv, mla_kpe,
         sb_q, sb_k, sb_v, gates) = _split_cols(h @ w_in[l])

        lam_init = 0.8 - 0.6 * math.exp(-0.3 * l)
        lp = diff_lambda[l].astype(jnp.float32)
        lam = jnp.exp(jnp.sum(lp[0] * lp[1])) - jnp.exp(jnp.sum(lp[2] * lp[3])) + lam_init
        qa = _rms(da_q.reshape(b, s, DA_HEADS, 2, DA_QK), diff_qk_g[l, 0])
        ka = _rms(da_k.reshape(b, s, DA_HEADS, 2, DA_QK), diff_qk_g[l, 1])
        va = da_v.reshape(b, s, DA_HEADS, DA_V)
        ya = _diff_attention(qa, ka, va, t5_bias, lam, lam_init, diff_subln_g[l])

        yb = _mla(mla_cq, mla_ckv, mla_kpe, mla_q_norm_g[l], mla_kv_norm_g[l],
                  w_q_up[l], w_kv_up[l], mla_qk_g[l])

        yc = _stick_breaking(sb_q.reshape(b, s, SB_HEADS, SB_DIM),
                             sb_k.reshape(b, s, SB_HEADS, SB_DIM),
                             sb_v.reshape(b, s, SB_HEADS, SB_DIM))

        branches = jnp.stack([ya.reshape(b, s, BRANCH_WIDTH),
                              yb.reshape(b, s, BRANCH_WIDTH),
                              yc.reshape(b, s, BRANCH_WIDTH)], axis=2)
        up = jnp.einsum('bsne,ned->bsnd', branches, w_branch[l])
        gate = jax.nn.sigmoid(gates.reshape(b, s, N_BRANCHES, d).astype(jnp.float32)).astype(x.dtype)
        merged = jnp.sum(gate * up, axis=2)
        x = x + g1[:, None] * (merged @ w_out[l])

        h2 = _rms(x, norm_mlp_g[l]) * (1.0 + sc2[:, None]) + sh2[:, None]
        x = x + g2[:, None] * (jnp.square(jax.nn.relu(h2 @ w_mlp_in[l])) @ w_mlp_out[l])
    return x
```

```cpp
#include <hip/hip_runtime.h>
#include <cstdio>
#include <cstdint>

#ifndef DUP_MASK
#define DUP_MASK 0
#endif
#ifndef MK_SPLIT
#define MK_SPLIT 0
#endif

#define GAS __attribute__((address_space(1)))
#define LAS __attribute__((address_space(3)))
typedef unsigned short bf16;
typedef short bf16x8 __attribute__((ext_vector_type(8)));
typedef short s16x4 __attribute__((ext_vector_type(4)));
typedef float f32x4 __attribute__((ext_vector_type(4)));
typedef float f32x2 __attribute__((ext_vector_type(2)));
typedef float f32x16 __attribute__((ext_vector_type(16)));
typedef unsigned u32x4 __attribute__((ext_vector_type(4)));
typedef unsigned u32x2 __attribute__((ext_vector_type(2)));

constexpr int S = 8192, DM = 2048, DEPTH = 4, DFF = 8192, NMOD = 6;
constexpr int IN_COLS = 13120, PN = 13312;
constexpr int C_DAQ = 0, C_DAK = 1024, C_DAV = 2048, C_CQ = 3072, C_CKV = 3584, C_KPE = 3840, C_SBQ = 4096, C_SBK = 5120, C_SBV = 6144, C_GATE = 7168;
constexpr int SRC_PAD_AT = 3904, PADW = 192;
constexpr float EPS = 1e-6f;
constexpr float LOG2E = 1.4426950408889634f;
constexpr float SC_DA = 0.125f * LOG2E;
constexpr float SC_MLA = 0.07216878364870323f * LOG2E;
constexpr float SC_SB = 0.08838834764831845f * LOG2E;
constexpr int GIN_TILES = 32;
constexpr float SB_DEAD = -150.0f;

constexpr size_t MiB = 1u << 20;
constexpr size_t WS_CTL = 0, CTL_ZERO_BYTES = 1 * MiB;
constexpr size_t WS_MODF = 1 * MiB;
constexpr size_t WS_ROPE = 2 * MiB;
constexpr size_t WS_W = 4 * MiB;
constexpr size_t W_IN = 0, W_QUP = W_IN + (size_t)PN * DM * 2, W_KVUP = W_QUP + (size_t)1536 * 512 * 2, W_BR = W_KVUP + (size_t)2048 * 256 * 2,
                 W_OUT = W_BR + (size_t)3 * 2048 * 1024 * 2, W_M1 = W_OUT + (size_t)DM * DM * 2, W_M2 = W_M1 + (size_t)DFF * DM * 2, W_LAYER = W_M2 + (size_t)DM * DFF * 2;
constexpr size_t WS_ACT = WS_W + DEPTH * W_LAYER;
constexpr size_t A_H = 0, A_PROJ = A_H + (size_t)S * DM * 2, A_QA = A_PROJ + (size_t)S * PN * 2, A_KA = A_QA + (size_t)S * 1024 * 2,
                 A_CQN = A_KA + (size_t)S * 1024 * 2, A_CKVN = A_CQN + (size_t)S * 512 * 2, A_KPE = A_CKVN + (size_t)S * 256 * 2,
                 A_QRAW = A_KPE + (size_t)S * 64 * 2, A_KVRAW = A_QRAW + (size_t)S * 1536 * 2, A_QH = A_KVRAW + (size_t)S * 2048 * 2,
                 A_KNOPE = A_QH + (size_t)S * 1536 * 2, A_OD = A_KNOPE + (size_t)S * 1024 * 2, A_YA = A_OD + (size_t)S * 2048 * 4,
                 A_YB = A_YA + (size_t)S * 1024 * 2, A_YC = A_YB + (size_t)S * 1024 * 2, A_MF = A_YC + (size_t)S * 1024 * 2,
                 A_MG = A_MF + (size_t)S * DM * 4, A_U = A_MG + (size_t)S * DM * 2, A_XB = A_U + (size_t)S * DFF * 2, A_XB2 = A_XB + (size_t)S * DM * 2, A_END = A_XB2 + (size_t)S * DM * 2;
constexpr size_t WS_END = WS_ACT + A_END;
constexpr int CW_BAR = 4096;
constexpr int CW_QUEUE = 16384;
constexpr int CW_DAC = 32768;
constexpr int CW_ADA = 8192;
constexpr size_t WS_BIAS = 512 * 1024;
constexpr int BIAS_PER_LAYER = PN + DFF;
constexpr size_t A_RSQA = A_H, A_RSQB = A_H + (size_t)1 * MiB;
constexpr size_t A_RSQCQ = A_H + (size_t)2 * MiB, A_RSQCKV = A_H + (size_t)3 * MiB;
constexpr size_t WS_ZERO = 256 * 1024;

constexpr int RING_BYTES = 131072;
constexpr int LDSCTL_OFF = RING_BYTES, MISC_OFF = LDSCTL_OFF + 320;
constexpr int LDS_BYTES = 147456;
constexpr int RS_OFF = MISC_OFF + 256;

__device__ __forceinline__ unsigned cvt_pk_bf16(float lo, float hi) { unsigned r; asm volatile("v_cvt_pk_bf16_f32 %0, %1, %2" : "=v"(r) : "v"(lo), "v"(hi)); return r; }
__device__ __forceinline__ float bf_lo(unsigned w) { return __uint_as_float(w << 16); }
__device__ __forceinline__ float bf_hi(unsigned w) { return __uint_as_float(w & 0xffff0000u); }
__device__ __forceinline__ float bf1(bf16 h) { return __uint_as_float((unsigned)h << 16); }
template <int M> __device__ __forceinline__ float swz(float v) {
    return __int_as_float(__builtin_amdgcn_ds_swizzle(__float_as_int(v), (M << 10) | 0x1F));
}
__device__ __forceinline__ float half_sum(float v) {
    auto rr = __builtin_amdgcn_permlane32_swap(__float_as_uint(v), __float_as_uint(v), false, false);
    return __uint_as_float(rr[0]) + __uint_as_float(rr[1]);
}
__device__ __forceinline__ float wave_sum(float v) {
    v += swz<1>(v); v += swz<2>(v); v += swz<4>(v); v += swz<8>(v); v += swz<16>(v);
    return half_sum(v);
}
__device__ __forceinline__ float rsq(float x) { return 1.0f / sqrtf(x); }

__device__ __forceinline__ int lane_id() { int l; asm volatile("v_mbcnt_lo_u32_b32 %0, -1, 0\n\tv_mbcnt_hi_u32_b32 %0, -1, %0" : "=v"(l)); return l; }
#define MYTID(wv) ((wv) * 64 + lane_id())

namespace pg8 {
constexpr int BM = 256, BK = 64, HALF = 128, HTB = HALF * BK * 2, STAGE_BYTES = 8 * HTB, NXCD = 8, WGM = 8;
__host__ __device__ __forceinline__ int lds_byte(int r, int c) { const int st = (r >> 4) * 2 + (c >> 5), rr = r & 15, cc = c & 31, ob = rr * 64 + cc * 2; return st * 1024 + (ob ^ (((ob >> 9) & 1) << 5)); }
__host__ __device__ __forceinline__ void stage_rc(int b, int& R, int& C) { const int st = b / 1024, sb = b % 1024, swz = sb ^ (((sb >> 9) & 1) << 5); R = (st >> 1) * 16 + swz / 64; C = (st & 1) * 32 + (swz % 64) / 2; }
__host__ __device__ __forceinline__ int perm32(int rho) { const int n = rho >> 4, i = rho & 15; return 8 * (i >> 2) + 4 * n + (i & 3); }

struct Unit { int pm, pn; };
struct Gemm { const bf16* A; const bf16* Bt; int M, N, K, lda; };

struct StaticOrder {
    int nM, nN, nwg, G, c;
    __device__ void init(int M, int N, int G_, int c_) { nM = M / BM; nN = N / BM; nwg = nM * nN; G = G_; c = c_; }
    __device__ bool next(int i, Unit& u) const {
        const long L = (long)i * G + c; if (L >= nwg) return false;
        int wgid = (int)L; { const int q = nwg / NXCD, r = nwg % NXCD, xcd = wgid % NXCD, off = wgid / NXCD; wgid = (xcd < r ? xcd * (q + 1) : r * (q + 1) + (xcd - r) * q) + off; }
        const int nig = WGM * nN, gid = wgid / nig, fm = gid * WGM, gsz = (nM - fm) < WGM ? (nM - fm) : WGM;
        u.pm = fm + ((wgid % nig) % gsz); u.pn = (wgid % nig) / gsz; return true;
    }
    __device__ __forceinline__ void a_ready(const Unit&) const {}
    __device__ __forceinline__ void done(const Unit&) const {}
};

struct OneUnit {
    Unit u0;
    __device__ bool next(int i, Unit& u) const { if (i > 0) return false; u = u0; return true; }
    __device__ __forceinline__ void a_ready(const Unit&) const {}
    __device__ __forceinline__ void done(const Unit&) const {}
};
template <int ACT  > struct EpiBf16 {
    static constexpr bool PERM = true, HAS_MID = false, RS = false, RSQ_OUT = false;
    bf16* O; int ldc; int sig_pn0;
    __device__ __forceinline__ void operator()(const f32x4 (&acc)[2][2][4][2], const Unit& u, int wr, int wc, int fr, int fq) const {
        const int row0 = u.pm * BM + wr * 64 + fr; const int col0 = u.pn * BM + wc * 32 + 8 * fq;
#pragma unroll
        for (int ai = 0; ai < 2; ++ai)
#pragma unroll
            for (int m = 0; m < 4; ++m) { bf16* rowp = O + (size_t)(row0 + ai * HALF + m * 16) * ldc + col0;
#pragma unroll
                for (int bj = 0; bj < 2; ++bj) { f32x4 v0 = acc[ai][bj][m][0], v1 = acc[ai][bj][m][1];
                    if (ACT == 2) {
#pragma unroll
                        for (int e = 0; e < 4; ++e) { const float a = fmaxf(v0[e], 0.f), b = fmaxf(v1[e], 0.f); v0[e] = a * a; v1[e] = b * b; } }
                    if (ACT == 3) { if (u.pn >= sig_pn0) {
#pragma unroll
                        for (int e = 0; e < 4; ++e) { v0[e] = __builtin_amdgcn_rcpf(1.f + __builtin_amdgcn_exp2f(-LOG2E * v0[e])); v1[e] = __builtin_amdgcn_rcpf(1.f + __builtin_amdgcn_exp2f(-LOG2E * v1[e])); } } }
                    u32x4 w; w.x = cvt_pk_bf16(v0[0], v0[1]); w.y = cvt_pk_bf16(v0[2], v0[3]); w.z = cvt_pk_bf16(v1[0], v1[1]); w.w = cvt_pk_bf16(v1[2], v1[3]);
                    *(u32x4*)(rowp + bj * HALF) = w; } }
    }
};
template <int ACT, bool RSO_ = false> struct EpiBf16N {
    static constexpr bool PERM = true, HAS_MID = false, RS = true, RSQ_OUT = false, RSO = RSO_, NO_BIAS = false;
    bf16* O; int ldc; int sig_pn0; const float* rsqp; const float* bias; float inv_n; float* rq_cq; float* rq_ckv;
    __device__ __forceinline__ void operator()(const f32x4 (&acc)[2][2][4][2], const Unit& u, int wr, int wc, int fr, int fq, const LAS float* raw, const LAS float* bl, LAS float* part) const {
        const int row0 = u.pm * BM + wr * 64 + fr; const int col0 = u.pn * BM + wc * 32 + 8 * fq;
        const bool want = RSO && u.pn >= C_CQ / 256 && u.pn <= C_CKV / 256;
        f32x4 bv[2][2];
#pragma unroll
        for (int bj = 0; bj < 2; ++bj)
#pragma unroll
            for (int n = 0; n < 2; ++n) bv[bj][n] = *(const LAS f32x4*)(bl + bj * HALF + wc * 32 + 8 * fq + 4 * n);
#pragma unroll
        for (int ai = 0; ai < 2; ++ai)
#pragma unroll
            for (int m = 0; m < 4; ++m) { bf16* rowp = O + (size_t)(row0 + ai * HALF + m * 16) * ldc + col0;
                const LAS float* rp = raw + (ai * HALF + wr * 64 + m * 16 + fr) * 8;
                const f32x4 p0 = *(const LAS f32x4*)rp, p1 = *(const LAS f32x4*)(rp + 4);
                const float rstd = __builtin_amdgcn_rsqf(((p0[0] + p0[1]) + (p0[2] + p0[3]) + (p1[0] + p1[1]) + (p1[2] + p1[3])) * inv_n + EPS);
                float ss = 0.f;
#pragma unroll
                for (int bj = 0; bj < 2; ++bj) { f32x4 v0 = acc[ai][bj][m][0] * rstd + bv[bj][0], v1 = acc[ai][bj][m][1] * rstd + bv[bj][1];
                    if (RSO) ss += ((v0[0] * v0[0] + v0[1] * v0[1]) + (v0[2] * v0[2] + v0[3] * v0[3])) + ((v1[0] * v1[0] + v1[1] * v1[1]) + (v1[2] * v1[2] + v1[3] * v1[3]));
                    if (ACT == 2) {
#pragma unroll
                        for (int e = 0; e < 4; ++e) { const float a = fmaxf(v0[e], 0.f), b = fmaxf(v1[e], 0.f); v0[e] = a * a; v1[e] = b * b; } }
                    if (ACT == 3) { if (u.pn >= sig_pn0) {
#pragma unroll
                        for (int e = 0; e < 4; ++e) { v0[e] = __builtin_amdgcn_rcpf(1.f + __builtin_amdgcn_exp2f(-LOG2E * v0[e])); v1[e] = __builtin_amdgcn_rcpf(1.f + __builtin_amdgcn_exp2f(-LOG2E * v1[e])); } } }
                    u32x4 w; w.x = cvt_pk_bf16(v0[0], v0[1]); w.y = cvt_pk_bf16(v0[2], v0[3]); w.z = cvt_pk_bf16(v1[0], v1[1]); w.w = cvt_pk_bf16(v1[2], v1[3]);
                    *(u32x4*)(rowp + bj * HALF) = w; }
                if (RSO) { if (want) { ss += swz<16>(ss); ss = half_sum(ss); if (fq == 0) part[wc * BM + ai * HALF + wr * 64 + m * 16 + fr] = ss; } } }
    }
};
struct EpiKvUp {
    static constexpr bool PERM = true, HAS_MID = false, RS = true, RSQ_OUT = false, RSO = false, NO_BIAS = true;
    bf16* KN; const float* gk; const float* rsqp;
    static constexpr float inv_n = 1.f / 256.f;
    __device__ __forceinline__ void operator()(const f32x4 (&acc)[2][2][4][2], const Unit& u, int wr, int wc, int fr_, int fq_, const LAS float* raw, const LAS float* bl, LAS float* part) const {
        const int ln_ = lane_id(), fr = ln_ & 15, fq = ln_ >> 4;
        const int row0 = u.pm * BM + wr * 64 + fr; const int cl = wc * 32 + 8 * fq;
        float rl[2][4];
#pragma unroll
        for (int ai = 0; ai < 2; ++ai)
#pragma unroll
            for (int m = 0; m < 4; ++m) { const int rloc = ai * HALF + wr * 64 + m * 16 + fr; const LAS float* rp = raw + rloc * 8;
                const f32x4 p0 = *(const LAS f32x4*)rp, p1 = *(const LAS f32x4*)(rp + 4);
                const float rstd = __builtin_amdgcn_rsqf(((p0[0] + p0[1]) + (p0[2] + p0[3]) + (p1[0] + p1[1]) + (p1[2] + p1[3])) * inv_n + EPS); rl[ai][m] = rstd;
                const f32x4 v0 = acc[ai][0][m][0] * rstd, v1 = acc[ai][0][m][1] * rstd;
                float ss = ((v0[0] * v0[0] + v0[1] * v0[1]) + (v0[2] * v0[2] + v0[3] * v0[3])) + ((v1[0] * v1[0] + v1[1] * v1[1]) + (v1[2] * v1[2] + v1[3] * v1[3]));
                ss += swz<16>(ss); ss = half_sum(ss);
                if (fq == 0) part[wc * BM + rloc] = ss; }
        asm volatile("s_waitcnt lgkmcnt(0)" ::: "memory"); __builtin_amdgcn_s_barrier();
        const f32x4 g0 = *(const f32x4*)(gk + cl), g1 = *(const f32x4*)(gk + cl + 4);
#pragma unroll
        for (int ai = 0; ai < 2; ++ai)
#pragma unroll
            for (int m = 0; m < 4; ++m) { const int rloc = ai * HALF + wr * 64 + m * 16 + fr; const size_t row = (size_t)(row0 + ai * HALF + m * 16);
                const float rk = __builtin_amdgcn_rsqf(((part[rloc] + part[BM + rloc]) + (part[2 * BM + rloc] + part[3 * BM + rloc])) * (1.f / 128.f) + EPS) * rl[ai][m];
                { const f32x4 v0 = acc[ai][0][m][0] * rk * g0, v1 = acc[ai][0][m][1] * rk * g1;
                  u32x4 w; w.x = cvt_pk_bf16(v0[0], v0[1]); w.y = cvt_pk_bf16(v0[2], v0[3]); w.z = cvt_pk_bf16(v1[0], v1[1]); w.w = cvt_pk_bf16(v1[2], v1[3]);
                  *(u32x4*)(KN + row * 1024 + u.pn * 128 + cl) = w; }
                { const f32x4 v0 = acc[ai][1][m][0] * rl[ai][m], v1 = acc[ai][1][m][1] * rl[ai][m];
                  u32x4 w; w.x = cvt_pk_bf16(v0[0], v0[1]); w.y = cvt_pk_bf16(v0[2], v0[3]); w.z = cvt_pk_bf16(v1[0], v1[1]); w.w = cvt_pk_bf16(v1[2], v1[3]);
                  *(u32x4*)((bf16*)((char*)KN + ((ptrdiff_t)A_KVRAW - (ptrdiff_t)A_KNOPE)) + row * 2048 + u.pn * 256 + 128 + cl) = w; } }
    }
};
template <int PASS> struct EpiBranch {
    static constexpr bool PERM = true;
    const bf16* G; int ldg; float* MF; bf16* MG;
    __device__ __forceinline__ void operator()(const f32x4 (&acc)[2][2][4][2], const Unit& u, int wr, int wc, int fr, int fq) const {
        const int row0 = u.pm * BM + wr * 64 + fr; const int col0 = u.pn * BM + wc * 32 + 8 * fq;
#pragma unroll
        for (int ai = 0; ai < 2; ++ai)
#pragma unroll
            for (int m = 0; m < 4; ++m) { const size_t row = (size_t)(row0 + ai * HALF + m * 16);
#pragma unroll
                for (int bj = 0; bj < 2; ++bj) { const int col = col0 + bj * HALF;
                    const u32x4 gw = *(const u32x4*)(G + row * ldg + col);
                    float g[8] = {bf_lo(gw.x), bf_hi(gw.x), bf_lo(gw.y), bf_hi(gw.y), bf_lo(gw.z), bf_hi(gw.z), bf_lo(gw.w), bf_hi(gw.w)};
                    f32x4 v0, v1;
#pragma unroll
                    for (int e = 0; e < 4; ++e) { v0[e] = acc[ai][bj][m][0][e] * __builtin_amdgcn_rcpf(1.f + __builtin_amdgcn_exp2f(-LOG2E * g[e]));
                                                  v1[e] = acc[ai][bj][m][1][e] * __builtin_amdgcn_rcpf(1.f + __builtin_amdgcn_exp2f(-LOG2E * g[4 + e])); }
                    float* mp = MF + row * DM + col;
                    if (PASS > 0) { v0 += *(const f32x4*)mp; v1 += *(const f32x4*)(mp + 4); }
                    if (PASS < 2) { *(f32x4*)mp = v0; *(f32x4*)(mp + 4) = v1; }
                    else { u32x4 w; w.x = cvt_pk_bf16(v0[0], v0[1]); w.y = cvt_pk_bf16(v0[2], v0[3]); w.z = cvt_pk_bf16(v1[0], v1[1]); w.w = cvt_pk_bf16(v1[2], v1[3]);
                           *(u32x4*)(MG + row * DM + col) = w; } } }
    }
};
struct EpiBranchRatio {
    static constexpr bool PERM = true, HAS_MID = true, RS = false, RSQ_OUT = false;
    const bf16* G; int ldg; bf16* MG;
    __device__ __forceinline__ void mid(f32x4 (&acc)[2][2][4][2], const Unit& u, int seg, int wr, int wc, int fr, int fq) const {
        const int row0 = u.pm * BM + wr * 64 + fr; const int col0 = u.pn * BM + wc * 32 + 8 * fq;
        const bf16* Ga = G + (seg - 1) * DM; const bf16* Gb = G + seg * DM;
#pragma unroll
        for (int ai = 0; ai < 2; ++ai)
#pragma unroll
            for (int mp = 0; mp < 2; ++mp) {
                u32x4 ga[2][2], gb[2][2];
#pragma unroll
                for (int mm = 0; mm < 2; ++mm)
#pragma unroll
                    for (int bj = 0; bj < 2; ++bj) { const size_t off = (size_t)(row0 + ai * HALF + (2 * mp + mm) * 16) * ldg + col0 + bj * HALF;
                        ga[mm][bj] = *(const u32x4*)(Ga + off); gb[mm][bj] = *(const u32x4*)(Gb + off); }
#pragma unroll
                for (int mm = 0; mm < 2; ++mm)
#pragma unroll
                    for (int bj = 0; bj < 2; ++bj) { const int m = 2 * mp + mm; const u32x4 a_ = ga[mm][bj], b_ = gb[mm][bj];
                        const float sa[8] = {bf_lo(a_.x), bf_hi(a_.x), bf_lo(a_.y), bf_hi(a_.y), bf_lo(a_.z), bf_hi(a_.z), bf_lo(a_.w), bf_hi(a_.w)};
                        const float sb[8] = {bf_lo(b_.x), bf_hi(b_.x), bf_lo(b_.y), bf_hi(b_.y), bf_lo(b_.z), bf_hi(b_.z), bf_lo(b_.w), bf_hi(b_.w)};
#pragma unroll
                        for (int e = 0; e < 4; ++e) { acc[ai][bj][m][0][e] *= sa[e] * __builtin_amdgcn_rcpf(fmaxf(sb[e], 1e-30f)); acc[ai][bj][m][1][e] *= sa[4 + e] * __builtin_amdgcn_rcpf(fmaxf(sb[4 + e], 1e-30f)); } }
            }
    }
    __device__ __forceinline__ void operator()(const f32x4 (&acc)[2][2][4][2], const Unit& u, int wr, int wc, int fr, int fq) const {
        const int row0 = u.pm * BM + wr * 64 + fr; const int col0 = u.pn * BM + wc * 32 + 8 * fq;
        const bf16* Gc = G + 2 * DM;
#pragma unroll
        for (int ai = 0; ai < 2; ++ai)
#pragma unroll
            for (int mp = 0; mp < 2; ++mp) {
                u32x4 gc[2][2];
#pragma unroll
                for (int mm = 0; mm < 2; ++mm)
#pragma unroll
                    for (int bj = 0; bj < 2; ++bj) gc[mm][bj] = *(const u32x4*)(Gc + (size_t)(row0 + ai * HALF + (2 * mp + mm) * 16) * ldg + col0 + bj * HALF);
#pragma unroll
                for (int mm = 0; mm < 2; ++mm)
#pragma unroll
                    for (int bj = 0; bj < 2; ++bj) { const int m = 2 * mp + mm; const u32x4 c_ = gc[mm][bj];
                        const float sc[8] = {bf_lo(c_.x), bf_hi(c_.x), bf_lo(c_.y), bf_hi(c_.y), bf_lo(c_.z), bf_hi(c_.z), bf_lo(c_.w), bf_hi(c_.w)};
                        f32x4 v0, v1;
#pragma unroll
                        for (int e = 0; e < 4; ++e) { v0[e] = acc[ai][bj][m][0][e] * sc[e]; v1[e] = acc[ai][bj][m][1][e] * sc[4 + e]; }
                        u32x4 w; w.x = cvt_pk_bf16(v0[0], v0[1]); w.y = cvt_pk_bf16(v0[2], v0[3]); w.z = cvt_pk_bf16(v1[0], v1[1]); w.w = cvt_pk_bf16(v1[2], v1[3]);
                        *(u32x4*)(MG + (size_t)(row0 + ai * HALF + m * 16) * DM + col0 + bj * HALF) = w; }
            }
    }
};
template <bool XIN16, bool XOUT16> struct EpiResid {
    static constexpr bool PERM = true, HAS_MID = false, RS = false, RSQ_OUT = XOUT16;
    const void* xin; void* out; const float* gvec; float* rsqp; LAS float* part;
    __device__ __forceinline__ void operator()(const f32x4 (&acc)[2][2][4][2], const Unit& u, int wr, int wc, int fr, int fq) const {
        const int row0 = u.pm * BM + wr * 64 + fr; const int col0 = u.pn * BM + wc * 32 + 8 * fq;
        f32x4 gv[2][2];
#pragma unroll
        for (int bj = 0; bj < 2; ++bj)
#pragma unroll
            for (int n = 0; n < 2; ++n) gv[bj][n] = *(const f32x4*)(gvec + col0 + bj * HALF + n * 4);
#pragma unroll
        for (int ai = 0; ai < 2; ++ai)
#pragma unroll
            for (int mp = 0; mp < 2; ++mp) {
                f32x4 xv[2][2][2];
#pragma unroll
                for (int mm = 0; mm < 2; ++mm) { const size_t off = (size_t)(row0 + ai * HALF + (2 * mp + mm) * 16) * DM + col0;
#pragma unroll
                    for (int bj = 0; bj < 2; ++bj) {
                        if (XIN16) { const u32x4 w_ = *(const u32x4*)((const bf16*)xin + off + bj * HALF);
                            xv[mm][bj][0] = (f32x4){bf_lo(w_.x), bf_hi(w_.x), bf_lo(w_.y), bf_hi(w_.y)}; xv[mm][bj][1] = (f32x4){bf_lo(w_.z), bf_hi(w_.z), bf_lo(w_.w), bf_hi(w_.w)}; }
                        else { xv[mm][bj][0] = *(const f32x4*)((const float*)xin + off + bj * HALF); xv[mm][bj][1] = *(const f32x4*)((const float*)xin + off + bj * HALF + 4); } } }
#pragma unroll
                for (int mm = 0; mm < 2; ++mm) { const int m = 2 * mp + mm; const size_t off = (size_t)(row0 + ai * HALF + m * 16) * DM + col0; float ss = 0.f;
#pragma unroll
                    for (int bj = 0; bj < 2; ++bj) { const f32x4 v0 = xv[mm][bj][0] + gv[bj][0] * acc[ai][bj][m][0], v1 = xv[mm][bj][1] + gv[bj][1] * acc[ai][bj][m][1];
                        if (XOUT16) ss += ((v0[0] * v0[0] + v0[1] * v0[1]) + (v0[2] * v0[2] + v0[3] * v0[3])) + ((v1[0] * v1[0] + v1[1] * v1[1]) + (v1[2] * v1[2] + v1[3] * v1[3]));
                        if (XOUT16) { u32x4 w; w.x = cvt_pk_bf16(v0[0], v0[1]); w.y = cvt_pk_bf16(v0[2], v0[3]); w.z = cvt_pk_bf16(v1[0], v1[1]); w.w = cvt_pk_bf16(v1[2], v1[3]);
                            *(u32x4*)((bf16*)out + off + bj * HALF) = w; }
                        else { *(f32x4*)((float*)out + off + bj * HALF) = v0; *(f32x4*)((float*)out + off + bj * HALF + 4) = v1; } }
                    if (XOUT16) { ss += swz<16>(ss); ss = half_sum(ss);
                        if (fq == 0) part[wc * BM + ai * HALF + wr * 64 + m * 16 + fr] = ss; } }
            }
    }
};

template <class Epi, class Sched>
__device__ __forceinline__ void gemm_phase(LAS unsigned char* lds, const Gemm g, const Sched& S, const Epi& E, const int wv) {
    int tid = MYTID(wv); asm volatile("" : "+v"(tid));
    const int wid = __builtin_amdgcn_readfirstlane(tid >> 6), lane = tid & 63, wr = wid >> 2, wc = wid & 3, fr = lane & 15, fq = lane >> 4;
    const int K = g.K, nt = K / BK, lda = g.lda;
    const int thook = nt >= 6 ? 4 : nt - 2;
    unsigned voffA[2], voffB[2];
#pragma unroll
    for (int i = 0; i < 2; ++i) { int R, C; stage_rc(tid * 16 + i * 8192, R, C); const int Rb = Epi::PERM ? ((R & ~31) + perm32(R & 31)) : R;
        voffA[i] = (unsigned)(R * lda + C) * 2u; voffB[i] = (unsigned)(Rb * K + C) * 2u; }
    const size_t kstep = (size_t)(BK * 2);
    const size_t hsA = (size_t)HALF * lda * 2, hsB = (size_t)HALF * K * 2;
    const size_t tsA = 2 * hsA, tsB = 2 * hsB;
    const unsigned ldsw = (unsigned)wid * 1024u;
    const int aoff = lds_byte(wr * 64 + fr, fq * 8), boff = lds_byte(wc * 32 + fr, fq * 8);
#define PG8_SA(b, h) (((b) * 2 + (h)) * HTB)
#define PG8_SB(b, h) ((4 + (b) * 2 + (h)) * HTB)
#define PG8_STAGE(bufoff, gbase, voff) do { _Pragma("unroll") for (int _i = 0; _i < 2; ++_i) \
        __builtin_amdgcn_global_load_lds((const unsigned*)((const char*)(gbase) + (voff)[_i]), (LAS unsigned*)(lds + (bufoff) + ldsw + _i * 8192), 16, 0, 0); } while (0)
#define PG8_LDA(dst, b, h) do { _Pragma("unroll") for (int m = 0; m < 4; ++m) _Pragma("unroll") for (int k = 0; k < 2; ++k) dst[m][k] = *(const LAS bf16x8*)(lds + PG8_SA(b, h) + aoff + m * 2048 + k * 1024); } while (0)
#define PG8_LDB(dst, b, h) do { _Pragma("unroll") for (int n = 0; n < 2; ++n) _Pragma("unroll") for (int k = 0; k < 2; ++k) dst[n][k] = *(const LAS bf16x8*)(lds + PG8_SB(b, h) + boff + n * 2048 + k * 1024); } while (0)
#define PG8_MMA(ai, bj, At, Bt) do { __builtin_amdgcn_s_setprio(1); _Pragma("unroll") for (int m = 0; m < 4; ++m) _Pragma("unroll") for (int n = 0; n < 2; ++n) _Pragma("unroll") for (int k = 0; k < 2; ++k) \
        acc[ai][bj][m][n] = __builtin_amdgcn_mfma_f32_16x16x32_bf16(Bt[n][k], At[m][k], acc[ai][bj][m][n], 0, 0, 0); __builtin_amdgcn_s_setprio(0); } while (0)
#define PG8_WAIT_V(n) asm volatile("s_waitcnt vmcnt(" #n ")" ::: "memory")
#define PG8_WAIT_L(n) asm volatile("s_waitcnt lgkmcnt(" #n ")" ::: "memory")
#define PG8_BAR __builtin_amdgcn_s_barrier()
#define PG8_SCHED __builtin_amdgcn_sched_barrier(0)
    Unit cur, nxt; int ui = 0;
    if (!S.next(0, cur)) return;
    f32x4 acc[2][2][4][2];
#pragma unroll
    for (int a = 0; a < 2; ++a)
#pragma unroll
        for (int b = 0; b < 2; ++b)
#pragma unroll
            for (int m = 0; m < 4; ++m)
#pragma unroll
                for (int n = 0; n < 2; ++n) acc[a][b][m][n] = (f32x4){0.f, 0.f, 0.f, 0.f};
    bf16x8 At[4][2], B0[2][2], B1[2][2];
    const char* cA = (const char*)g.A + (size_t)cur.pm * tsA; const char* cB = (const char*)g.Bt + (size_t)cur.pn * tsB;
    S.a_ready(cur);
    PG8_STAGE(PG8_SB(0, 0), cB, voffB); PG8_STAGE(PG8_SB(0, 1), cB + hsB, voffB); PG8_STAGE(PG8_SA(0, 0), cA, voffA); PG8_STAGE(PG8_SA(0, 1), cA + hsA, voffA);
    if (wr == 1) PG8_BAR;
    PG8_WAIT_V(2); PG8_BAR;
    PG8_STAGE(PG8_SB(1, 0), cB + kstep, voffB); PG8_STAGE(PG8_SA(1, 0), cA + kstep, voffA); PG8_STAGE(PG8_SB(1, 1), cB + hsB + kstep, voffB);
    PG8_WAIT_V(6); PG8_BAR;
    for (;;) {
        const bool has_next = S.next(ui + 1, nxt);
        const char* nA = has_next ? (const char*)g.A + (size_t)nxt.pm * tsA : cA; const char* nB = has_next ? (const char*)g.Bt + (size_t)nxt.pn * tsB : cB;
        for (int t = 0; t < nt; t += 2) {
            const bool last = (t == nt - 2);
            const char* a1 = cA + (size_t)(t + 1) * kstep;
            const char* a2 = last ? nA : cA + (size_t)(t + 2) * kstep; const char* b2 = last ? nB : cB + (size_t)(t + 2) * kstep;
            const char* a3 = a2 + kstep; const char* b3 = b2 + kstep;
            if (last && has_next) S.a_ready(nxt);
            if constexpr (Epi::HAS_MID) { if (t > 0 && (t & 15) == 0) E.mid(acc, cur, t >> 4, wr, wc, fr, fq); }
            if constexpr (Epi::RS) { if (t == thook) {
                const int ln_ = lane_id();
                __builtin_amdgcn_global_load_lds((const unsigned*)((const char*)(E.rsqp + (size_t)cur.pm * BM * 8) + ldsw + ln_ * 16), (LAS unsigned*)(lds + RS_OFF + ldsw), 16, 0, 0);
                if constexpr (!Epi::NO_BIAS) { if (wid == 0) __builtin_amdgcn_global_load_lds((const unsigned*)((const char*)(E.bias + cur.pn * BM) + ln_ * 16), (LAS unsigned*)(lds + RS_OFF + 8192), 16, 0, 0); } } }
            PG8_LDB(B0, 0, 0); PG8_LDB(B1, 0, 1); PG8_SCHED; PG8_LDA(At, 0, 0); PG8_STAGE(PG8_SA(1, 1), a1 + hsA, voffA);
            PG8_WAIT_V(8); PG8_WAIT_L(0); PG8_BAR; PG8_MMA(0, 0, At, B0); PG8_MMA(0, 1, At, B1); PG8_BAR; PG8_SCHED;
            PG8_LDA(At, 0, 1); PG8_STAGE(PG8_SB(0, 0), b2, voffB); PG8_STAGE(PG8_SB(0, 1), b2 + hsB, voffB); PG8_STAGE(PG8_SA(0, 0), a2, voffA);
            PG8_WAIT_V(8); PG8_WAIT_L(0); PG8_BAR; PG8_MMA(1, 0, At, B0); PG8_MMA(1, 1, At, B1); PG8_BAR; PG8_SCHED;
            PG8_LDB(B0, 1, 0); PG8_LDB(B1, 1, 1); PG8_SCHED; PG8_LDA(At, 1, 0); PG8_STAGE(PG8_SA(0, 1), a2 + hsA, voffA);
            PG8_WAIT_V(8); PG8_WAIT_L(0); PG8_BAR; PG8_MMA(0, 0, At, B0); PG8_MMA(0, 1, At, B1); PG8_BAR; PG8_SCHED;
            PG8_LDA(At, 1, 1); PG8_STAGE(PG8_SB(1, 0), b3, voffB); PG8_STAGE(PG8_SB(1, 1), b3 + hsB, voffB); PG8_STAGE(PG8_SA(1, 0), a3, voffA);
            PG8_WAIT_V(8); PG8_WAIT_L(0); PG8_BAR; PG8_MMA(1, 0, At, B0); PG8_MMA(1, 1, At, B1); PG8_BAR; PG8_SCHED;
        }
        if (wr == 0) PG8_BAR;
        if constexpr (Epi::RS) E(acc, cur, wr, wc, fr, fq, (const LAS float*)(lds + RS_OFF), (const LAS float*)(lds + RS_OFF + 8192), (LAS float*)(lds + RS_OFF + 9216)); else E(acc, cur, wr, wc, fr, fq);
        S.done(cur);
        if constexpr (Epi::RS) { if constexpr (Epi::RSO) { if (cur.pn >= C_CQ / 256 && cur.pn <= C_CKV / 256) {
            asm volatile("s_waitcnt lgkmcnt(0)" ::: "memory"); PG8_BAR;
            const int t2 = wid * 64 + lane_id();
            if (t2 < BM) { const LAS float* pp = (const LAS float*)(lds + RS_OFF + 9216) + t2; const float sm = (pp[0] + pp[BM]) + (pp[2 * BM] + pp[3 * BM]);
                const bool ckv = cur.pn == C_CKV / 256; const int slot = ckv ? 0 : cur.pn - C_CQ / 256; float* rq = (ckv ? E.rq_ckv : E.rq_cq) + (size_t)(cur.pm * BM + t2) * 8;
                rq[slot] = sm;
                if (slot == 0) {
                    float zf; asm volatile("v_mov_b32 %0, 0" : "=v"(zf));
                    if (ckv) rq[1] = zf;
#pragma unroll
                    for (int z = 2; z < 8; ++z) rq[z] = zf; } } } } }
        if constexpr (Epi::RSQ_OUT) {
            asm volatile("s_waitcnt lgkmcnt(0)" ::: "memory"); PG8_BAR;
            const int t2 = wid * 64 + lane_id();
            if (t2 < BM) { const LAS float* pp = (const LAS float*)(lds + RS_OFF) + t2; E.rsqp[(size_t)(cur.pm * BM + t2) * 8 + cur.pn] = (pp[0] + pp[BM]) + (pp[2 * BM] + pp[3 * BM]); } }
        if (!has_next) break;
#pragma unroll
        for (int a = 0; a < 2; ++a)
#pragma unroll
            for (int b = 0; b < 2; ++b)
#pragma unroll
                for (int m = 0; m < 4; ++m)
#pragma unroll
                    for (int n = 0; n < 2; ++n) acc[a][b][m][n] = (f32x4){0.f, 0.f, 0.f, 0.f};
        cur = nxt; cA = nA; cB = nB; ++ui;
        if (wr == 1) PG8_BAR;
    }
    PG8_WAIT_V(0);
    PG8_BAR;
#undef PG8_SA
#undef PG8_SB
#undef PG8_STAGE
#undef PG8_LDA
#undef PG8_LDB
#undef PG8_MMA
#undef PG8_WAIT_V
#undef PG8_WAIT_L
#undef PG8_BAR
#undef PG8_SCHED
}
}

namespace att {
constexpr int NW = 8, QBLK = 32, KVBLK = 64, QB = 256;
constexpr int SHM_V = KVBLK * 128 * 2;
constexpr int NSLOT = 3, KSLOT = 64 * 192 * 2;
constexpr int L_V = 0, L_K = NSLOT * SHM_V, L_WS = L_K + NSLOT * KSLOT, L_BIAS = L_WS + NW * 64 * 4, L_FLAG = L_BIAS + 1024, L_QT = 0, L_END = L_FLAG + 256;
static_assert(L_END <= RING_BYTES, "attention LDS");
#define SBAR() __builtin_amdgcn_sched_barrier(0)
__device__ __forceinline__ int crow(int r, int hi) { return (r & 3) + 8 * (r >> 2) + 4 * hi; }
template <int RB> __device__ __forceinline__ int kaddr(int row, int blk, int c8) {
    const int sw = (RB == 256) ? (row & 7) : ((row >> 1) & 7);
    return row * RB + blk * 128 + ((c8 ^ sw) << 4);
}
template <int RB> __device__ __forceinline__ int kswz(int row, int colB) { return kaddr<RB>(row, colB >> 7, (colB >> 4) & 7); }
constexpr float THR = 11.0f;
__device__ __forceinline__ void partialSM(f32x16& p0, f32x16& p1, float& m_reg, float& mn, float& alpha) {
    float pmax = p0[0];
#pragma unroll
    for (int r = 1; r < 16; ++r) pmax = fmaxf(pmax, p0[r]);
#pragma unroll
    for (int r = 0; r < 16; ++r) pmax = fmaxf(pmax, p1[r]);
    { auto rr = __builtin_amdgcn_permlane32_swap(__float_as_uint(pmax), __float_as_uint(pmax), false, false);
      pmax = fmaxf(__uint_as_float(rr[0]), __uint_as_float(rr[1])); }
    if (__builtin_expect(__all(pmax - m_reg <= THR), 1)) { mn = m_reg; alpha = 1.f; }
    else { mn = fmaxf(m_reg, pmax); alpha = __builtin_amdgcn_exp2f(m_reg - mn); m_reg = mn; }
#pragma unroll
    for (int r = 0; r < 16; ++r) p0[r] = p0[r] - mn;
#pragma unroll
    for (int r = 0; r < 16; ++r) p1[r] = p1[r] - mn;
#pragma unroll
    for (int r = 0; r < 16; ++r) p0[r] = __builtin_amdgcn_exp2f(p0[r]);
}
#define PK4(P, BASE, OUT) do { unsigned a0 = cvt_pk_bf16(P[BASE + 0], P[BASE + 1]), a1 = cvt_pk_bf16(P[BASE + 2], P[BASE + 3]);   \
    unsigned b0 = cvt_pk_bf16(P[BASE + 4], P[BASE + 5]), b1 = cvt_pk_bf16(P[BASE + 6], P[BASE + 7]);                              \
    auto r0 = __builtin_amdgcn_permlane32_swap(a0, b0, false, false); auto r1 = __builtin_amdgcn_permlane32_swap(a1, b1, false, false); \
    u32x4 w = {r0[0], r1[0], r0[1], r1[1]}; OUT = *reinterpret_cast<bf16x8*>(&w); } while (0)
__device__ __forceinline__ void finishSM(f32x16& p0, f32x16& p1, float alpha, float& l_reg, bf16x8& pa0, bf16x8& pa1, bf16x8& pa2, bf16x8& pa3) {
#pragma unroll
    for (int r = 0; r < 16; ++r) p1[r] = __builtin_amdgcn_exp2f(p1[r]);
    float ps = 0;
#pragma unroll
    for (int r = 0; r < 16; ++r) ps += p0[r];
#pragma unroll
    for (int r = 0; r < 16; ++r) ps += p1[r];
    { auto rr = __builtin_amdgcn_permlane32_swap(__float_as_uint(ps), __float_as_uint(ps), false, false);
      ps = __uint_as_float(rr[0]) + __uint_as_float(rr[1]); }
    l_reg = l_reg * alpha + ps;
    PK4(p0, 0, pa0); PK4(p0, 8, pa1); PK4(p1, 0, pa2); PK4(p1, 8, pa3);
}
template <int DK, int QREG> __device__ __forceinline__ void qkt(f32x16& p0, f32x16& p1, const LAS char* Ks, const bf16x8* qr, const LAS char* qt, int r32, int hi) {
    constexpr int RB = DK * 2;
    p0 = f32x16{}; p1 = f32x16{};
#pragma unroll
    for (int d0 = 0; d0 < DK / 16; ++d0) { const int ka = kaddr<RB>(r32, d0 >> 2, 4 * hi + (d0 & 3));
        const bf16x8 b0 = *(const LAS bf16x8*)(Ks + ka);
        const bf16x8 b1 = *(const LAS bf16x8*)(Ks + ka + 32 * RB);
        bf16x8 qf;
        if (d0 < QREG) qf = qr[d0]; else qf = *(const LAS bf16x8*)(qt + kaddr<128>(r32, (d0 - QREG) >> 2, 4 * hi + (d0 & 3)));
        p0 = __builtin_amdgcn_mfma_f32_32x32x16_bf16(b0, qf, p0, 0, 0, 0);
        p1 = __builtin_amdgcn_mfma_f32_32x32x16_bf16(b1, qf, p1, 0, 0, 0); }
}
__device__ __forceinline__ int v_st(int k, int c) { const int kk = (k & ~0xC) | ((k & 4) << 1) | ((k & 8) >> 1); return ((kk >> 3) * 4 + (c >> 5)) * 512 + ((kk & 7) * 32 + (c & 31)) * 2; }
__device__ __forceinline__ int v_rd_base(int lane) { return ((lane & 3) << 3) | (((lane >> 2) & 3) << 6) | (((lane >> 4) & 1) << 5) | (((lane >> 5) & 1) << 8); }
constexpr int v_rd_off(int d0, int ks, int half) { return d0 * 512 + ks * 4096 + half * 2048; }
template <int OFF> __device__ __forceinline__ s16x4 tr_read(int vb) {
    s16x4 r; asm volatile("ds_read_b64_tr_b16 %0, %1 offset:%2" : "=&v"(r) : "v"(vb), "i"(OFF) : "memory"); return r;
}
template <int D0> __device__ __forceinline__ void pv_one(f32x16& od, int vb, bf16x8 pa0, bf16x8 pa1, bf16x8 pa2, bf16x8 pa3) {
    const s16x4 l0 = tr_read<v_rd_off(D0, 0, 0)>(vb), h0 = tr_read<v_rd_off(D0, 0, 1)>(vb), l1 = tr_read<v_rd_off(D0, 1, 0)>(vb), h1 = tr_read<v_rd_off(D0, 1, 1)>(vb);
    const s16x4 l2 = tr_read<v_rd_off(D0, 2, 0)>(vb), h2 = tr_read<v_rd_off(D0, 2, 1)>(vb), l3 = tr_read<v_rd_off(D0, 3, 0)>(vb), h3 = tr_read<v_rd_off(D0, 3, 1)>(vb);
    asm volatile("s_waitcnt lgkmcnt(0)" ::: "memory"); SBAR();
#define PKV(L, H) (bf16x8){L[0], L[1], L[2], L[3], H[0], H[1], H[2], H[3]}
    od = __builtin_amdgcn_mfma_f32_32x32x16_bf16(pa0, PKV(l0, h0), od, 0, 0, 0);
    od = __builtin_amdgcn_mfma_f32_32x32x16_bf16(pa1, PKV(l1, h1), od, 0, 0, 0);
    od = __builtin_amdgcn_mfma_f32_32x32x16_bf16(pa2, PKV(l2, h2), od, 0, 0, 0);
    od = __builtin_amdgcn_mfma_f32_32x32x16_bf16(pa3, PKV(l3, h3), od, 0, 0, 0);
#undef PKV
}
__device__ __forceinline__ void pv_d0(f32x16* o, int vb, bf16x8 pa0, bf16x8 pa1, bf16x8 pa2, bf16x8 pa3) {
    pv_one<0>(o[0], vb, pa0, pa1, pa2, pa3); pv_one<1>(o[1], vb, pa0, pa1, pa2, pa3); pv_one<2>(o[2], vb, pa0, pa1, pa2, pa3); pv_one<3>(o[3], vb, pa0, pa1, pa2, pa3);
}

struct KVSrc { const bf16* k0; int ldk0; const bf16* k1; int ldk1; const bf16* v; int ldv; };

template <int DK, int DK0> struct Stager {
    static constexpr int NK0 = DK0 / 64, NK1 = (DK - DK0) / 64, NKC = NK0 + NK1;
    static constexpr int CPR0 = DK0 / 8, CPR1 = (DK - DK0) / 8 > 0 ? (DK - DK0) / 8 : 1;
    const bf16* kb[NKC]; int kstride[NKC];
    int koff[NKC]; int klds[NKC];
    const bf16* vb; int vstride; int voff0, voff1, vst0, vst1;
    __device__ __forceinline__ void init(const KVSrc& s, int tid) {
#pragma unroll
        for (int i = 0; i < NK0; ++i) { const int c = tid + 512 * i, row = c / CPR0, ch = c % CPR0;
            kb[i] = s.k0; kstride[i] = 64 * s.ldk0; koff[i] = row * s.ldk0 + ch * 8; klds[i] = kswz<DK * 2>(row, ch * 16); }
#pragma unroll
        for (int i = 0; i < NK1; ++i) { const int c = tid + 512 * i, row = c / CPR1, ch = c % CPR1;
            kb[NK0 + i] = s.k1; kstride[NK0 + i] = 64 * s.ldk1; koff[NK0 + i] = row * s.ldk1 + ch * 8; klds[NK0 + i] = kswz<DK * 2>(row, DK0 * 2 + ch * 16); }
        const int sr = tid >> 4, sc = (tid & 15) * 8;
        vb = s.v; vstride = 64 * s.ldv; voff0 = sr * s.ldv + sc; voff1 = (32 + sr) * s.ldv + sc;
        vst0 = v_st(sr, sc); vst1 = v_st(32 + sr, sc);
    }
    __device__ __forceinline__ bf16x8 ldk(int i, int t) const { return *reinterpret_cast<const bf16x8*>(kb[i] + (size_t)t * kstride[i] + koff[i]); }
    __device__ __forceinline__ bf16x8 ldv0(int t) const { return *reinterpret_cast<const bf16x8*>(vb + (size_t)t * vstride + voff0); }
    __device__ __forceinline__ bf16x8 ldv1(int t) const { return *reinterpret_cast<const bf16x8*>(vb + (size_t)t * vstride + voff1); }
};

template <bool F32> __device__ __forceinline__ void store_o_staged(const f32x16 (&o)[4], const float* rl, LAS char* stg, float* Of, bf16* Ob, int ldo, int le) {
    const int r32e = le & 31, hie = le >> 5, rr0 = le >> 4, ch = le & 15;
    if constexpr (!F32) {
        LAS bf16* st = (LAS bf16*)stg;
#pragma unroll
        for (int r = 0; r < 16; ++r) { const int ro = (r & 3) + 8 * (r >> 2) + 4 * hie;
#pragma unroll
            for (int d0 = 0; d0 < 4; ++d0) { const float v = rl ? o[d0][r] * rl[r] : o[d0][r]; st[ro * 128 + d0 * 32 + r32e] = (bf16)(cvt_pk_bf16(v, v) & 0xffffu); } }
#pragma unroll
        for (int i = 0; i < 8; ++i) { const int row = i * 4 + rr0; const u32x4 v = *(const LAS u32x4*)(stg + row * 256 + ch * 16); *(u32x4*)(Ob + (size_t)row * ldo + ch * 8) = v; }
    } else {
        LAS float* st = (LAS float*)stg;
#pragma unroll
        for (int p = 0; p < 2; ++p) {
#pragma unroll
            for (int r = 0; r < 16; ++r) { const int ro = (r & 3) + 8 * (r >> 2) + 4 * hie;
#pragma unroll
                for (int dd = 0; dd < 2; ++dd) { const float v = rl ? o[2 * p + dd][r] * rl[r] : o[2 * p + dd][r]; st[ro * 64 + dd * 32 + r32e] = v; } }
#pragma unroll
            for (int i = 0; i < 8; ++i) { const int row = i * 4 + rr0; const f32x4 v = *(const LAS f32x4*)(stg + row * 256 + ch * 16); *(f32x4*)(Of + (size_t)row * ldo + p * 64 + ch * 4) = v; }
        }
    }
}
typedef short v4i16_t __attribute__((ext_vector_type(4)));
__device__ __forceinline__ s16x4 vtr(const LAS char* p) { return __builtin_bit_cast(s16x4, __builtin_amdgcn_ds_read_tr16_b64_v4i16((LAS v4i16_t*)p)); }
struct DaFin { const float* other; unsigned* cnt; float lam; const float* gsub; float omli; bool own_first; };
struct QPrep { const float* g; const float* rc; const float* rs; };
template <int DK, int DK0, bool BIAS, bool OUTF32, bool NEGM_, bool ILB, bool NOMAX = false, bool QPREP = false>
__device__ __forceinline__ void softmax_unit_v3(LAS char* lds, const bf16* Qb, int ldq, const KVSrc kv, int q0, float* Of, bf16* Ob, int ldo, const int wv, const DaFin fin = DaFin{}, const QPrep qp = QPrep{}) {
    constexpr int RB = DK * 2, NKCH = DK / 64, NQ = DK / 16, NM = 2 * NQ;
    constexpr bool NEGM = NEGM_ && !NOMAX;
    int tid = MYTID(wv); asm volatile("" : "+v"(tid));
    const int lane = tid & 63, r32 = lane & 31, hi = lane >> 5; const int wid = __builtin_amdgcn_readfirstlane(tid >> 6);
    LAS char* V_lds = lds + L_V; LAS char* K_lds = lds + L_K;
    LAS float* ws = (LAS float*)(lds + L_WS) + wid * 64; LAS float* li_l = ws; LAS float* al_l = ws + 32;
    const LAS float* tbl = (const LAS float*)(lds + L_BIAS);
    const bf16* kptr[NKCH]; int kstr[NKCH]; const bf16* vptr[2]; const int vstr = 64 * kv.ldv;
#pragma unroll
    for (int i = 0; i < NKCH; ++i) { const int p = (wid + 8 * i) * 1024 + lane * 16, row = p / RB, within = p - row * RB, blk = within >> 7;
        const int sw = (RB == 256) ? (row & 7) : ((row >> 1) & 7); const int c8 = ((within >> 4) & 7) ^ sw, col = (blk * 8 + c8) * 8;
        if (col < DK0) { kptr[i] = kv.k0 + (size_t)row * kv.ldk0 + col; kstr[i] = 64 * kv.ldk0; }
        else { kptr[i] = kv.k1 + (size_t)row * kv.ldk1 + (col - DK0); kstr[i] = 64 * kv.ldk1; } }
#pragma unroll
    for (int i = 0; i < 2; ++i) { const int p = (wid + 8 * i) * 1024 + lane * 16, sub = p >> 9, within = p & 511;
        const int kk = (sub >> 2) * 8 + (within >> 6), c = (sub & 3) * 32 + ((within & 63) >> 1);
        vptr[i] = kv.v + (size_t)kk * kv.ldv + c; }

#define DMA_TILE(slot) do { \
    _Pragma("unroll") for (int i_ = 0; i_ < NKCH; ++i_) { __builtin_amdgcn_global_load_lds((const unsigned*)kptr[i_], (LAS unsigned*)(K_lds + (slot) * KSLOT + (wid + 8 * i_) * 1024), 16, 0, 0); kptr[i_] += kstr[i_]; } \
    _Pragma("unroll") for (int i_ = 0; i_ < 2; ++i_) { __builtin_amdgcn_global_load_lds((const unsigned*)vptr[i_], (LAS unsigned*)(V_lds + (slot) * SHM_V + (wid + 8 * i_) * 1024), 16, 0, 0); vptr[i_] += vstr; } } while (0)
#define WAIT_BAR() asm volatile("s_waitcnt vmcnt(0) lgkmcnt(0)\n\ts_barrier" ::: "memory")
    DMA_TILE(0); DMA_TILE(1);
    float m_reg, l_reg = 0.f; f32x16 o[4] = {}; bf16x8 qr[NQ];
    const bf16* Qw = Qb + (size_t)(wid * QBLK + r32) * ldq + hi * 32;
#pragma unroll
    for (int d0 = 0; d0 < NQ; ++d0) qr[d0] = *reinterpret_cast<const bf16x8*>(Qw + (d0 >> 2) * 64 + (d0 & 3) * 8);
    if constexpr (QPREP) {
        static_assert(!QPREP || DK == 192, "QPREP: MLA head layout");
        float ssn = 0.f, ssp = 0.f;
#pragma unroll
        for (int d0 = 0; d0 < 12; ++d0)
#pragma unroll
            for (int e = 0; e < 8; ++e) { const float x = bf1((bf16)qr[d0][e]); if (d0 < 8) ssn += x * x; else ssp += x * x; }
        const float rn = rsq(half_sum(ssn) * (1.f / 128.f) + EPS) * SC_MLA, rp = rsq(half_sum(ssp) * (1.f / 64.f) + EPS) * SC_MLA;
        const int prow = q0 + wid * QBLK + r32;
#pragma unroll
        for (int d0 = 0; d0 < 12; ++d0) { const int col = (d0 >> 2) * 64 + hi * 32 + (d0 & 3) * 8;
            const f32x4 ga = *(const f32x4*)(qp.g + col), gb = *(const f32x4*)(qp.g + col + 4);
            float y[8];
#pragma unroll
            for (int e = 0; e < 8; ++e) y[e] = bf1((bf16)qr[d0][e]) * (d0 < 8 ? rn : rp) * (e < 4 ? ga[e] : gb[e - 4]);
            if (d0 >= 8) { const int i0 = (d0 & 3) * 8;
                const f32x4 ca = *(const f32x4*)(qp.rc + (size_t)prow * 32 + i0), cb = *(const f32x4*)(qp.rc + (size_t)prow * 32 + i0 + 4);
                const f32x4 sa = *(const f32x4*)(qp.rs + (size_t)prow * 32 + i0), sb = *(const f32x4*)(qp.rs + (size_t)prow * 32 + i0 + 4);
#pragma unroll
                for (int e = 0; e < 8; ++e) { auto rr = __builtin_amdgcn_permlane32_swap(__float_as_uint(y[e]), __float_as_uint(y[e]), false, false);
                    const float yp = __uint_as_float(hi ? rr[0] : rr[1]); const float c = e < 4 ? ca[e] : cb[e - 4], sn = e < 4 ? sa[e] : sb[e - 4];
                    y[e] = hi ? (yp * sn + y[e] * c) : (y[e] * c - yp * sn); } }
            u32x4 w; w.x = cvt_pk_bf16(y[0], y[1]); w.y = cvt_pk_bf16(y[2], y[3]); w.z = cvt_pk_bf16(y[4], y[5]); w.w = cvt_pk_bf16(y[6], y[7]);
            qr[d0] = __builtin_bit_cast(bf16x8, w); }
    }
    const LAS char* vrd = V_lds + v_rd_base(lane);
    const LAS char* krd[4];
#pragma unroll
    for (int j = 0; j < 4; ++j) krd[j] = K_lds + kaddr<RB>(r32, 0, 4 * hi + j);
    const int NT = q0 / KVBLK + 4;
    const int cw = q0 / KVBLK + (wid >> 1);
    const int tq = q0 + wid * QBLK + r32 + 64 - 4 * hi;
#define POST(P0, P1, jj) do { if ((jj) > cw) { float ni_ = -1e30f; asm volatile("" : "+v"(ni_));     \
        _Pragma("unroll") for (int r = 0; r < 16; ++r) { P0[r] = ni_; P1[r] = ni_; } } \
    else if (BIAS && (jj) >= cw - 2) { const int tb_ = tq - 64 * (jj); \
        _Pragma("unroll") for (int r = 0; r < 16; ++r) { const int kk_ = (r & 3) + 8 * (r >> 2); P0[r] += tbl[tb_ - kk_]; P1[r] += tbl[tb_ - kk_ - 32]; } } } while (0)
#define ROWMAX(P0, P1) ({ float a_ = fmaxf(fmaxf(P0[0], P0[1]), P1[0]), b_ = fmaxf(fmaxf(P0[2], P0[3]), P1[1]); a_ = fmaxf(fmaxf(a_, P1[2]), P1[3]); \
    _Pragma("unroll") for (int r = 4; r < 16; r += 4) { a_ = fmaxf(fmaxf(a_, P0[r]), P0[r + 1]); b_ = fmaxf(fmaxf(b_, P0[r + 2]), P0[r + 3]); a_ = fmaxf(fmaxf(a_, P1[r]), P1[r + 1]); b_ = fmaxf(fmaxf(b_, P1[r + 2]), P1[r + 3]); } \
    float m_ = fmaxf(a_, b_); auto rr_ = __builtin_amdgcn_permlane32_swap(__float_as_uint(m_), __float_as_uint(m_), false, false); fmaxf(__uint_as_float(rr_[0]), __uint_as_float(rr_[1])); })
    f32x16 pA0, pA1, pB0, pB1; u32x4 pw[4];
    WAIT_BAR();
    { pA0 = f32x16{}; pA1 = f32x16{};
#pragma unroll
      for (int d0 = 0; d0 < NQ; ++d0) { const bf16x8 b0 = *(const LAS bf16x8*)(krd[d0 & 3] + (d0 >> 2) * 128), b1 = *(const LAS bf16x8*)(krd[d0 & 3] + (d0 >> 2) * 128 + 32 * RB);
          pA0 = __builtin_amdgcn_mfma_f32_32x32x16_bf16(b0, qr[d0], pA0, 0, 0, 0); pA1 = __builtin_amdgcn_mfma_f32_32x32x16_bf16(b1, qr[d0], pA1, 0, 0, 0); }
      POST(pA0, pA1, 0);
      if constexpr (NOMAX) m_reg = 0.f; else m_reg = ROWMAX(pA0, pA1);
#pragma unroll
      for (int r = 0; r < 16; ++r) { pA0[r] = __builtin_amdgcn_exp2f(NOMAX ? pA0[r] : pA0[r] - m_reg); pA1[r] = __builtin_amdgcn_exp2f(NOMAX ? pA1[r] : pA1[r] - m_reg); } }
    f32x16 negm;
    if constexpr (NEGM) {
#pragma unroll
        for (int r = 0; r < 16; ++r) negm[r] = -m_reg;
        asm volatile("" : "+v"(negm)); }
    int s_prev = 0, s_cur = 1, s_next = 2;
#define ROT() do { const int t_ = s_prev; s_prev = s_cur; s_cur = s_next; s_next = t_; } while (0)
    unsigned ta0, ta1;
#define SLICE(Y0, Y1, s_) do { constexpr int g_ = (s_) >> 1, bs_ = (g_ & 1) * 8 + ((s_) & 1) * 4; \
        const float y0_ = (g_ < 2) ? Y0[bs_] : Y1[bs_], y1_ = (g_ < 2) ? Y0[bs_ + 1] : Y1[bs_ + 1], y2_ = (g_ < 2) ? Y0[bs_ + 2] : Y1[bs_ + 2], y3_ = (g_ < 2) ? Y0[bs_ + 3] : Y1[bs_ + 3]; \
        sacc0 += y0_; sacc1 += y1_; sacc0 += y2_; sacc1 += y3_; \
        if (((s_) & 1) == 0) { ta0 = cvt_pk_bf16(y0_, y1_); ta1 = cvt_pk_bf16(y2_, y3_); } \
        else { const unsigned tb0_ = cvt_pk_bf16(y0_, y1_), tb1_ = cvt_pk_bf16(y2_, y3_); \
               pw[g_] = (u32x4){ta0, ta1, tb0_, tb1_}; } } while (0)
#define PIN(x) asm volatile("" : "+v"(x))
#define KFRAG(i_) (*(const LAS bf16x8*)(krd[((i_) >> 1) & 3] + kso_ + ((i_) >> 3) * 128 + ((i_) & 1) * 32 * RB))
#define VLO(i_) vtr(vb_ + v_rd_off((i_) & 3, (i_) >> 2, 0))
#define VHI(i_) vtr(vb_ + v_rd_off((i_) & 3, (i_) >> 2, 1))
#define EXPX(XV, e_) XV[e_] = __builtin_amdgcn_exp2f((NEGM || NOMAX) ? XV[e_] : XV[e_] - m_reg)
#define PVX(D0, XV, B_, vba) do { \
        const s16x4 l0_ = tr_read<v_rd_off(D0, 0, 0)>(vba), h0_ = tr_read<v_rd_off(D0, 0, 1)>(vba), l1_ = tr_read<v_rd_off(D0, 1, 0)>(vba), h1_ = tr_read<v_rd_off(D0, 1, 1)>(vba); \
        const s16x4 l2_ = tr_read<v_rd_off(D0, 2, 0)>(vba), h2_ = tr_read<v_rd_off(D0, 2, 1)>(vba), l3_ = tr_read<v_rd_off(D0, 3, 0)>(vba), h3_ = tr_read<v_rd_off(D0, 3, 1)>(vba); \
        asm volatile("s_waitcnt lgkmcnt(0)" ::: "memory"); SBAR(); \
        o[D0] = __builtin_amdgcn_mfma_f32_32x32x16_bf16(__builtin_bit_cast(bf16x8, pw[0]), (bf16x8){l0_[0], l0_[1], l0_[2], l0_[3], h0_[0], h0_[1], h0_[2], h0_[3]}, o[D0], 0, 0, 0); EXPX(XV, B_ + 0); EXPX(XV, B_ + 1); PIN(XV); SBAR(); \
        o[D0] = __builtin_amdgcn_mfma_f32_32x32x16_bf16(__builtin_bit_cast(bf16x8, pw[1]), (bf16x8){l1_[0], l1_[1], l1_[2], l1_[3], h1_[0], h1_[1], h1_[2], h1_[3]}, o[D0], 0, 0, 0); EXPX(XV, B_ + 2); EXPX(XV, B_ + 3); PIN(XV); SBAR(); \
        o[D0] = __builtin_amdgcn_mfma_f32_32x32x16_bf16(__builtin_bit_cast(bf16x8, pw[2]), (bf16x8){l2_[0], l2_[1], l2_[2], l2_[3], h2_[0], h2_[1], h2_[2], h2_[3]}, o[D0], 0, 0, 0); EXPX(XV, B_ + 4); EXPX(XV, B_ + 5); PIN(XV); SBAR(); \
        o[D0] = __builtin_amdgcn_mfma_f32_32x32x16_bf16(__builtin_bit_cast(bf16x8, pw[3]), (bf16x8){l3_[0], l3_[1], l3_[2], l3_[3], h3_[0], h3_[1], h3_[2], h3_[3]}, o[D0], 0, 0, 0); EXPX(XV, B_ + 6); EXPX(XV, B_ + 7); PIN(XV); SBAR(); } while (0)
#define TRF(i_, vba) do { tl_[i_] = tr_read<v_rd_off((i_) >> 2, (i_) & 3, 0)>(vba); th_[i_] = tr_read<v_rd_off((i_) >> 2, (i_) & 3, 1)>(vba); } while (0)
#define PVM(i_, XV, B_, vba) do { \
        if ((i_) + 2 < 16) { TRF(((i_) + 2 < 16 ? (i_) + 2 : 15), vba); asm volatile("s_waitcnt lgkmcnt(4)" ::: "memory"); } \
        else if ((i_) + 1 < 16) asm volatile("s_waitcnt lgkmcnt(2)" ::: "memory"); else asm volatile("s_waitcnt lgkmcnt(0)" ::: "memory"); \
        SBAR(); \
        o[(i_) >> 2] = __builtin_amdgcn_mfma_f32_32x32x16_bf16(__builtin_bit_cast(bf16x8, pw[(i_) & 3]), (bf16x8){tl_[i_][0], tl_[i_][1], tl_[i_][2], tl_[i_][3], th_[i_][0], th_[i_][1], th_[i_][2], th_[i_][3]}, o[(i_) >> 2], 0, 0, 0); \
        EXPX(XV, B_); EXPX(XV, B_ + 1); PIN(XV); SBAR(); } while (0)
#define STEP(X0, X1, Y0, Y1, jj, HASNEXT) do { \
        const int kso_ = s_cur * KSLOT; const LAS char* vb_ = vrd + s_prev * SHM_V; \
        float sacc0 = 0.f, sacc1 = 0.f; \
        bf16x8 kf_[NM]; s16x4 vl_[16], vh_[16]; \
        SBAR(); \
        kf_[0] = KFRAG(0); kf_[1] = KFRAG(1); kf_[2] = KFRAG(2); SBAR(); \
          \
        _Pragma("unroll") for (int i_ = 0; i_ < NM; ++i_) { const int d0_ = i_ >> 1; \
            if (i_ + 3 < NM) kf_[i_ + 3] = KFRAG(i_ + 3); \
            if ((i_ & 1) == 0) X0 = __builtin_amdgcn_mfma_f32_32x32x16_bf16(kf_[i_], qr[d0_], (d0_ == 0) ? (NEGM ? negm : f32x16{}) : X0, 0, 0, 0); \
            else               X1 = __builtin_amdgcn_mfma_f32_32x32x16_bf16(kf_[i_], qr[d0_], (d0_ == 0) ? (NEGM ? negm : f32x16{}) : X1, 0, 0, 0); \
            if ((0 * NM) / 8 == i_) SLICE(Y0, Y1, 0); if ((1 * NM) / 8 == i_) SLICE(Y0, Y1, 1); if ((2 * NM) / 8 == i_) SLICE(Y0, Y1, 2); if ((3 * NM) / 8 == i_) SLICE(Y0, Y1, 3); \
            if ((4 * NM) / 8 == i_) SLICE(Y0, Y1, 4); if ((5 * NM) / 8 == i_) SLICE(Y0, Y1, 5); if ((6 * NM) / 8 == i_) SLICE(Y0, Y1, 6); if ((7 * NM) / 8 == i_) SLICE(Y0, Y1, 7); \
            PIN(sacc0); PIN(sacc1); SBAR(); } \
        l_reg += sacc0 + sacc1; \
        POST(X0, X1, jj); \
          \
        bool resc_ = false; \
        if constexpr (!NOMAX) { const float rm_ = ROWMAX(X0, X1); \
          if constexpr (NEGM) {              \
            if (__builtin_expect(__any(rm_ > THR), 0)) { const float dl_ = fmaxf(rm_, 0.f); const float al_ = __builtin_amdgcn_exp2f(-dl_); m_reg += dl_; l_reg *= al_; \
                _Pragma("unroll") for (int r = 0; r < 16; ++r) { X0[r] -= dl_; X1[r] -= dl_; negm[r] = -m_reg; } \
                { const int l2_ = lane_id(); if ((l2_ >> 5) == 0) al_l[l2_ & 31] = al_; } resc_ = true; } \
          } else { \
            if (__builtin_expect(__any(rm_ - m_reg > THR), 0)) { const float mn_ = fmaxf(m_reg, rm_); const float al_ = __builtin_amdgcn_exp2f(m_reg - mn_); m_reg = mn_; l_reg *= al_; \
                { const int l2_ = lane_id(); if ((l2_ >> 5) == 0) al_l[l2_ & 31] = al_; } resc_ = true; } } } \
        if (HASNEXT) DMA_TILE(s_next);     \
        PIN(X0); PIN(X1); SBAR(); \
        if constexpr (ILB) { \
        vl_[0] = VLO(0); vh_[0] = VHI(0); vl_[1] = VLO(1); vh_[1] = VHI(1); vl_[2] = VLO(2); vh_[2] = VHI(2); SBAR(); \
          \
        _Pragma("unroll") for (int i_ = 0; i_ < 16; ++i_) { const int ks_ = i_ >> 2, d0_ = i_ & 3; \
            if (i_ + 3 < 16) { vl_[i_ + 3] = VLO(i_ + 3); vh_[i_ + 3] = VHI(i_ + 3); } \
            const bf16x8 vf_ = (bf16x8){vl_[i_][0], vl_[i_][1], vl_[i_][2], vl_[i_][3], vh_[i_][0], vh_[i_][1], vh_[i_][2], vh_[i_][3]}; \
            o[d0_] = __builtin_amdgcn_mfma_f32_32x32x16_bf16(__builtin_bit_cast(bf16x8, pw[ks_]), vf_, o[d0_], 0, 0, 0); \
            if (i_ < 8) { X0[2 * i_] = __builtin_amdgcn_exp2f(NEGM ? X0[2 * i_] : X0[2 * i_] - m_reg); X0[2 * i_ + 1] = __builtin_amdgcn_exp2f(NEGM ? X0[2 * i_ + 1] : X0[2 * i_ + 1] - m_reg); PIN(X0); } \
            else { X1[2 * i_ - 16] = __builtin_amdgcn_exp2f(NEGM ? X1[2 * i_ - 16] : X1[2 * i_ - 16] - m_reg); X1[2 * i_ - 15] = __builtin_amdgcn_exp2f(NEGM ? X1[2 * i_ - 15] : X1[2 * i_ - 15] - m_reg); PIN(X1); } \
            SBAR(); } \
        } else { \
        const int vba_ = (int)(unsigned)(uintptr_t)vrd + s_prev * SHM_V; \
        s16x4 tl_[16], th_[16]; \
        TRF(0, vba_); TRF(1, vba_); \
        PVM(0, X0, 0, vba_); PVM(1, X0, 2, vba_); PVM(2, X0, 4, vba_); PVM(3, X0, 6, vba_); PVM(4, X0, 8, vba_); PVM(5, X0, 10, vba_); PVM(6, X0, 12, vba_); PVM(7, X0, 14, vba_); \
        PVM(8, X1, 0, vba_); PVM(9, X1, 2, vba_); PVM(10, X1, 4, vba_); PVM(11, X1, 6, vba_); PVM(12, X1, 8, vba_); PVM(13, X1, 10, vba_); PVM(14, X1, 12, vba_); PVM(15, X1, 14, vba_); } \
        if (resc_) { asm volatile("s_waitcnt lgkmcnt(0)" ::: "memory"); \
            const int h2_ = lane_id() >> 5;     \
            _Pragma("unroll") for (int d = 0; d < 4; ++d) _Pragma("unroll") for (int r = 0; r < 16; ++r) o[d][r] *= al_l[crow(r, h2_)]; } \
        WAIT_BAR(); ROT(); } while (0)
    for (int j = 1; j + 1 < NT; j += 2) {
        STEP(pB0, pB1, pA0, pA1, j, true);
        STEP(pA0, pA1, pB0, pB1, j + 1, true);
    }
    STEP(pB0, pB1, pA0, pA1, NT - 1, false);
    { float sacc0 = 0.f, sacc1 = 0.f;
      SLICE(pB0, pB1, 0); SLICE(pB0, pB1, 1); SLICE(pB0, pB1, 2); SLICE(pB0, pB1, 3); SLICE(pB0, pB1, 4); SLICE(pB0, pB1, 5); SLICE(pB0, pB1, 6); SLICE(pB0, pB1, 7);
      l_reg += sacc0 + sacc1;
      const LAS char* vb_ = vrd + s_prev * SHM_V;
#pragma unroll
      for (int i_ = 0; i_ < 16; ++i_) { const int ks_ = i_ >> 2, d0_ = i_ & 3;
          const s16x4 vl_ = vtr(vb_ + v_rd_off(d0_, ks_, 0)), vh_ = vtr(vb_ + v_rd_off(d0_, ks_, 1));
          const bf16x8 vf_ = (bf16x8){vl_[0], vl_[1], vl_[2], vl_[3], vh_[0], vh_[1], vh_[2], vh_[3]};
          o[d0_] = __builtin_amdgcn_mfma_f32_32x32x16_bf16(__builtin_bit_cast(bf16x8, pw[ks_]), vf_, o[d0_], 0, 0, 0); } }
    l_reg = half_sum(l_reg);
    if (hi == 0) li_l[r32] = l_reg; asm volatile("s_waitcnt lgkmcnt(0)" ::: "memory");
    { const int le = lane_id(), hie = le >> 5;
      float rl[16];
#pragma unroll
      for (int r = 0; r < 16; ++r) rl[r] = __builtin_amdgcn_rcpf(li_l[(r & 3) + 8 * (r >> 2) + 4 * hie]);
      if constexpr (!OUTF32) store_o_staged<false>(o, rl, K_lds + wid * 8192, nullptr, Ob + (size_t)(wid * QBLK) * ldo, ldo, le);
      else {
#pragma unroll
        for (int d0 = 0; d0 < 4; ++d0)
#pragma unroll
            for (int r = 0; r < 16; ++r) o[d0][r] *= rl[r];
        float* so = Of + (size_t)wid * 4096 + le * 4;
#pragma unroll
        for (int d0 = 0; d0 < 4; ++d0)
#pragma unroll
            for (int rq = 0; rq < 4; ++rq) { const f32x4 sv_ = (f32x4){o[d0][4 * rq], o[d0][4 * rq + 1], o[d0][4 * rq + 2], o[d0][4 * rq + 3]}; const float* sp_ = so + (4 * d0 + rq) * 256;
                asm volatile("global_store_dwordx4 %0, %1, off sc1" :: "v"(sp_), "v"(sv_) : "memory"); }
        volatile LAS unsigned* flg = (volatile LAS unsigned*)(lds + L_FLAG);
        asm volatile("s_waitcnt vmcnt(0)" ::: "memory");
        __syncthreads();
        if (wid == 0 && le == 0) {
            const unsigned old = __hip_atomic_fetch_add(fin.cnt, 1u, __ATOMIC_RELAXED, __HIP_MEMORY_SCOPE_AGENT);
            if (old & 1u) __builtin_amdgcn_fence(__ATOMIC_ACQUIRE, "agent");
            flg[8] = old & 1u; }
        __syncthreads();
        if (flg[8]) {
            const float* po = fin.other + (size_t)wid * 4096 + le * 4;
            f32x4 pv[4][4];
#pragma unroll
            for (int d0 = 0; d0 < 4; ++d0)
#pragma unroll
                for (int rq = 0; rq < 4; ++rq) pv[d0][rq] = *(const f32x4*)(po + (4 * d0 + rq) * 256);
            float gs[4];
#pragma unroll
            for (int d0 = 0; d0 < 4; ++d0) gs[d0] = fin.gsub[32 * d0 + (le & 31)] * fin.omli;
#pragma unroll
            for (int r = 0; r < 16; ++r) { float ss = 0.f;
#pragma unroll
                for (int d0 = 0; d0 < 4; ++d0) { const float pp = pv[d0][r >> 2][r & 3]; const float dv = fin.own_first ? o[d0][r] - fin.lam * pp : pp - fin.lam * o[d0][r]; o[d0][r] = dv; ss += dv * dv; }
                ss += swz<1>(ss); ss += swz<2>(ss); ss += swz<4>(ss); ss += swz<8>(ss); ss += swz<16>(ss);
                const float rn = rsq(ss * (1.f / 128.f) + EPS);
#pragma unroll
                for (int d0 = 0; d0 < 4; ++d0) o[d0][r] = o[d0][r] * rn * gs[d0]; }
            store_o_staged<false>(o, nullptr, K_lds + wid * 8192, nullptr, Ob + (size_t)(wid * QBLK) * ldo, ldo, le);
        }
      } }
    asm volatile("s_waitcnt lgkmcnt(0)\n\ts_barrier" ::: "memory");
#undef DMA_TILE
#undef WAIT_BAR
#undef POST
#undef ROWMAX
#undef ROT
#undef SLICE
#undef STEP
#undef PVX
#undef PVM
#undef TRF
#undef EXPX
#undef PIN
#undef KFRAG
#undef VLO
#undef VHI
}

__device__ __forceinline__ void sb_unit(LAS char* lds, const bf16* Qb, int ldq, const KVSrc kv, int q0, bf16* Ob, int ldo, const int wv) {
    constexpr int DK = 128, SHM_K = 64 * DK * 2;
    int tid = MYTID(wv); asm volatile("" : "+v"(tid));
    const int lane = tid & 63, r32 = lane & 31, hi = lane >> 5; const int wid = __builtin_amdgcn_readfirstlane(tid >> 6);
    LAS char* V_lds = lds + L_V; LAS char* K_lds = lds + L_K;
    volatile LAS unsigned* flags = (volatile LAS unsigned*)(lds + L_FLAG);
    f32x16 o[4] = {}; bf16x8 qr[8];
    const bf16* Qw = Qb + (size_t)(wid * QBLK + r32) * ldq + hi * 32;
#pragma unroll
    for (int d0 = 0; d0 < 8; ++d0) qr[d0] = *reinterpret_cast<const bf16x8*>(Qw + (d0 >> 2) * 64 + (d0 & 3) * 8);
    Stager<128, 128> st; st.init(kv, tid);
    const int vb0 = (int)(unsigned)(uintptr_t)V_lds + v_rd_base(lane);
    const int cw = q0 / KVBLK + (wid >> 1);
    const int lim = 32 * (wid & 1) + r32;
    float R = 0.f; bool alive = true;
    bf16x8 vs0, vs1, ks0, ks1;
    int j = q0 / KVBLK + 3;
    vs0 = st.ldv0(j); vs1 = st.ldv1(j); ks0 = st.ldk(0, j); ks1 = st.ldk(1, j);
    for (; j >= 0; --j) {
        __syncthreads();
        *(LAS bf16x8*)(V_lds + st.vst0) = vs0; *(LAS bf16x8*)(V_lds + st.vst1) = vs1; *(LAS bf16x8*)(K_lds + st.klds[0]) = ks0; *(LAS bf16x8*)(K_lds + st.klds[1]) = ks1;
        __syncthreads();
        if (j > 0) { const int jn = j - 1;
            vs0 = st.ldv0(jn); vs1 = st.ldv1(jn); ks0 = st.ldk(0, jn); ks1 = st.ldk(1, jn); }
        if (j <= cw && alive) {
            f32x16 z0, z1, m0, m1;
            qkt<128, 8>(z0, z1, K_lds, qr, K_lds, r32, hi);
#pragma unroll
            for (int r = 0; r < 16; ++r) { z0[r] *= SC_SB; z1[r] *= SC_SB; }
            const bool diag = (j == cw);
#pragma unroll
            for (int r = 0; r < 16; ++r) {
                { const float zl = z0[r], e = __builtin_amdgcn_exp2f(-fabsf(zl)); const float l1p = (e < 2.44140625e-4f) ? e * LOG2E * (1.f - 0.5f * e) : __builtin_amdgcn_logf(1.f + e);
                  m0[r] = -(fmaxf(zl, 0.f) + l1p); }
                { const float zl = z1[r], e = __builtin_amdgcn_exp2f(-fabsf(zl)); const float l1p = (e < 2.44140625e-4f) ? e * LOG2E * (1.f - 0.5f * e) : __builtin_amdgcn_logf(1.f + e);
                  m1[r] = -(fmaxf(zl, 0.f) + l1p); }
            }
            if (diag) {
#pragma unroll
                for (int r = 0; r < 16; ++r) { const int kk = crow(r, hi);
                    if (!(kk < lim)) { m0[r] = 0.f; z0[r] = -1e30f; }
                    if (!(kk + 32 < lim)) { m1[r] = 0.f; z1[r] = -1e30f; } }
            }
            float Glo[8], Ghi[8];
#pragma unroll
            for (int i = 0; i < 8; ++i) { const float gs = (i < 4) ? (m0[4 * i] + m0[4 * i + 1]) + (m0[4 * i + 2] + m0[4 * i + 3])
                                                                   : (m1[4 * (i - 4)] + m1[4 * (i - 4) + 1]) + (m1[4 * (i - 4) + 2] + m1[4 * (i - 4) + 3]);
                auto rr = __builtin_amdgcn_permlane32_swap(__float_as_uint(gs), __float_as_uint(gs), false, false);
                Glo[i] = __uint_as_float(rr[0]); Ghi[i] = __uint_as_float(rr[1]); }
            float sa_odd = 0.f, sa_even = Ghi[7]; float base[8];
            base[7] = R + (hi ? sa_odd : sa_even);
#pragma unroll
            for (int i = 6; i >= 0; --i) { sa_odd = sa_even + Glo[i + 1]; sa_even = sa_odd + Ghi[i]; base[i] = R + (hi ? sa_odd : sa_even); }
            const float total = sa_even + Glo[0];
#pragma unroll
            for (int i = 0; i < 8; ++i) {
                if (i < 4) { const int b = 4 * i; float bt = base[i];
                    const float w3 = __builtin_amdgcn_exp2f(z0[b + 3] + m0[b + 3] + bt); bt += m0[b + 3];
                    const float w2 = __builtin_amdgcn_exp2f(z0[b + 2] + m0[b + 2] + bt); bt += m0[b + 2];
                    const float w1 = __builtin_amdgcn_exp2f(z0[b + 1] + m0[b + 1] + bt); bt += m0[b + 1];
                    const float w0 = __builtin_amdgcn_exp2f(z0[b] + m0[b] + bt);
                    z0[b] = w0; z0[b + 1] = w1; z0[b + 2] = w2; z0[b + 3] = w3; }
                else { const int b = 4 * (i - 4); float bt = base[i];
                    const float w3 = __builtin_amdgcn_exp2f(z1[b + 3] + m1[b + 3] + bt); bt += m1[b + 3];
                    const float w2 = __builtin_amdgcn_exp2f(z1[b + 2] + m1[b + 2] + bt); bt += m1[b + 2];
                    const float w1 = __builtin_amdgcn_exp2f(z1[b + 1] + m1[b + 1] + bt); bt += m1[b + 1];
                    const float w0 = __builtin_amdgcn_exp2f(z1[b] + m1[b] + bt);
                    z1[b] = w0; z1[b + 1] = w1; z1[b + 2] = w2; z1[b + 3] = w3; }
            }
            R += total;
            bf16x8 pa0, pa1, pa2, pa3;
            PK4(z0, 0, pa0); PK4(z0, 8, pa1); PK4(z1, 0, pa2); PK4(z1, 8, pa3);
            SBAR();
            pv_d0(o, vb0, pa0, pa1, pa2, pa3);
            alive = __any(R > SB_DEAD);
        }
        if (lane == 0) flags[wid] = alive ? 1u : 0u;
        __syncthreads();
        unsigned any_alive = 0;
#pragma unroll
        for (int w = 0; w < NW; ++w) any_alive |= flags[w];
        if (!any_alive) break;
    }
    { const int le = lane_id(); store_o_staged<false>(o, nullptr, K_lds + wid * 8192, nullptr, Ob + (size_t)(wid * QBLK) * ldo, ldo, le); }
    __syncthreads();
}
#undef PK4
#undef SBAR
}

typedef GAS unsigned gu32;
#define RLX_AGENT __ATOMIC_RELAXED, __HIP_MEMORY_SCOPE_AGENT
#define XB_TMO      128
#define XB_XCNT(j)  (256  + 64 * (j))
#define XB_XSUB(j)  (1280 + 64 * (j))
#define XB_XGEN(j)  (2304 + 64 * (j))
#define XB_TOP      3328
#define XB_TOPGEN   3392
#define XCD_BAR_WORDS 3456
#define XB_SPIN_CAP (1u << 18)
__device__ __forceinline__ unsigned xb_ld(unsigned* p)              { return __hip_atomic_load(p, __ATOMIC_RELAXED, __HIP_MEMORY_SCOPE_AGENT); }
__device__ __forceinline__ unsigned xb_add(unsigned* p, unsigned v) { return __hip_atomic_fetch_add(p, v, __ATOMIC_RELAXED, __HIP_MEMORY_SCOPE_AGENT); }
__device__ __forceinline__ unsigned xb_xcc_id() { return (unsigned)__builtin_amdgcn_s_getreg((3 << 11) | 20) & 0xFu; }
#define XB_SPIN(cond, bar) do { unsigned _sp = 0; while (cond) { __builtin_amdgcn_s_sleep(1); \
    if ((++_sp & 255u) == 0u) { if (xb_ld(&(bar)[XB_TMO])) break; if (_sp > XB_SPIN_CAP) { atomicAdd(&(bar)[XB_TMO], 1u); break; } } } } while (0)
struct XcdBarrier { unsigned* bar; unsigned x; volatile LAS unsigned* st; };
__device__ __forceinline__ XcdBarrier xcd_barrier_post(unsigned* bar, volatile LAS unsigned* st, const int wv) {
    XcdBarrier b; b.bar = bar; b.x = xb_xcc_id(); b.st = st;
    if (MYTID(wv) == 0) (void)xb_add(&bar[XB_XCNT(b.x)], 1u);
    return b;
}
__device__ __forceinline__ void xcd_barrier_complete(unsigned* bar, unsigned x, unsigned& nloc, unsigned& nx) {
    const unsigned G = gridDim.x * gridDim.y * gridDim.z;
    unsigned sum, cnt, mine, sp = 0u;
    for (;;) {
        sum = 0u; cnt = 0u; mine = 0u;
#pragma unroll
        for (unsigned j = 0; j < 16; ++j) { const unsigned c = xb_ld(&bar[XB_XCNT(j)]); sum += c; cnt += (c > 0u) ? 1u : 0u; mine = (j == x) ? c : mine; }
        if (sum == G) break;
        __builtin_amdgcn_s_sleep(1);
        if ((++sp & 255u) == 0u) { if (xb_ld(&bar[XB_TMO])) break; if (sp > XB_SPIN_CAP) { atomicAdd(&bar[XB_TMO], 1u); break; } }
    }
    nloc = mine > 0u ? mine : 1u; nx = cnt > 0u ? cnt : 1u;
}
__device__ __forceinline__ void xcd_barrier(const XcdBarrier& b, const int wv) {
    asm volatile("s_waitcnt vmcnt(0)" ::: "memory");
    __syncthreads();
    if (MYTID(wv) == 0) {
        GAS unsigned* barg_ = (GAS unsigned*)b.bar; asm volatile("" : "+s"(barg_)); unsigned* bar = (unsigned*)barg_; unsigned bx_ = b.x; asm volatile("" : "+s"(bx_));
        __builtin_amdgcn_s_waitcnt(0);
        unsigned nloc = b.st[0], nx = b.st[1];
        if (nloc == 0u) { xcd_barrier_complete(bar, bx_, nloc, nx); b.st[0] = nloc; b.st[1] = nx; }
        const unsigned old = xb_add(&bar[XB_XSUB(bx_)], 1u);
        const unsigned gen = old / nloc;
        if (old + 1u == (gen + 1u) * nloc) {
            __builtin_amdgcn_fence(__ATOMIC_RELEASE, "agent");
            asm volatile("s_waitcnt vmcnt(0)" ::: "memory");
            const unsigned og = xb_add(&bar[XB_TOP], 1u);
            const unsigned tg = og / nx;
            if (og + 1u == (tg + 1u) * nx) xb_add(&bar[XB_TOPGEN], 1u);
            else XB_SPIN(xb_ld(&bar[XB_TOPGEN]) == tg, bar);
            __builtin_amdgcn_fence(__ATOMIC_ACQUIRE, "agent");
            xb_add(&bar[XB_XGEN(bx_)], 1u);
            asm volatile("s_waitcnt vmcnt(0)" ::: "memory");
        } else {
            XB_SPIN(xb_ld(&bar[XB_XGEN(bx_)]) == gen, bar);
            __builtin_amdgcn_fence(__ATOMIC_ACQUIRE, "agent");
            asm volatile("s_waitcnt vmcnt(0)" ::: "memory");
        }
    }
    __syncthreads();
}

struct Args { const float* in[20]; float* out; unsigned char* ws; int ph_lo, ph_hi, dup, pad; };
enum { I_X = 0, I_C, I_WADA, I_BADA, I_GMIX, I_GMLP, I_WIN, I_DQKG, I_DLAM, I_DSUB, I_T5, I_MQG, I_MKVG, I_WQUP, I_WKVUP, I_MQKG, I_WBR, I_WOUT, I_WM1, I_WM2 };
constexpr int NWAVES = 8, NTHR = 512;
constexpr int PH_PER_LAYER = 12, NPHASE = 1 + DEPTH * PH_PER_LAYER;

struct ConvDesc { const float* src; int N; bf16* dst; int ldk; const float* gk; const float* sk; };
__device__ __forceinline__ ConvDesc conv_make(const float* W, int K, int N, bf16* WT, int row_off, int item, int lane, int ldk, const float* g = nullptr, const float* sc = nullptr) {
    const int nblk = N / 32, kb = item / nblk, nb = item % nblk, k0 = 64 * kb, n0 = 32 * nb;
    ConvDesc d; d.src = W + (size_t)(k0 + (lane >> 3)) * N + n0 + 4 * (lane & 7); d.N = N; d.dst = WT + (size_t)(row_off + n0) * ldk + k0; d.ldk = ldk;
    d.gk = g ? g + k0 : nullptr; d.sk = sc ? sc + k0 : nullptr; return d;
}
__device__ __forceinline__ void conv_load(const ConvDesc& d, f32x4 (&v)[8]) {
#pragma unroll
    for (int i = 0; i < 8; ++i) v[i] = __builtin_nontemporal_load((const f32x4*)(d.src + (size_t)(8 * i) * d.N));
}
__device__ __forceinline__ void conv_finish(const ConvDesc& d, const f32x4 (&v)[8], LAS float* scr, int lane, const float* shk = nullptr, float* bacc = nullptr) {
#pragma unroll
    for (int i = 0; i < 8; ++i) { LAS float* p = scr + (8 * i + (lane >> 3)) * 33 + 4 * (lane & 7); p[0] = v[i].x; p[1] = v[i].y; p[2] = v[i].z; p[3] = v[i].w; }
    asm volatile("s_waitcnt lgkmcnt(0)" ::: "memory");
    const int c = lane & 7;
    float gm[8] = {1.f, 1.f, 1.f, 1.f, 1.f, 1.f, 1.f, 1.f};
    if (d.gk) { const f32x4 g0 = *(const f32x4*)(d.gk + 8 * c), g1 = *(const f32x4*)(d.gk + 8 * c + 4); f32x4 s0 = {0.f, 0.f, 0.f, 0.f}, s1 = {0.f, 0.f, 0.f, 0.f};
        if (d.sk) { s0 = *(const f32x4*)(d.sk + 8 * c); s1 = *(const f32x4*)(d.sk + 8 * c + 4); }
#pragma unroll
        for (int e = 0; e < 4; ++e) { gm[e] = g0[e] * (1.f + s0[e]); gm[4 + e] = g1[e] * (1.f + s1[e]); } }
    float sh8[8] = {0.f, 0.f, 0.f, 0.f, 0.f, 0.f, 0.f, 0.f};
    if (bacc) { const f32x4 h0 = *(const f32x4*)(shk + 8 * c), h1 = *(const f32x4*)(shk + 8 * c + 4);
#pragma unroll
        for (int e = 0; e < 4; ++e) { sh8[e] = h0[e]; sh8[4 + e] = h1[e]; } }
#pragma unroll
    for (int j = 0; j < 4; ++j) { const int n = (lane >> 3) + 8 * j; const LAS float* sp = scr + (8 * c) * 33 + n;
        if (bacc) bacc[j] += ((sp[0 * 33] * sh8[0] + sp[1 * 33] * sh8[1]) + (sp[2 * 33] * sh8[2] + sp[3 * 33] * sh8[3])) + ((sp[4 * 33] * sh8[4] + sp[5 * 33] * sh8[5]) + (sp[6 * 33] * sh8[6] + sp[7 * 33] * sh8[7]));
        u32x4 o; o.x = cvt_pk_bf16(sp[0 * 33] * gm[0], sp[1 * 33] * gm[1]); o.y = cvt_pk_bf16(sp[2 * 33] * gm[2], sp[3 * 33] * gm[3]); o.z = cvt_pk_bf16(sp[4 * 33] * gm[4], sp[5 * 33] * gm[5]); o.w = cvt_pk_bf16(sp[6 * 33] * gm[6], sp[7 * 33] * gm[7]);
        *(u32x4*)(d.dst + (size_t)n * d.ldk + 8 * c) = o; }
    asm volatile("s_waitcnt lgkmcnt(0)" ::: "memory");
}

__device__ __forceinline__ void ada_item(const Args& a, unsigned char* ws, LAS unsigned char* lds, int l, int cb, int tid) {
    const int lane = tid & 63, wave = tid >> 6;
    LAS float* red = (LAS float*)lds;
    const float* cvec = a.in[I_C];
    float* modf = (float*)(ws + WS_MODF);
    const float* W = a.in[I_WADA] + (size_t)l * DM * (NMOD * DM) + cb * 256 + 4 * lane;
    f32x4 acc = {0.f, 0.f, 0.f, 0.f};
    const int kbeg = wave * 256;
#pragma unroll 32
    for (int k = 0; k < 256; ++k) { const f32x4 w = __builtin_nontemporal_load((const f32x4*)(W + (size_t)(kbeg + k) * (NMOD * DM))); const float cv = cvec[kbeg + k]; acc += w * cv; }
    *(LAS f32x4*)(red + wave * 256 + 4 * lane) = acc;
    __syncthreads();
    if (tid < 256) { float s = 0.f;
#pragma unroll
        for (int w = 0; w < 8; ++w) s += red[w * 256 + tid];
        const int j = cb * 256 + tid; modf[l * (NMOD * DM) + j] = s + a.in[I_BADA][l * (NMOD * DM) + j]; }
    asm volatile("s_waitcnt vmcnt(0)" ::: "memory");
    __syncthreads();
    if (tid == 0) { __builtin_amdgcn_fence(__ATOMIC_RELEASE, "agent"); (void)__hip_atomic_fetch_add((unsigned*)(ws + WS_CTL) + CW_ADA + 64 * l, 1u, __ATOMIC_RELAXED, __HIP_MEMORY_SCOPE_AGENT); }
}
__device__ __forceinline__ void wait_ada(unsigned char* ws, int l, int tid) {
    if (tid == 0) { unsigned* p = (unsigned*)(ws + WS_CTL) + CW_ADA + 64 * l;
        while (__hip_atomic_load(p, __ATOMIC_RELAXED, __HIP_MEMORY_SCOPE_AGENT) < 48u) __builtin_amdgcn_s_sleep(4);
        __builtin_amdgcn_fence(__ATOMIC_ACQUIRE, "agent"); }
    __syncthreads();
}
constexpr int CI_IN = (DM / 64) * (IN_COLS / 32), CI_Q = (512 / 64) * (1536 / 32), CI_KV = (256 / 64) * (2048 / 32), CI_BR1 = (1024 / 64) * (2048 / 32),
              CI_O = (DM / 64) * (DM / 32), CI_1 = (DM / 64) * (DFF / 32), CI_2 = (DFF / 64) * (DM / 32);
constexpr int CONV_PER_LAYER = CI_IN + CI_Q + CI_KV + 3 * CI_BR1 + CI_O + CI_1 + CI_2;
constexpr int CONV_CHUNK = 128, CONV_NCHUNK = (CONV_PER_LAYER + CONV_CHUNK - 1) / CONV_CHUNK;
constexpr int CONV_NDEP = CI_Q + CI_KV + 3 * CI_BR1 + CI_O + CI_2;
__device__ __forceinline__ ConvDesc conv_desc(const Args& a, unsigned char* ws, int l, int r, int lane) {
    unsigned char* wl = ws + WS_W + (size_t)l * W_LAYER;
    if (r < CI_Q) return conv_make(a.in[I_WQUP] + (size_t)l * 512 * 1536, 512, 1536, (bf16*)(wl + W_QUP), 0, r, lane, 512, a.in[I_MQG] + l * 512); r -= CI_Q;
    if (r < CI_KV) return conv_make(a.in[I_WKVUP] + (size_t)l * 256 * 2048, 256, 2048, (bf16*)(wl + W_KVUP), 0, r, lane, 256, a.in[I_MKVG] + l * 256); r -= CI_KV;
    if (r < 3 * CI_BR1) { const int n = r / CI_BR1; r -= n * CI_BR1;
        return conv_make(a.in[I_WBR] + ((size_t)l * 3 + n) * 1024 * 2048, 1024, 2048, (bf16*)(wl + W_BR) + (size_t)n * 1024, 0, r, lane, 3072); } r -= 3 * CI_BR1;
    if (r < CI_O) return conv_make(a.in[I_WOUT] + (size_t)l * DM * DM, DM, DM, (bf16*)(wl + W_OUT), 0, r, lane, DM); r -= CI_O;
    return conv_make(a.in[I_WM2] + (size_t)l * DFF * DM, DFF, DM, (bf16*)(wl + W_M2), 0, r, lane, DFF);
}
__device__ __forceinline__ void conv_item(const Args& a, unsigned char* ws, int l, int r, LAS float* scr, int lane) {
    const ConvDesc d = conv_desc(a, ws, l, r, lane); f32x4 v[8]; conv_load(d, v); conv_finish(d, v, scr, lane);
}
__device__ __forceinline__ void conv_pair(const Args& a, unsigned char* ws, int l, int r0, int r1, LAS float* scr, int lane) {
    const ConvDesc d0 = conv_desc(a, ws, l, r0, lane), d1 = conv_desc(a, ws, l, r1, lane); f32x4 v0[8], v1[8];
    conv_load(d0, v0); conv_load(d1, v1); conv_finish(d0, v0, scr, lane); conv_finish(d1, v1, scr, lane);
}
__device__ __forceinline__ void conv_quad(const Args& a, unsigned char* ws, int l, int r0, LAS float* scr, int lane) {
    const ConvDesc d0 = conv_desc(a, ws, l, r0, lane), d1 = conv_desc(a, ws, l, r0 + 1, lane), d2 = conv_desc(a, ws, l, r0 + 2, lane), d3 = conv_desc(a, ws, l, r0 + 3, lane);
    f32x4 v0[8], v1[8], v2[8], v3[8];
    conv_load(d0, v0); conv_load(d1, v1); conv_load(d2, v2); conv_load(d3, v3);
    conv_finish(d0, v0, scr, lane); conv_finish(d1, v1, scr, lane); conv_finish(d2, v2, scr, lane); conv_finish(d3, v3, scr, lane);
}
constexpr int CC_IN = IN_COLS / 32, CC_1 = DFF / 32, CONV_COLS = CC_IN + CC_1;
__device__ __forceinline__ void conv_col(const Args& a, unsigned char* ws, int l, int ci, LAS float* scr, int lane) {
    unsigned char* wl = ws + WS_W + (size_t)l * W_LAYER;
    const float* modl = (const float*)(ws + WS_MODF) + (size_t)l * (NMOD * DM);
    const bool first = ci < CC_IN; const int nb = first ? ci : ci - CC_IN, N = first ? IN_COLS : DFF, nblk = N / 32;
    const float* W = first ? a.in[I_WIN] + (size_t)l * DM * IN_COLS : a.in[I_WM1] + (size_t)l * DM * DFF;
    bf16* WT = (bf16*)(wl + (first ? W_IN : W_M1));
    const int roff = (first && 32 * nb >= SRC_PAD_AT) ? PADW : 0;
    const float* g = first ? a.in[I_GMIX] + l * DM : a.in[I_GMLP] + l * DM; const float* sc = modl + (first ? 1 : 4) * DM; const float* sh = modl + (first ? 0 : 3) * DM;
    float bacc[4] = {0.f, 0.f, 0.f, 0.f};
    for (int kb = 0; kb < DM / 64; kb += 4) {
        const ConvDesc d0 = conv_make(W, DM, N, WT, roff, kb * nblk + nb, lane, DM, g, sc), d1 = conv_make(W, DM, N, WT, roff, (kb + 1) * nblk + nb, lane, DM, g, sc);
        const ConvDesc d2 = conv_make(W, DM, N, WT, roff, (kb + 2) * nblk + nb, lane, DM, g, sc), d3 = conv_make(W, DM, N, WT, roff, (kb + 3) * nblk + nb, lane, DM, g, sc);
        f32x4 v0[8], v1[8], v2[8], v3[8];
        conv_load(d0, v0); conv_load(d1, v1); conv_load(d2, v2); conv_load(d3, v3);
        conv_finish(d0, v0, scr, lane, sh + 64 * kb, bacc); conv_finish(d1, v1, scr, lane, sh + 64 * (kb + 1), bacc); conv_finish(d2, v2, scr, lane, sh + 64 * (kb + 2), bacc); conv_finish(d3, v3, scr, lane, sh + 64 * (kb + 3), bacc);
    }
    float* bias = (float*)(ws + WS_CTL + WS_BIAS) + (size_t)l * BIAS_PER_LAYER + (first ? roff : PN) + 32 * nb;
#pragma unroll
    for (int j = 0; j < 4; ++j) { float b = bacc[j]; b += swz<1>(b); b += swz<2>(b); b += swz<4>(b); if ((lane & 7) == 0) bias[(lane >> 3) + 8 * j] = b; }
}
constexpr int PREP_CHUNK = 64, PREP_NCHUNK = (CONV_NDEP + PREP_CHUNK - 1) / PREP_CHUNK, PREP_NCOL = (CONV_COLS + NWAVES - 1) / NWAVES, PREP_ITEMS = 48 + PREP_NCHUNK + PREP_NCOL, PREP_LEAD = 100, PREP_TAIL = 64;
static_assert(PREP_LEAD <= PREP_NCHUNK, "prep order");
__device__ __forceinline__ void prep_item(const Args& a, unsigned char* ws, LAS unsigned char* lds, int l, int idx, int tid) {
    if (idx < 48) { ada_item(a, ws, lds, l, idx, tid); return; }
    int ch = idx - 48; const int lane = tid & 63, wave = tid >> 6; LAS float* scr = (LAS float*)(lds + wave * 16384);
    if (ch >= PREP_LEAD && ch < PREP_LEAD + PREP_NCOL) { wait_ada(ws, l, tid); const int ci = (ch - PREP_LEAD) * NWAVES + wave; if (ci < CONV_COLS) conv_col(a, ws, l, ci, scr, lane); __syncthreads(); return; }
    if (ch >= PREP_LEAD + PREP_NCOL) ch -= PREP_NCOL;
    const int beg = ch * PREP_CHUNK, end = (beg + PREP_CHUNK < CONV_NDEP) ? beg + PREP_CHUNK : CONV_NDEP;
    for (int r = beg + 4 * wave; r < end; r += 4 * NWAVES) { if (r + 3 < end) conv_quad(a, ws, l, r, scr, lane); else for (int q = r; q < end && q < r + 4; ++q) conv_item(a, ws, l, q, scr, lane); }
    __syncthreads();
}

__device__ __forceinline__ void prologue(const Args& a, LAS unsigned char* lds, int G, const int wv) {
    int tid = MYTID(wv); asm volatile("" : "+v"(tid));
    const int lane = tid & 63, wave = tid >> 6;
    GAS unsigned char* wsg_ = (GAS unsigned char*)a.ws; asm volatile("" : "+s"(wsg_)); unsigned char* ws = (unsigned char*)wsg_;
    for (int it = blockIdx.x; it < 48; it += G) ada_item(a, ws, lds, 0, it, tid);
    {
        float* rc = (float*)(ws + WS_ROPE); float* rs = rc + S * 32;
        for (int e = blockIdx.x * NTHR + tid; e < S * 32; e += G * NTHR) {
            const int pos = e >> 5, i = e & 31;
            const float inv = exp2f(-(float)i * (13.287712379549449f / 32.0f));
            const float ang = (float)pos * inv;
            const double rev = (double)ang * 0.15915494309189535; const float fr = (float)(rev - rint(rev));
            rc[e] = __builtin_amdgcn_cosf(fr); rs[e] = __builtin_amdgcn_sinf(fr);
        }
    }
    {
        const float* x = a.in[I_X]; bf16* XB = (bf16*)(ws + WS_ACT + A_XB); float* RQ = (float*)(ws + WS_ACT + A_RSQA);
        for (int row = blockIdx.x * NWAVES + wave; row < S; row += G * NWAVES) {
            const f32x4* xr = (const f32x4*)(x + (size_t)row * DM) + lane; f32x4 v[8]; float sq = 0.f;
#pragma unroll
            for (int j = 0; j < 8; ++j) v[j] = xr[64 * j];
            u32x2* o8 = (u32x2*)(XB + (size_t)row * DM) + lane;
#pragma unroll
            for (int j = 0; j < 8; ++j) { sq += (v[j].x * v[j].x + v[j].y * v[j].y) + (v[j].z * v[j].z + v[j].w * v[j].w);
                u32x2 w; w.x = cvt_pk_bf16(v[j].x, v[j].y); w.y = cvt_pk_bf16(v[j].z, v[j].w); o8[64 * j] = w; }
            sq = wave_sum(sq);
            if (lane < 8) RQ[(size_t)row * 8 + lane] = (lane == 0) ? sq : 0.f;
        }
    }
    {
        LAS float* scr = (LAS float*)(lds + wave * 16384);
        const int NA = 48, X = (G > NA) ? (G - NA) * NWAVES * 2 : 0;
        if ((int)blockIdx.x >= NA) for (int it = ((int)blockIdx.x - NA) * NWAVES + wave; it < X; it += (G - NA) * NWAVES) conv_item(a, ws, 0, it, scr, lane);
        for (int it = X + (int)blockIdx.x * NWAVES + wave; it < CONV_NDEP; it += G * NWAVES) conv_item(a, ws, 0, it, scr, lane);
        __syncthreads();
        wait_ada(ws, 0, tid);
        for (int ci = (int)blockIdx.x + G * wave; ci < CONV_COLS; ci += G * NWAVES) conv_col(a, ws, 0, ci, scr, lane);
    }
}

__device__ __forceinline__ void ld16f(const bf16* p, float* x) {
    const u32x4 a = *(const u32x4*)p, b = *(const u32x4*)(p + 8);
    x[0] = bf_lo(a.x); x[1] = bf_hi(a.x); x[2] = bf_lo(a.y); x[3] = bf_hi(a.y); x[4] = bf_lo(a.z); x[5] = bf_hi(a.z); x[6] = bf_lo(a.w); x[7] = bf_hi(a.w);
    x[8] = bf_lo(b.x); x[9] = bf_hi(b.x); x[10] = bf_lo(b.y); x[11] = bf_hi(b.y); x[12] = bf_lo(b.z); x[13] = bf_hi(b.z); x[14] = bf_lo(b.w); x[15] = bf_hi(b.w);
}
__device__ __forceinline__ void st16f(bf16* p, const float* x) {
    u32x4 a, b; a.x = cvt_pk_bf16(x[0], x[1]); a.y = cvt_pk_bf16(x[2], x[3]); a.z = cvt_pk_bf16(x[4], x[5]); a.w = cvt_pk_bf16(x[6], x[7]);
    b.x = cvt_pk_bf16(x[8], x[9]); b.y = cvt_pk_bf16(x[10], x[11]); b.z = cvt_pk_bf16(x[12], x[13]); b.w = cvt_pk_bf16(x[14], x[15]);
    *(u32x4*)p = a; *(u32x4*)(p + 8) = b;
}
__device__ __forceinline__ void ld8f(const bf16* p, float* x) {
    const u32x4 a = *(const u32x4*)p;
    x[0] = bf_lo(a.x); x[1] = bf_hi(a.x); x[2] = bf_lo(a.y); x[3] = bf_hi(a.y); x[4] = bf_lo(a.z); x[5] = bf_hi(a.z); x[6] = bf_lo(a.w); x[7] = bf_hi(a.w);
}
__device__ __forceinline__ void st8f(bf16* p, const float* x) {
    u32x4 a; a.x = cvt_pk_bf16(x[0], x[1]); a.y = cvt_pk_bf16(x[2], x[3]); a.z = cvt_pk_bf16(x[4], x[5]); a.w = cvt_pk_bf16(x[6], x[7]); *(u32x4*)p = a;
}

__device__ __forceinline__ void post1_phase(const Args& a, int l, int G, const int wv) {
    int tid = MYTID(wv); asm volatile("" : "+v"(tid));
    const int lane = tid & 63, wave = tid >> 6;
    GAS unsigned char* wsg_ = (GAS unsigned char*)a.ws; asm volatile("" : "+s"(wsg_)); unsigned char* ws = (unsigned char*)wsg_;
    const bf16* proj = (const bf16*)(ws + WS_ACT + A_PROJ);
    bf16* QA = (bf16*)(ws + WS_ACT + A_QA); bf16* KA = (bf16*)(ws + WS_ACT + A_KA); bf16* KPE = (bf16*)(ws + WS_ACT + A_KPE);
    const float* rc = (const float*)(ws + WS_ROPE); const float* rs = rc + S * 32;
    const float* gq = a.in[I_DQKG] + l * 128; const float* gk = gq + 64;
    const float* gkpe = a.in[I_MQKG] + l * 384 + 192 + 128;
    float gqv[16], gkv[16];
#pragma unroll
    for (int e = 0; e < 16; ++e) { gqv[e] = gq[16 * (lane & 3) + e] * SC_DA; gkv[e] = gk[16 * (lane & 3) + e]; }
    const float gpe = gkpe[lane];
    int rbeg = (int)blockIdx.x * NWAVES + wave, rend = S, rstep = G * NWAVES;
    if (G == 256) { const int b_ = (int)blockIdx.x; const int r0_ = b_ < 192 ? 26 * b_ : 4992 + 50 * (b_ - 192), nr_ = b_ < 192 ? 26 : 50; rbeg = r0_ + wave; rend = r0_ + nr_; rstep = NWAVES; }
    for (int row = rbeg; row < rend; row += rstep) {
        const bf16* P = proj + (size_t)row * PN;
        float x[16];
        { ld16f(P + C_DAQ + 16 * lane, x); float s = 0.f;
#pragma unroll
          for (int e = 0; e < 16; ++e) s += x[e] * x[e];
          s += swz<1>(s); s += swz<2>(s); const float r = rsq(s * (1.f / 64.f) + EPS);
#pragma unroll
          for (int e = 0; e < 16; ++e) x[e] = x[e] * r * gqv[e];
          st16f(QA + (size_t)row * 1024 + 16 * lane, x); }
        { ld16f(P + C_DAK + 16 * lane, x); float s = 0.f;
#pragma unroll
          for (int e = 0; e < 16; ++e) s += x[e] * x[e];
          s += swz<1>(s); s += swz<2>(s); const float r = rsq(s * (1.f / 64.f) + EPS);
#pragma unroll
          for (int e = 0; e < 16; ++e) x[e] = x[e] * r * gkv[e];
          st16f(KA + (size_t)row * 1024 + 16 * lane, x); }
        { const float v = bf1(P[C_KPE + lane]); const float r = rsq(wave_sum(v * v) * (1.f / 64.f) + EPS);
          const float y = v * r * gpe; float yp; { auto rr = __builtin_amdgcn_permlane32_swap(__float_as_uint(y), __float_as_uint(y), false, false); yp = __uint_as_float(lane < 32 ? rr[1] : rr[0]); }
          const int i = lane & 31; const float c = rc[row * 32 + i], sn = rs[row * 32 + i];
          const float o = (lane < 32) ? (y * c - yp * sn) : (yp * sn + y * c);
          KPE[(size_t)row * 64 + lane] = (bf16)(cvt_pk_bf16(o, o) & 0xffffu); }
    }
}


#ifndef ATT_MASK
#define ATT_MASK 7
#endif
__device__ __forceinline__ void attn_phase(const Args& a, int l, int layer, LAS unsigned char* ldsl, volatile LAS unsigned* MISC, const int wv) {
    GAS unsigned char* wsg_ = (GAS unsigned char*)a.ws; asm volatile("" : "+s"(wsg_)); unsigned char* ws = (unsigned char*)wsg_;
    LAS char* lds = (LAS char*)ldsl;
    const bf16* proj = (const bf16*)(ws + WS_ACT + A_PROJ);
    const bf16* QA = (const bf16*)(ws + WS_ACT + A_QA); const bf16* KA = (const bf16*)(ws + WS_ACT + A_KA); const bf16* KPE = (const bf16*)(ws + WS_ACT + A_KPE);
    const bf16* KVRAW = (const bf16*)(ws + WS_ACT + A_KVRAW); const bf16* QRAW = (const bf16*)(ws + WS_ACT + A_QRAW); const bf16* KNOPE = (const bf16*)(ws + WS_ACT + A_KNOPE);
    float* OD = (float*)(ws + WS_ACT + A_OD); bf16* YA = (bf16*)(ws + WS_ACT + A_YA); bf16* YB = YA + 1024; bf16* YC = YA + 2048;
    unsigned* qhead = (unsigned*)(ws + WS_CTL) + CW_QUEUE + 28 * 64 * l;
    const int xcd = (int)(xb_xcc_id() & 7u);
#define CLAIMP(qp) ({ if (MYTID(wv) == 0) MISC[16] = __hip_atomic_fetch_add((qp), 1u, RLX_AGENT); __syncthreads(); const int v_ = (int)MISC[16]; __syncthreads(); v_; })
#define CLAIMX(t_, N_, qsel) ({ \
        if (wv == 0) { const int ln_ = lane_id(); int res_ = -1, qx_ = 0; \
            for (;;) { const unsigned hv_ = (ln_ < 8) ? __hip_atomic_load(qhead + 64 * ((t_) * 8 + ((xcd + ln_) & 7)), RLX_AGENT) : 0xffffffffu; \
                const unsigned long long mk_ = __ballot(hv_ < (unsigned)(N_)); if (mk_ == 0ull) break; \
                const int i_ = __builtin_ctzll(mk_); qx_ = (xcd + i_) & 7; unsigned tk_ = 0u; \
                if (ln_ == 0) tk_ = __hip_atomic_fetch_add(qhead + 64 * ((t_) * 8 + qx_), 1u, RLX_AGENT); \
                tk_ = (unsigned)__builtin_amdgcn_readfirstlane((int)tk_); if (tk_ < (unsigned)(N_)) { res_ = (int)tk_; break; } } \
            if (ln_ == 0) { MISC[16] = (unsigned)res_; MISC[17] = (unsigned)qx_; } } \
        __syncthreads(); const int v_ = (int)MISC[16]; qsel = (int)MISC[17]; __syncthreads(); v_; })
#define CLAIM(qi) CLAIMP(qhead + 64 * (24 + (qi) - 3))
    bool prep_left = (layer + 1 < DEPTH);
#define PREP_ONE() do { if (prep_left) { const int pi_ = CLAIM(4); if (pi_ < PREP_ITEMS - PREP_TAIL) prep_item(a, ws, ldsl, layer + 1, pi_, MYTID(wv)); else prep_left = false; } } while (0)
    if (ATT_MASK & 1) { for (;;) { int h;
        const int ui = CLAIMX(0, 32, h); if (ui < 0) break;
        const int qb = 31 - ui, q0 = qb * 256;
        att::KVSrc kv{KNOPE + h * 128, 1024, KPE, 64, KVRAW + h * 256 + 128, 2048};
        const att::QPrep qp{a.in[I_MQKG] + layer * 384, (const float*)(ws + WS_ROPE), (const float*)(ws + WS_ROPE) + S * 32};
        att::softmax_unit_v3<192, 128, false, false, false, false, false, true>(lds, QRAW + (size_t)q0 * 1536 + h * 192, 1536, kv, q0, nullptr, YB + (size_t)q0 * 3072 + h * 128, 3072, wv, att::DaFin{}, qp);
        PREP_ONE();
      } }
    int npass = 2; asm volatile("" : "+s"(npass));
    for (int pass = 0; pass < npass; ++pass) {
    if (ATT_MASK & 2) { for (;;) { int h, hc, qb;
        if (pass == 0) { const int ui = CLAIMX(1, 56, h); if (ui < 0) break; hc = 2 * h + (ui & 1); qb = 31 - (ui >> 1); }
        else { const int u_ = CLAIM(6); if (u_ >= 64) break; hc = u_ & 15; qb = 3 - (u_ >> 4); h = hc >> 1; }
        const int q0 = qb * 256;
        { const int tid = MYTID(wv); if (tid < 256) { const int rel = 64 - tid, n = rel < 0 ? -rel : rel;
            int large = 8 + (int)(logf((float)(n < 1 ? 1 : n) / 8.0f) / 2.772588722239781f * 8.0f); large = large < 15 ? large : 15;
            const int bucket = (rel > 0 ? 16 : 0) + (n < 8 ? n : large);
            ((LAS float*)(lds + att::L_BIAS))[tid] = (a.in[I_T5][bucket * 8 + h] - a.in[I_T5][15 * 8 + h]) * LOG2E; } }
        __syncthreads();
        att::KVSrc kv{KA + hc * 64, 1024, KA, 1024, proj + C_DAV + h * 128, PN};
        const float* lp = a.in[I_DLAM] + layer * 256; const int ln_ = lane_id();
        const float lam_init = 0.8f - 0.6f * expf(-0.3f * (float)layer);
        float lam = expf(wave_sum(lp[ln_] * lp[64 + ln_])) - expf(wave_sum(lp[128 + ln_] * lp[192 + ln_])) + lam_init;
        lam = __int_as_float(__builtin_amdgcn_readfirstlane(__float_as_int(lam))); const float omli = __int_as_float(__builtin_amdgcn_readfirstlane(__float_as_int(1.f - lam_init)));
        att::DaFin fin{OD + (size_t)(((hc ^ 1) * 32 + qb) * 8) * 4096, (unsigned*)(ws + WS_CTL) + CW_DAC + (l * 8 + h) * 32 + qb, lam, a.in[I_DSUB] + layer * 128, omli, (hc & 1) == 0};
        att::softmax_unit_v3<64, 64, true, true, true, false>(lds, QA + (size_t)q0 * 1024 + hc * 64, 1024, kv, q0, OD + (size_t)((hc * 32 + qb) * 8) * 4096, YA + (size_t)q0 * 3072 + h * 128, 3072, wv, fin);
        PREP_ONE();
      } }
    if (pass == 0) {
    if (ATT_MASK & 4) { for (;;) { int h;
        const int ui = CLAIMX(2, 32, h); if (ui < 0) break;
        const int qb = 31 - ui, q0 = qb * 256;
        att::KVSrc kv{proj + C_SBK + h * 128, PN, proj, PN, proj + C_SBV + h * 128, PN};
        att::sb_unit(lds, proj + (size_t)q0 * PN + C_SBQ + h * 128, PN, kv, q0, YC + (size_t)q0 * 3072 + h * 128, 3072, wv);
      } }
    {
        __syncthreads();
        const bf16* Hh = (const bf16*)(ws + WS_ACT + A_XB); const bf16* Wi = (const bf16*)(ws + WS_W + (size_t)layer * W_LAYER + W_IN); bf16* PJ = (bf16*)(ws + WS_ACT + A_PROJ);
        const float* RQ = (const float*)(ws + WS_ACT + A_RSQA); const float* B1 = (const float*)(ws + WS_CTL + WS_BIAS) + (size_t)layer * BIAS_PER_LAYER;
        constexpr int NFILL = (PN / 256 - GIN_TILES) * (S / 256);
        for (;;) { const int ui = CLAIM(3); if (ui >= NFILL) break;
            pg8::Gemm g{Hh, Wi, S, PN, DM, DM}; pg8::OneUnit So; So.u0.pm = ui & 31; So.u0.pn = GIN_TILES + (ui >> 5);
            pg8::EpiBf16N<3> E{PJ, PN, C_GATE / 256, RQ, B1, 1.f / DM, nullptr, nullptr}; pg8::gemm_phase(ldsl, g, So, E, wv); }
    }
    while (prep_left) PREP_ONE();
    } }
    if (layer + 1 < DEPTH) for (;;) { const int pi_ = CLAIM(5); if (pi_ >= PREP_TAIL) break; prep_item(a, ws, ldsl, layer + 1, PREP_ITEMS - PREP_TAIL + pi_, MYTID(wv)); }
    __syncthreads();
#undef PREP_ONE
#undef CLAIM
#undef CLAIMP
#undef CLAIMX
}

__global__ void __launch_bounds__(NTHR, 2) mk_fwd(Args args) {
    extern __shared__ __attribute__((aligned(16))) unsigned char lds_raw[];
    LAS unsigned char* lds = (LAS unsigned char*)lds_raw;
    volatile LAS unsigned* MISC = (volatile LAS unsigned*)(lds + MISC_OFF);
    const int wv = __builtin_amdgcn_readfirstlane((int)threadIdx.x >> 6);
    const int tid = MYTID(wv), G = gridDim.x;
    unsigned char* ws = args.ws;
    for (int u = tid; u < (LDS_BYTES - LDSCTL_OFF) / 4; u += NTHR) ((LAS unsigned*)(lds + LDSCTL_OFF))[u] = 0u;
    __syncthreads();
    XcdBarrier bar; bar.bar = (unsigned*)(ws + WS_CTL) + CW_BAR; bar.x = 0; bar.st = nullptr;
    if (!MK_SPLIT) bar = xcd_barrier_post((unsigned*)(ws + WS_CTL) + CW_BAR, MISC + 8, wv);
    const int lo = args.ph_lo, hi = args.ph_hi;
#ifndef PH_MASK
#define PH_MASK 0x1FFF
#endif
#if MK_SPLIT
#define IN(k) (lo <= (k) && (k) < hi)
#else
#define IN(k) true
#endif
#define INL(c) (((PH_MASK >> (1 + (c))) & 1) && IN(pb + (c)))
#define SEAM(k) do { if (IN((k) + 1)) xcd_barrier(bar, wv); } while (0)
#if DUP_MASK
#define REP(c) for (int rep_ = ((args.dup >> (c)) & 1); rep_ >= 0; --rep_)
#else
#define REP(c) for (int rep_ = 0; rep_ >= 0; --rep_)
#endif
#define RSEAM() do { if (rep_ > 0) xcd_barrier(bar, wv); } while (0)

    if ((PH_MASK & 1) && IN(0)) { REP(12) { prologue(args, lds, G, wv); RSEAM(); } SEAM(0); }

    for (int l = 0; l < DEPTH; ++l) {
        const int pb = 1 + l * PH_PER_LAYER;
        LAS float* PART = (LAS float*)(lds + RS_OFF);
        {
        GAS unsigned char* wsg_ = (GAS unsigned char*)args.ws; asm volatile("" : "+s"(wsg_)); unsigned char* ws = (unsigned char*)wsg_;
        bf16* PROJ = (bf16*)(ws + WS_ACT + A_PROJ); bf16* XB = (bf16*)(ws + WS_ACT + A_XB);
        float* RQA = (float*)(ws + WS_ACT + A_RSQA); float* RQCQ = (float*)(ws + WS_ACT + A_RSQCQ); float* RQCKV = (float*)(ws + WS_ACT + A_RSQCKV); const float* BIAS = (const float*)(ws + WS_CTL + WS_BIAS) + (size_t)l * BIAS_PER_LAYER;
        bf16* QRAW = (bf16*)(ws + WS_ACT + A_QRAW); bf16* KVRAW = (bf16*)(ws + WS_ACT + A_KVRAW);
        unsigned char* wl = ws + WS_W + (size_t)l * W_LAYER;
        if (INL(1)) { pg8::Gemm g{XB, (const bf16*)(wl + W_IN), S, GIN_TILES * 256, DM, DM}; pg8::StaticOrder So; So.init(S, GIN_TILES * 256, G, (int)blockIdx.x);
            pg8::EpiBf16N<3, true> E{PROJ, PN, C_GATE / 256, RQA, BIAS, 1.f / DM, RQCQ, RQCKV}; REP(1) { pg8::gemm_phase(lds, g, So, E, wv); RSEAM(); } SEAM(pb + 1); }
        if (INL(2)) { REP(2) {
            const float* ZERO = (const float*)(ws + WS_CTL + WS_ZERO);
            if ((blockIdx.x & 1) == 0) post1_phase(args, l, G, wv);
            { pg8::Gemm g{PROJ + C_CQ, (const bf16*)(wl + W_QUP), S, 1536, 512, PN}; pg8::StaticOrder So; So.init(S, 1536, G, (int)blockIdx.x);
              pg8::EpiBf16N<0> E{QRAW, 1536, 0, RQCQ, ZERO, 1.f / 512.f, nullptr, nullptr}; pg8::gemm_phase(lds, g, So, E, wv); }
            { pg8::Gemm g{PROJ + C_CKV, (const bf16*)(wl + W_KVUP), S, 2048, 256, PN}; pg8::StaticOrder So; So.init(S, 2048, G, (int)blockIdx.x);
              pg8::EpiKvUp E{(bf16*)(ws + WS_ACT + A_KNOPE), args.in[I_MQKG] + l * 384 + 192, RQCKV}; pg8::gemm_phase(lds, g, So, E, wv); }
            if ((blockIdx.x & 1) != 0) post1_phase(args, l, G, wv);
            RSEAM(); } SEAM(pb + 3); }
        if (INL(5)) { REP(5) { attn_phase(args, 2 * l + rep_, l, lds, MISC, wv); RSEAM(); } SEAM(pb + 5); }
        }
        {
        GAS unsigned char* wsg_ = (GAS unsigned char*)args.ws; asm volatile("" : "+s"(wsg_)); unsigned char* ws = (unsigned char*)wsg_;
        bf16* PROJ = (bf16*)(ws + WS_ACT + A_PROJ); bf16* XB = (bf16*)(ws + WS_ACT + A_XB); bf16* XB2 = (bf16*)(ws + WS_ACT + A_XB2);
        float* RQA = (float*)(ws + WS_ACT + A_RSQA); float* RQB = (float*)(ws + WS_ACT + A_RSQB); const float* BIAS = (const float*)(ws + WS_CTL + WS_BIAS) + (size_t)l * BIAS_PER_LAYER;
        bf16* YA = (bf16*)(ws + WS_ACT + A_YA); float* MF = (float*)(ws + WS_ACT + A_MF); bf16* MG = (bf16*)(ws + WS_ACT + A_MG); bf16* U = (bf16*)(ws + WS_ACT + A_U);
        const float* modl = (const float*)(ws + WS_MODF) + l * (NMOD * DM);
        unsigned char* wl = ws + WS_W + (size_t)l * W_LAYER;
        if (INL(7)) { REP(7) {
            pg8::Gemm g{YA, (const bf16*)(wl + W_BR), S, DM, 3072, 3072}; pg8::StaticOrder So; So.init(S, DM, G, (int)blockIdx.x);
            pg8::EpiBranchRatio E{PROJ + C_GATE, PN, MG}; pg8::gemm_phase(lds, g, So, E, wv);
            RSEAM(); } SEAM(pb + 7); }
        if (INL(8)) { pg8::Gemm g{MG, (const bf16*)(wl + W_OUT), S, DM, DM, DM}; pg8::StaticOrder So; So.init(S, DM, G, (int)blockIdx.x);
            REP(8) { if (l == 0) { pg8::EpiResid<false, true> E{args.in[I_X], rep_ ? (void*)MF : (void*)XB2, modl + 2 * DM, RQB, PART}; pg8::gemm_phase(lds, g, So, E, wv); }
                     else { pg8::EpiResid<true, true> E{XB, rep_ ? (void*)MF : (void*)XB2, modl + 2 * DM, RQB, PART}; pg8::gemm_phase(lds, g, So, E, wv); } RSEAM(); } SEAM(pb + 8); }
        if (INL(10)) { pg8::Gemm g{XB2, (const bf16*)(wl + W_M1), S, DFF, DM, DM}; pg8::StaticOrder So; So.init(S, DFF, G, (int)blockIdx.x);
            pg8::EpiBf16N<2> E{U, DFF, 0, RQB, BIAS + PN, 1.f / DM, nullptr, nullptr}; REP(10) { pg8::gemm_phase(lds, g, So, E, wv); RSEAM(); } SEAM(pb + 10); }
        if (INL(11)) { pg8::Gemm g{U, (const bf16*)(wl + W_M2), S, DM, DFF, DFF}; pg8::StaticOrder So; So.init(S, DM, G, (int)blockIdx.x);
            REP(11) { if (l == DEPTH - 1) { pg8::EpiResid<true, false> E{XB2, rep_ ? (void*)MF : (void*)args.out, modl + 5 * DM, nullptr, PART}; pg8::gemm_phase(lds, g, So, E, wv); }
                      else { pg8::EpiResid<true, true> E{XB2, rep_ ? (void*)MF : (void*)XB, modl + 5 * DM, RQA, PART}; pg8::gemm_phase(lds, g, So, E, wv); } RSEAM(); } SEAM(pb + 11); }
        }
    }
#undef IN
#undef INL
#undef SEAM
#undef REP
#undef RSEAM
}

extern "C" void kernel_launch(void* const* d_in, const int* in_sizes, int n_in, void* d_out, int out_size, void* d_ws, size_t ws_size, hipStream_t stream) {
    static int grid = 0;
    if (grid == 0) {
        if (n_in != 20 || in_sizes[0] != S * DM || out_size != S * DM || ws_size < WS_END) {
            fprintf(stderr, "kernel_launch: shape mismatch: n_in %d in0 %d out %d ws %zu (need %zu)\n", n_in, n_in > 0 ? in_sizes[0] : -1, out_size, ws_size, (size_t)WS_END); grid = -1; return; }
        int dev = 0, cus = 0, per_cu = 0;
        if (hipGetDevice(&dev) != hipSuccess || hipDeviceGetAttribute(&cus, hipDeviceAttributeMultiprocessorCount, dev) != hipSuccess) { grid = -1; return; }
        if (hipFuncSetAttribute((const void*)mk_fwd, hipFuncAttributeMaxDynamicSharedMemorySize, LDS_BYTES) != hipSuccess) { fprintf(stderr, "kernel_launch: hipFuncSetAttribute failed\n"); grid = -1; return; }
        if (hipOccupancyMaxActiveBlocksPerMultiprocessor(&per_cu, (const void*)mk_fwd, NTHR, LDS_BYTES) != hipSuccess || per_cu < 1)
            fprintf(stderr, "kernel_launch: note: occupancy query reports %d workgroups per CU\n", per_cu);
        (void)hipGetLastError();
        grid = cus;
    }
    if (grid < 0) return;
    if (hipMemsetAsync((char*)d_ws + WS_CTL, 0, CTL_ZERO_BYTES, stream) != hipSuccess) { fprintf(stderr, "kernel_launch: memset failed\n"); return; }
    Args a{};
    for (int i = 0; i < 20; ++i) a.in[i] = (const float*)d_in[i];
    a.out = (float*)d_out; a.ws = (unsigned char*)d_ws; a.dup = DUP_MASK;
#if MK_SPLIT
    for (int p = 0; p < NPHASE; ++p) { a.ph_lo = p; a.ph_hi = p + 1; hipLaunchKernelGGL(mk_fwd, dim3(grid), dim3(NTHR), LDS_BYTES, stream, a); }
#else
    a.ph_lo = 0; a.ph_hi = NPHASE;
    hipLaunchKernelGGL(mk_fwd, dim3(grid), dim3(NTHR), LDS_BYTES, stream, a);
#endif
    const hipError_t le = hipPeekAtLastError();
    if (le != hipSuccess) fprintf(stderr, "kernel_launch: launch failed: %s\n", hipGetErrorName(le));
}
```

```cpp
#include <hip/hip_runtime.h>
#include <cstdio>
#include <cstdint>

#ifndef DUP_MASK
#define DUP_MASK 0
#endif
#ifndef MK_SPLIT
#define MK_SPLIT 0
#endif

#define GAS __attribute__((address_space(1)))
#define LAS __attribute__((address_space(3)))
typedef unsigned short bf16;
typedef short bf16x8 __attribute__((ext_vector_type(8)));
typedef short s16x4 __attribute__((ext_vector_type(4)));
typedef float f32x4 __attribute__((ext_vector_type(4)));
typedef float f32x2 __attribute__((ext_vector_type(2)));
typedef float f32x16 __attribute__((ext_vector_type(16)));
typedef unsigned u32x4 __attribute__((ext_vector_type(4)));
typedef unsigned u32x2 __attribute__((ext_vector_type(2)));

constexpr int S = 8192, DM = 2048, DEPTH = 4, DFF = 8192, NMOD = 6;
constexpr int IN_COLS = 13120, PN = 13312;
constexpr int C_DAQ = 0, C_DAK = 1024, C_DAV = 2048, C_CQ = 3072, C_CKV = 3584, C_KPE = 3840, C_SBQ = 4096, C_SBK = 5120, C_SBV = 6144, C_GATE = 7168;
constexpr int SRC_PAD_AT = 3904, PADW = 192;
constexpr float EPS = 1e-6f;
constexpr float LOG2E = 1.4426950408889634f;
constexpr float SC_DA = 0.125f * LOG2E;
constexpr float SC_MLA = 0.07216878364870323f * LOG2E;
constexpr float SC_SB = 0.08838834764831845f * LOG2E;
constexpr int GIN_TILES = 32;
constexpr float SB_DEAD = -150.0f;

constexpr size_t MiB = 1u << 20;
constexpr size_t WS_CTL = 0, CTL_ZERO_BYTES = 1 * MiB;
constexpr size_t WS_MODF = 1 * MiB;
constexpr size_t WS_ROPE = 2 * MiB;
constexpr size_t WS_W = 4 * MiB;
constexpr size_t W_IN = 0, W_QUP = W_IN + (size_t)PN * DM * 2, W_KVUP = W_QUP + (size_t)1536 * 512 * 2, W_BR = W_KVUP + (size_t)2048 * 256 * 2,
                 W_OUT = W_BR + (size_t)3 * 2048 * 1024 * 2, W_M1 = W_OUT + (size_t)DM * DM * 2, W_M2 = W_M1 + (size_t)DFF * DM * 2, W_LAYER = W_M2 + (size_t)DM * DFF * 2;
constexpr size_t WS_ACT = WS_W + DEPTH * W_LAYER;
constexpr size_t A_H = 0, A_PROJ = A_H + (size_t)S * DM * 2, A_QA = A_PROJ + (size_t)S * PN * 2, A_KA = A_QA + (size_t)S * 1024 * 2,
                 A_CQN = A_KA + (size_t)S * 1024 * 2, A_CKVN = A_CQN + (size_t)S * 512 * 2, A_KPE = A_CKVN + (size_t)S * 256 * 2,
                 A_QRAW = A_KPE + (size_t)S * 64 * 2, A_KVRAW = A_QRAW + (size_t)S * 1536 * 2, A_QH = A_KVRAW + (size_t)S * 2048 * 2,
                 A_KNOPE = A_QH + (size_t)S * 1536 * 2, A_OD = A_KNOPE + (size_t)S * 1024 * 2, A_YA = A_OD + (size_t)S * 2048 * 4,
                 A_YB = A_YA + (size_t)S * 1024 * 2, A_YC = A_YB + (size_t)S * 1024 * 2, A_MF = A_YC + (size_t)S * 1024 * 2,
                 A_MG = A_MF + (size_t)S * DM * 4, A_U = A_MG + (size_t)S * DM * 2, A_XB = A_U + (size_t)S * DFF * 2, A_XB2 = A_XB + (size_t)S * DM * 2, A_END = A_XB2 + (size_t)S * DM * 2;
constexpr size_t WS_END = WS_ACT + A_END;
constexpr int CW_BAR = 4096;
constexpr int CW_QUEUE = 16384;
constexpr int CW_DAC = 32768;
constexpr int CW_ADA = 8192;
constexpr size_t WS_BIAS = 512 * 1024;
constexpr int BIAS_PER_LAYER = PN + DFF;
constexpr size_t A_RSQA = A_H, A_RSQB = A_H + (size_t)1 * MiB;
constexpr size_t A_RSQCQ = A_H + (size_t)2 * MiB, A_RSQCKV = A_H + (size_t)3 * MiB;
constexpr size_t WS_ZERO = 256 * 1024;

constexpr int RING_BYTES = 131072;
constexpr int LDSCTL_OFF = RING_BYTES, MISC_OFF = LDSCTL_OFF + 320;
constexpr int LDS_BYTES = 147456;
constexpr int RS_OFF = MISC_OFF + 256;

__device__ __forceinline__ unsigned cvt_pk_bf16(float lo, float hi) { unsigned r; asm volatile("v_cvt_pk_bf16_f32 %0, %1, %2" : "=v"(r) : "v"(lo), "v"(hi)); return r; }
__device__ __forceinline__ float bf_lo(unsigned w) { return __uint_as_float(w << 16); }
__device__ __forceinline__ float bf_hi(unsigned w) { return __uint_as_float(w & 0xffff0000u); }
__device__ __forceinline__ float bf1(bf16 h) { return __uint_as_float((unsigned)h << 16); }
template <int M> __device__ __forceinline__ float swz(float v) {
    return __int_as_float(__builtin_amdgcn_ds_swizzle(__float_as_int(v), (M << 10) | 0x1F));
}
__device__ __forceinline__ float half_sum(float v) {
    auto rr = __builtin_amdgcn_permlane32_swap(__float_as_uint(v), __float_as_uint(v), false, false);
    return __uint_as_float(rr[0]) + __uint_as_float(rr[1]);
}
__device__ __forceinline__ float wave_sum(float v) {
    v += swz<1>(v); v += swz<2>(v); v += swz<4>(v); v += swz<8>(v); v += swz<16>(v);
    return half_sum(v);
}
__device__ __forceinline__ float rsq(float x) { return 1.0f / sqrtf(x); }
__device__ __forceinline__ float wave_max(float v) {
    v = fmaxf(v, swz<1>(v)); v = fmaxf(v, swz<2>(v)); v = fmaxf(v, swz<4>(v)); v = fmaxf(v, swz<8>(v)); v = fmaxf(v, swz<16>(v));
    auto rr = __builtin_amdgcn_permlane32_swap(__float_as_uint(v), __float_as_uint(v), false, false);
    return fmaxf(__uint_as_float(rr[0]), __uint_as_float(rr[1]));
}
constexpr float SMAX_BOUND = 60.f;

__device__ __forceinline__ int lane_id() { int l; asm volatile("v_mbcnt_lo_u32_b32 %0, -1, 0\n\tv_mbcnt_hi_u32_b32 %0, -1, %0" : "=v"(l)); return l; }
#define MYTID(wv) ((wv) * 64 + lane_id())

namespace pg8 {
constexpr int BM = 256, BK = 64, HALF = 128, HTB = HALF * BK * 2, STAGE_BYTES = 8 * HTB, NXCD = 8, WGM = 8;
__host__ __device__ __forceinline__ int lds_byte(int r, int c) { const int st = (r >> 4) * 2 + (c >> 5), rr = r & 15, cc = c & 31, ob = rr * 64 + cc * 2; return st * 1024 + (ob ^ (((ob >> 9) & 1) << 5)); }
__host__ __device__ __forceinline__ void stage_rc(int b, int& R, int& C) { const int st = b / 1024, sb = b % 1024, swz = sb ^ (((sb >> 9) & 1) << 5); R = (st >> 1) * 16 + swz / 64; C = (st & 1) * 32 + (swz % 64) / 2; }
__host__ __device__ __forceinline__ int perm32(int rho) { const int n = rho >> 4, i = rho & 15; return 8 * (i >> 2) + 4 * n + (i & 3); }

struct Unit { int pm, pn; };
struct Gemm { const bf16* A; const bf16* Bt; int M, N, K, lda; };

struct StaticOrder {
    int nM, nN, nwg, G, c;
    __device__ void init(int M, int N, int G_, int c_) { nM = M / BM; nN = N / BM; nwg = nM * nN; G = G_; c = c_; }
    __device__ bool next(int i, Unit& u) const {
        const long L = (long)i * G + c; if (L >= nwg) return false;
        int wgid = (int)L; { const int q = nwg / NXCD, r = nwg % NXCD, xcd = wgid % NXCD, off = wgid / NXCD; wgid = (xcd < r ? xcd * (q + 1) : r * (q + 1) + (xcd - r) * q) + off; }
        const int nig = WGM * nN, gid = wgid / nig, fm = gid * WGM, gsz = (nM - fm) < WGM ? (nM - fm) : WGM;
        u.pm = fm + ((wgid % nig) % gsz); u.pn = (wgid % nig) / gsz; return true;
    }
    __device__ __forceinline__ void a_ready(const Unit&) const {}
    __device__ __forceinline__ void done(const Unit&) const {}
};

struct OneUnit {
    Unit u0;
    __device__ bool next(int i, Unit& u) const { if (i > 0) return false; u = u0; return true; }
    __device__ __forceinline__ void a_ready(const Unit&) const {}
    __device__ __forceinline__ void done(const Unit&) const {}
};
template <int ACT  > struct EpiBf16 {
    static constexpr bool PERM = true, HAS_MID = false, RS = false, RSQ_OUT = false;
    bf16* O; int ldc; int sig_pn0;
    __device__ __forceinline__ void operator()(const f32x4 (&acc)[2][2][4][2], const Unit& u, int wr, int wc, int fr, int fq) const {
        const int row0 = u.pm * BM + wr * 64 + fr; const int col0 = u.pn * BM + wc * 32 + 8 * fq;
#pragma unroll
        for (int ai = 0; ai < 2; ++ai)
#pragma unroll
            for (int m = 0; m < 4; ++m) { bf16* rowp = O + (size_t)(row0 + ai * HALF + m * 16) * ldc + col0;
#pragma unroll
                for (int bj = 0; bj < 2; ++bj) { f32x4 v0 = acc[ai][bj][m][0], v1 = acc[ai][bj][m][1];
                    if (ACT == 2) {
#pragma unroll
                        for (int e = 0; e < 4; ++e) { const float a = fmaxf(v0[e], 0.f), b = fmaxf(v1[e], 0.f); v0[e] = a * a; v1[e] = b * b; } }
                    if (ACT == 3) { if (u.pn >= sig_pn0) {
#pragma unroll
                        for (int e = 0; e < 4; ++e) { v0[e] = __builtin_amdgcn_rcpf(1.f + __builtin_amdgcn_exp2f(-LOG2E * v0[e])); v1[e] = __builtin_amdgcn_rcpf(1.f + __builtin_amdgcn_exp2f(-LOG2E * v1[e])); } } }
                    u32x4 w; w.x = cvt_pk_bf16(v0[0], v0[1]); w.y = cvt_pk_bf16(v0[2], v0[3]); w.z = cvt_pk_bf16(v1[0], v1[1]); w.w = cvt_pk_bf16(v1[2], v1[3]);
                    *(u32x4*)(rowp + bj * HALF) = w; } }
    }
};
template <int ACT, bool RSO_ = false> struct EpiBf16N {
    static constexpr bool PERM = true, HAS_MID = false, RS = true, RSQ_OUT = false, RSO = RSO_, NO_BIAS = false;
    bf16* O; int ldc; int sig_pn0; const float* rsqp; const float* bias; float inv_n; float* rq_cq; float* rq_ckv;
    __device__ __forceinline__ void operator()(const f32x4 (&acc)[2][2][4][2], const Unit& u, int wr, int wc, int fr, int fq, const LAS float* raw, const LAS float* bl, LAS float* part) const {
        const int row0 = u.pm * BM + wr * 64 + fr; const int col0 = u.pn * BM + wc * 32 + 8 * fq;
        const bool want = RSO && u.pn >= C_CQ / 256 && u.pn <= C_CKV / 256;
        f32x4 bv[2][2];
#pragma unroll
        for (int bj = 0; bj < 2; ++bj)
#pragma unroll
            for (int n = 0; n < 2; ++n) bv[bj][n] = *(const LAS f32x4*)(bl + bj * HALF + wc * 32 + 8 * fq + 4 * n);
#pragma unroll
        for (int ai = 0; ai < 2; ++ai)
#pragma unroll
            for (int m = 0; m < 4; ++m) { bf16* rowp = O + (size_t)(row0 + ai * HALF + m * 16) * ldc + col0;
                const LAS float* rp = raw + (ai * HALF + wr * 64 + m * 16 + fr) * 8;
                const f32x4 p0 = *(const LAS f32x4*)rp, p1 = *(const LAS f32x4*)(rp + 4);
                const float rstd = __builtin_amdgcn_rsqf(((p0[0] + p0[1]) + (p0[2] + p0[3]) + (p1[0] + p1[1]) + (p1[2] + p1[3])) * inv_n + EPS);
                float ss = 0.f;
#pragma unroll
                for (int bj = 0; bj < 2; ++bj) { f32x4 v0 = acc[ai][bj][m][0] * rstd + bv[bj][0], v1 = acc[ai][bj][m][1] * rstd + bv[bj][1];
                    if (RSO) ss += ((v0[0] * v0[0] + v0[1] * v0[1]) + (v0[2] * v0[2] + v0[3] * v0[3])) + ((v1[0] * v1[0] + v1[1] * v1[1]) + (v1[2] * v1[2] + v1[3] * v1[3]));
                    if (ACT == 2) {
#pragma unroll
                        for (int e = 0; e < 4; ++e) { const float a = fmaxf(v0[e], 0.f), b = fmaxf(v1[e], 0.f); v0[e] = a * a; v1[e] = b * b; } }
                    if (ACT == 3) { if (u.pn >= sig_pn0) {
#pragma unroll
                        for (int e = 0; e < 4; ++e) { v0[e] = __builtin_amdgcn_rcpf(1.f + __builtin_amdgcn_exp2f(-LOG2E * v0[e])); v1[e] = __builtin_amdgcn_rcpf(1.f + __builtin_amdgcn_exp2f(-LOG2E * v1[e])); } } }
                    u32x4 w; w.x = cvt_pk_bf16(v0[0], v0[1]); w.y = cvt_pk_bf16(v0[2], v0[3]); w.z = cvt_pk_bf16(v1[0], v1[1]); w.w = cvt_pk_bf16(v1[2], v1[3]);
                    *(u32x4*)(rowp + bj * HALF) = w; }
                if (RSO) { if (want) { ss += swz<16>(ss); ss = half_sum(ss); if (fq == 0) part[wc * BM + ai * HALF + wr * 64 + m * 16 + fr] = ss; } } }
    }
};
struct EpiKvUp {
    static constexpr bool PERM = true, HAS_MID = false, RS = true, RSQ_OUT = false, RSO = false, NO_BIAS = true;
    bf16* KN; const float* gk; const float* rsqp;
    static constexpr float inv_n = 1.f / 256.f;
    __device__ __forceinline__ void operator()(const f32x4 (&acc)[2][2][4][2], const Unit& u, int wr, int wc, int fr_, int fq_, const LAS float* raw, const LAS float* bl, LAS float* part) const {
        const int ln_ = lane_id(), fr = ln_ & 15, fq = ln_ >> 4;
        const int row0 = u.pm * BM + wr * 64 + fr; const int cl = wc * 32 + 8 * fq;
        float rl[2][4];
#pragma unroll
        for (int ai = 0; ai < 2; ++ai)
#pragma unroll
            for (int m = 0; m < 4; ++m) { const int rloc = ai * HALF + wr * 64 + m * 16 + fr; const LAS float* rp = raw + rloc * 8;
                const f32x4 p0 = *(const LAS f32x4*)rp, p1 = *(const LAS f32x4*)(rp + 4);
                const float rstd = __builtin_amdgcn_rsqf(((p0[0] + p0[1]) + (p0[2] + p0[3]) + (p1[0] + p1[1]) + (p1[2] + p1[3])) * inv_n + EPS); rl[ai][m] = rstd;
                const f32x4 v0 = acc[ai][0][m][0] * rstd, v1 = acc[ai][0][m][1] * rstd;
                float ss = ((v0[0] * v0[0] + v0[1] * v0[1]) + (v0[2] * v0[2] + v0[3] * v0[3])) + ((v1[0] * v1[0] + v1[1] * v1[1]) + (v1[2] * v1[2] + v1[3] * v1[3]));
                ss += swz<16>(ss); ss = half_sum(ss);
                if (fq == 0) part[wc * BM + rloc] = ss; }
        asm volatile("s_waitcnt lgkmcnt(0)" ::: "memory"); __builtin_amdgcn_s_barrier();
        const f32x4 g0 = *(const f32x4*)(gk + cl), g1 = *(const f32x4*)(gk + cl + 4);
#pragma unroll
        for (int ai = 0; ai < 2; ++ai)
#pragma unroll
            for (int m = 0; m < 4; ++m) { const int rloc = ai * HALF + wr * 64 + m * 16 + fr; const size_t row = (size_t)(row0 + ai * HALF + m * 16);
                const float rk = __builtin_amdgcn_rsqf(((part[rloc] + part[BM + rloc]) + (part[2 * BM + rloc] + part[3 * BM + rloc])) * (1.f / 128.f) + EPS) * rl[ai][m];
                { const f32x4 v0 = acc[ai][0][m][0] * rk * g0, v1 = acc[ai][0][m][1] * rk * g1;
                  u32x4 w; w.x = cvt_pk_bf16(v0[0], v0[1]); w.y = cvt_pk_bf16(v0[2], v0[3]); w.z = cvt_pk_bf16(v1[0], v1[1]); w.w = cvt_pk_bf16(v1[2], v1[3]);
                  *(u32x4*)(KN + row * 1024 + u.pn * 128 + cl) = w; }
                { const f32x4 v0 = acc[ai][1][m][0] * rl[ai][m], v1 = acc[ai][1][m][1] * rl[ai][m];
                  u32x4 w; w.x = cvt_pk_bf16(v0[0], v0[1]); w.y = cvt_pk_bf16(v0[2], v0[3]); w.z = cvt_pk_bf16(v1[0], v1[1]); w.w = cvt_pk_bf16(v1[2], v1[3]);
                  *(u32x4*)((bf16*)((char*)KN + ((ptrdiff_t)A_KVRAW - (ptrdiff_t)A_KNOPE)) + row * 2048 + u.pn * 256 + 128 + cl) = w; } }
    }
};
template <int PASS> struct EpiBranch {
    static constexpr bool PERM = true;
    const bf16* G; int ldg; float* MF; bf16* MG;
    __device__ __forceinline__ void operator()(const f32x4 (&acc)[2][2][4][2], const Unit& u, int wr, int wc, int fr, int fq) const {
        const int row0 = u.pm * BM + wr * 64 + fr; const int col0 = u.pn * BM + wc * 32 + 8 * fq;
#pragma unroll
        for (int ai = 0; ai < 2; ++ai)
#pragma unroll
            for (int m = 0; m < 4; ++m) { const size_t row = (size_t)(row0 + ai * HALF + m * 16);
#pragma unroll
                for (int bj = 0; bj < 2; ++bj) { const int col = col0 + bj * HALF;
                    const u32x4 gw = *(const u32x4*)(G + row * ldg + col);
                    float g[8] = {bf_lo(gw.x), bf_hi(gw.x), bf_lo(gw.y), bf_hi(gw.y), bf_lo(gw.z), bf_hi(gw.z), bf_lo(gw.w), bf_hi(gw.w)};
                    f32x4 v0, v1;
#pragma unroll
                    for (int e = 0; e < 4; ++e) { v0[e] = acc[ai][bj][m][0][e] * __builtin_amdgcn_rcpf(1.f + __builtin_amdgcn_exp2f(-LOG2E * g[e]));
                                                  v1[e] = acc[ai][bj][m][1][e] * __builtin_amdgcn_rcpf(1.f + __builtin_amdgcn_exp2f(-LOG2E * g[4 + e])); }
                    float* mp = MF + row * DM + col;
                    if (PASS > 0) { v0 += *(const f32x4*)mp; v1 += *(const f32x4*)(mp + 4); }
                    if (PASS < 2) { *(f32x4*)mp = v0; *(f32x4*)(mp + 4) = v1; }
                    else { u32x4 w; w.x = cvt_pk_bf16(v0[0], v0[1]); w.y = cvt_pk_bf16(v0[2], v0[3]); w.z = cvt_pk_bf16(v1[0], v1[1]); w.w = cvt_pk_bf16(v1[2], v1[3]);
                           *(u32x4*)(MG + row * DM + col) = w; } } }
    }
};
struct EpiBranchRatio {
    static constexpr bool PERM = true, HAS_MID = true, RS = false, RSQ_OUT = false;
    const bf16* G; int ldg; bf16* MG;
    __device__ __forceinline__ void mid(f32x4 (&acc)[2][2][4][2], const Unit& u, int seg, int wr, int wc, int fr, int fq) const {
        const int row0 = u.pm * BM + wr * 64 + fr; const int col0 = u.pn * BM + wc * 32 + 8 * fq;
        const bf16* Ga = G + (seg - 1) * DM; const bf16* Gb = G + seg * DM;
#pragma unroll
        for (int ai = 0; ai < 2; ++ai)
#pragma unroll
            for (int mp = 0; mp < 2; ++mp) {
                u32x4 ga[2][2], gb[2][2];
#pragma unroll
                for (int mm = 0; mm < 2; ++mm)
#pragma unroll
                    for (int bj = 0; bj < 2; ++bj) { const size_t off = (size_t)(row0 + ai * HALF + (2 * mp + mm) * 16) * ldg + col0 + bj * HALF;
                        ga[mm][bj] = *(const u32x4*)(Ga + off); gb[mm][bj] = *(const u32x4*)(Gb + off); }
#pragma unroll
                for (int mm = 0; mm < 2; ++mm)
#pragma unroll
                    for (int bj = 0; bj < 2; ++bj) { const int m = 2 * mp + mm; const u32x4 a_ = ga[mm][bj], b_ = gb[mm][bj];
                        const float sa[8] = {bf_lo(a_.x), bf_hi(a_.x), bf_lo(a_.y), bf_hi(a_.y), bf_lo(a_.z), bf_hi(a_.z), bf_lo(a_.w), bf_hi(a_.w)};
                        const float sb[8] = {bf_lo(b_.x), bf_hi(b_.x), bf_lo(b_.y), bf_hi(b_.y), bf_lo(b_.z), bf_hi(b_.z), bf_lo(b_.w), bf_hi(b_.w)};
#pragma unroll
                        for (int e = 0; e < 4; ++e) { acc[ai][bj][m][0][e] *= sa[e] * __builtin_amdgcn_rcpf(fmaxf(sb[e], 1e-30f)); acc[ai][bj][m][1][e] *= sa[4 + e] * __builtin_amdgcn_rcpf(fmaxf(sb[4 + e], 1e-30f)); } }
            }
    }
    __device__ __forceinline__ void operator()(const f32x4 (&acc)[2][2][4][2], const Unit& u, int wr, int wc, int fr, int fq) const {
        const int row0 = u.pm * BM + wr * 64 + fr; const int col0 = u.pn * BM + wc * 32 + 8 * fq;
        const bf16* Gc = G + 2 * DM;
#pragma unroll
        for (int ai = 0; ai < 2; ++ai)
#pragma unroll
            for (int mp = 0; mp < 2; ++mp) {
                u32x4 gc[2][2];
#pragma unroll
                for (int mm = 0; mm < 2; ++mm)
#pragma unroll
                    for (int bj = 0; bj < 2; ++bj) gc[mm][bj] = *(const u32x4*)(Gc + (size_t)(row0 + ai * HALF + (2 * mp + mm) * 16) * ldg + col0 + bj * HALF);
#pragma unroll
                for (int mm = 0; mm < 2; ++mm)
#pragma unroll
                    for (int bj = 0; bj < 2; ++bj) { const int m = 2 * mp + mm; const u32x4 c_ = gc[mm][bj];
                        const float sc[8] = {bf_lo(c_.x), bf_hi(c_.x), bf_lo(c_.y), bf_hi(c_.y), bf_lo(c_.z), bf_hi(c_.z), bf_lo(c_.w), bf_hi(c_.w)};
                        f32x4 v0, v1;
#pragma unroll
                        for (int e = 0; e < 4; ++e) { v0[e] = acc[ai][bj][m][0][e] * sc[e]; v1[e] = acc[ai][bj][m][1][e] * sc[4 + e]; }
                        u32x4 w; w.x = cvt_pk_bf16(v0[0], v0[1]); w.y = cvt_pk_bf16(v0[2], v0[3]); w.z = cvt_pk_bf16(v1[0], v1[1]); w.w = cvt_pk_bf16(v1[2], v1[3]);
                        *(u32x4*)(MG + (size_t)(row0 + ai * HALF + m * 16) * DM + col0 + bj * HALF) = w; }
            }
    }
};
template <bool XIN16, bool XOUT16> struct EpiResid {
    static constexpr bool PERM = true, HAS_MID = false, RS = false, RSQ_OUT = XOUT16;
    const void* xin; void* out; const float* gvec; float* rsqp; LAS float* part;
    __device__ __forceinline__ void operator()(const f32x4 (&acc)[2][2][4][2], const Unit& u, int wr, int wc, int fr, int fq) const {
        const int row0 = u.pm * BM + wr * 64 + fr; const int col0 = u.pn * BM + wc * 32 + 8 * fq;
        f32x4 gv[2][2];
#pragma unroll
        for (int bj = 0; bj < 2; ++bj)
#pragma unroll
            for (int n = 0; n < 2; ++n) gv[bj][n] = *(const f32x4*)(gvec + col0 + bj * HALF + n * 4);
#pragma unroll
        for (int ai = 0; ai < 2; ++ai)
#pragma unroll
            for (int mp = 0; mp < 2; ++mp) {
                f32x4 xv[2][2][2];
#pragma unroll
                for (int mm = 0; mm < 2; ++mm) { const size_t off = (size_t)(row0 + ai * HALF + (2 * mp + mm) * 16) * DM + col0;
#pragma unroll
                    for (int bj = 0; bj < 2; ++bj) {
                        if (XIN16) { const u32x4 w_ = *(const u32x4*)((const bf16*)xin + off + bj * HALF);
                            xv[mm][bj][0] = (f32x4){bf_lo(w_.x), bf_hi(w_.x), bf_lo(w_.y), bf_hi(w_.y)}; xv[mm][bj][1] = (f32x4){bf_lo(w_.z), bf_hi(w_.z), bf_lo(w_.w), bf_hi(w_.w)}; }
                        else { xv[mm][bj][0] = *(const f32x4*)((const float*)xin + off + bj * HALF); xv[mm][bj][1] = *(const f32x4*)((const float*)xin + off + bj * HALF + 4); } } }
#pragma unroll
                for (int mm = 0; mm < 2; ++mm) { const int m = 2 * mp + mm; const size_t off = (size_t)(row0 + ai * HALF + m * 16) * DM + col0; float ss = 0.f;
#pragma unroll
                    for (int bj = 0; bj < 2; ++bj) { const f32x4 v0 = xv[mm][bj][0] + gv[bj][0] * acc[ai][bj][m][0], v1 = xv[mm][bj][1] + gv[bj][1] * acc[ai][bj][m][1];
                        if (XOUT16) ss += ((v0[0] * v0[0] + v0[1] * v0[1]) + (v0[2] * v0[2] + v0[3] * v0[3])) + ((v1[0] * v1[0] + v1[1] * v1[1]) + (v1[2] * v1[2] + v1[3] * v1[3]));
                        if (XOUT16) { u32x4 w; w.x = cvt_pk_bf16(v0[0], v0[1]); w.y = cvt_pk_bf16(v0[2], v0[3]); w.z = cvt_pk_bf16(v1[0], v1[1]); w.w = cvt_pk_bf16(v1[2], v1[3]);
                            *(u32x4*)((bf16*)out + off + bj * HALF) = w; }
                        else { *(f32x4*)((float*)out + off + bj * HALF) = v0; *(f32x4*)((float*)out + off + bj * HALF + 4) = v1; } }
                    if (XOUT16) { ss += swz<16>(ss); ss = half_sum(ss);
                        if (fq == 0) part[wc * BM + ai * HALF + wr * 64 + m * 16 + fr] = ss; } }
            }
    }
};

template <class Epi, class Sched>
__device__ __forceinline__ void gemm_phase(LAS unsigned char* lds, const Gemm g, const Sched& S, const Epi& E, const int wv) {
    int tid = MYTID(wv); asm volatile("" : "+v"(tid));
    const int wid = __builtin_amdgcn_readfirstlane(tid >> 6), lane = tid & 63, wr = wid >> 2, wc = wid & 3, fr = lane & 15, fq = lane >> 4;
    const int K = g.K, nt = K / BK, lda = g.lda;
    const int thook = nt >= 6 ? 4 : nt - 2;
    unsigned voffA[2], voffB[2];
#pragma unroll
    for (int i = 0; i < 2; ++i) { int R, C; stage_rc(tid * 16 + i * 8192, R, C); const int Rb = Epi::PERM ? ((R & ~31) + perm32(R & 31)) : R;
        voffA[i] = (unsigned)(R * lda + C) * 2u; voffB[i] = (unsigned)(Rb * K + C) * 2u; }
    const size_t kstep = (size_t)(BK * 2);
    const size_t hsA = (size_t)HALF * lda * 2, hsB = (size_t)HALF * K * 2;
    const size_t tsA = 2 * hsA, tsB = 2 * hsB;
    const unsigned ldsw = (unsigned)wid * 1024u;
    const int aoff = lds_byte(wr * 64 + fr, fq * 8), boff = lds_byte(wc * 32 + fr, fq * 8);
#define PG8_SA(b, h) (((b) * 2 + (h)) * HTB)
#define PG8_SB(b, h) ((4 + (b) * 2 + (h)) * HTB)
#define PG8_STAGE(bufoff, gbase, voff) do { _Pragma("unroll") for (int _i = 0; _i < 2; ++_i) \
        __builtin_amdgcn_global_load_lds((const unsigned*)((const char*)(gbase) + (voff)[_i]), (LAS unsigned*)(lds + (bufoff) + ldsw + _i * 8192), 16, 0, 0); } while (0)
#define PG8_LDA(dst, b, h) do { _Pragma("unroll") for (int m = 0; m < 4; ++m) _Pragma("unroll") for (int k = 0; k < 2; ++k) dst[m][k] = *(const LAS bf16x8*)(lds + PG8_SA(b, h) + aoff + m * 2048 + k * 1024); } while (0)
#define PG8_LDB(dst, b, h) do { _Pragma("unroll") for (int n = 0; n < 2; ++n) _Pragma("unroll") for (int k = 0; k < 2; ++k) dst[n][k] = *(const LAS bf16x8*)(lds + PG8_SB(b, h) + boff + n * 2048 + k * 1024); } while (0)
#define PG8_MMA(ai, bj, At, Bt) do { __builtin_amdgcn_s_setprio(1); _Pragma("unroll") for (int m = 0; m < 4; ++m) _Pragma("unroll") for (int n = 0; n < 2; ++n) _Pragma("unroll") for (int k = 0; k < 2; ++k) \
        acc[ai][bj][m][n] = __builtin_amdgcn_mfma_f32_16x16x32_bf16(Bt[n][k], At[m][k], acc[ai][bj][m][n], 0, 0, 0); __builtin_amdgcn_s_setprio(0); } while (0)
#define PG8_WAIT_V(n) asm volatile("s_waitcnt vmcnt(" #n ")" ::: "memory")
#define PG8_WAIT_L(n) asm volatile("s_waitcnt lgkmcnt(" #n ")" ::: "memory")
#define PG8_BAR __builtin_amdgcn_s_barrier()
#define PG8_SCHED __builtin_amdgcn_sched_barrier(0)
    Unit cur, nxt; int ui = 0;
    if (!S.next(0, cur)) return;
    f32x4 acc[2][2][4][2];
#pragma unroll
    for (int a = 0; a < 2; ++a)
#pragma unroll
        for (int b = 0; b < 2; ++b)
#pragma unroll
            for (int m = 0; m < 4; ++m)
#pragma unroll
                for (int n = 0; n < 2; ++n) acc[a][b][m][n] = (f32x4){0.f, 0.f, 0.f, 0.f};
    bf16x8 At[4][2], B0[2][2], B1[2][2];
    const char* cA = (const char*)g.A + (size_t)cur.pm * tsA; const char* cB = (const char*)g.Bt + (size_t)cur.pn * tsB;
    S.a_ready(cur);
    PG8_STAGE(PG8_SB(0, 0), cB, voffB); PG8_STAGE(PG8_SB(0, 1), cB + hsB, voffB); PG8_STAGE(PG8_SA(0, 0), cA, voffA); PG8_STAGE(PG8_SA(0, 1), cA + hsA, voffA);
    if (wr == 1) PG8_BAR;
    PG8_WAIT_V(2); PG8_BAR;
    PG8_STAGE(PG8_SB(1, 0), cB + kstep, voffB); PG8_STAGE(PG8_SA(1, 0), cA + kstep, voffA); PG8_STAGE(PG8_SB(1, 1), cB + hsB + kstep, voffB);
    PG8_WAIT_V(6); PG8_BAR;
    for (;;) {
        const bool has_next = S.next(ui + 1, nxt);
        const char* nA = has_next ? (const char*)g.A + (size_t)nxt.pm * tsA : cA; const char* nB = has_next ? (const char*)g.Bt + (size_t)nxt.pn * tsB : cB;
        for (int t = 0; t < nt; t += 2) {
            const bool last = (t == nt - 2);
            const char* a1 = cA + (size_t)(t + 1) * kstep;
            const char* a2 = last ? nA : cA + (size_t)(t + 2) * kstep; const char* b2 = last ? nB : cB + (size_t)(t + 2) * kstep;
            const char* a3 = a2 + kstep; const char* b3 = b2 + kstep;
            if (last && has_next) S.a_ready(nxt);
            if constexpr (Epi::HAS_MID) { if (t > 0 && (t & 15) == 0) E.mid(acc, cur, t >> 4, wr, wc, fr, fq); }
            if constexpr (Epi::RS) { if (t == thook) {
                const int ln_ = lane_id();
                __builtin_amdgcn_global_load_lds((const unsigned*)((const char*)(E.rsqp + (size_t)cur.pm * BM * 8) + ldsw + ln_ * 16), (LAS unsigned*)(lds + RS_OFF + ldsw), 16, 0, 0);
                if constexpr (!Epi::NO_BIAS) { if (wid == 0) __builtin_amdgcn_global_load_lds((const unsigned*)((const char*)(E.bias + cur.pn * BM) + ln_ * 16), (LAS unsigned*)(lds + RS_OFF + 8192), 16, 0, 0); } } }
            PG8_LDB(B0, 0, 0); PG8_LDB(B1, 0, 1); PG8_SCHED; PG8_LDA(At, 0, 0); PG8_STAGE(PG8_SA(1, 1), a1 + hsA, voffA);
            PG8_WAIT_V(8); PG8_WAIT_L(0); PG8_BAR; PG8_MMA(0, 0, At, B0); PG8_MMA(0, 1, At, B1); PG8_BAR; PG8_SCHED;
            PG8_LDA(At, 0, 1); PG8_STAGE(PG8_SB(0, 0), b2, voffB); PG8_STAGE(PG8_SB(0, 1), b2 + hsB, voffB); PG8_STAGE(PG8_SA(0, 0), a2, voffA);
            PG8_WAIT_V(8); PG8_WAIT_L(0); PG8_BAR; PG8_MMA(1, 0, At, B0); PG8_MMA(1, 1, At, B1); PG8_BAR; PG8_SCHED;
            PG8_LDB(B0, 1, 0); PG8_LDB(B1, 1, 1); PG8_SCHED; PG8_LDA(At, 1, 0); PG8_STAGE(PG8_SA(0, 1), a2 + hsA, voffA);
            PG8_WAIT_V(8); PG8_WAIT_L(0); PG8_BAR; PG8_MMA(0, 0, At, B0); PG8_MMA(0, 1, At, B1); PG8_BAR; PG8_SCHED;
            PG8_LDA(At, 1, 1); PG8_STAGE(PG8_SB(1, 0), b3, voffB); PG8_STAGE(PG8_SB(1, 1), b3 + hsB, voffB); PG8_STAGE(PG8_SA(1, 0), a3, voffA);
            PG8_WAIT_V(8); PG8_WAIT_L(0); PG8_BAR; PG8_MMA(1, 0, At, B0); PG8_MMA(1, 1, At, B1); PG8_BAR; PG8_SCHED;
        }
        if (wr == 0) PG8_BAR;
        if constexpr (Epi::RS) E(acc, cur, wr, wc, fr, fq, (const LAS float*)(lds + RS_OFF), (const LAS float*)(lds + RS_OFF + 8192), (LAS float*)(lds + RS_OFF + 9216)); else E(acc, cur, wr, wc, fr, fq);
        S.done(cur);
        if constexpr (Epi::RS) { if constexpr (Epi::RSO) { if (cur.pn >= C_CQ / 256 && cur.pn <= C_CKV / 256) {
            asm volatile("s_waitcnt lgkmcnt(0)" ::: "memory"); PG8_BAR;
            const int t2 = wid * 64 + lane_id();
            if (t2 < BM) { const LAS float* pp = (const LAS float*)(lds + RS_OFF + 9216) + t2; const float sm = (pp[0] + pp[BM]) + (pp[2 * BM] + pp[3 * BM]);
                const bool ckv = cur.pn == C_CKV / 256; const int slot = ckv ? 0 : cur.pn - C_CQ / 256; float* rq = (ckv ? E.rq_ckv : E.rq_cq) + (size_t)(cur.pm * BM + t2) * 8;
                rq[slot] = sm;
                if (slot == 0) {
                    float zf; asm volatile("v_mov_b32 %0, 0" : "=v"(zf));
                    if (ckv) rq[1] = zf;
#pragma unroll
                    for (int z = 2; z < 8; ++z) rq[z] = zf; } } } } }
        if constexpr (Epi::RSQ_OUT) {
            asm volatile("s_waitcnt lgkmcnt(0)" ::: "memory"); PG8_BAR;
            const int t2 = wid * 64 + lane_id();
            if (t2 < BM) { const LAS float* pp = (const LAS float*)(lds + RS_OFF) + t2; E.rsqp[(size_t)(cur.pm * BM + t2) * 8 + cur.pn] = (pp[0] + pp[BM]) + (pp[2 * BM] + pp[3 * BM]); } }
        if (!has_next) break;
#pragma unroll
        for (int a = 0; a < 2; ++a)
#pragma unroll
            for (int b = 0; b < 2; ++b)
#pragma unroll
                for (int m = 0; m < 4; ++m)
#pragma unroll
                    for (int n = 0; n < 2; ++n) acc[a][b][m][n] = (f32x4){0.f, 0.f, 0.f, 0.f};
        cur = nxt; cA = nA; cB = nB; ++ui;
        if (wr == 1) PG8_BAR;
    }
    PG8_WAIT_V(0);
    PG8_BAR;
#undef PG8_SA
#undef PG8_SB
#undef PG8_STAGE
#undef PG8_LDA
#undef PG8_LDB
#undef PG8_MMA
#undef PG8_WAIT_V
#undef PG8_WAIT_L
#undef PG8_BAR
#undef PG8_SCHED
}
}

namespace att {
constexpr int NW = 8, QBLK = 32, KVBLK = 64, QB = 256;
constexpr int SHM_V = KVBLK * 128 * 2;
constexpr int NSLOT = 3, KSLOT = 64 * 192 * 2;
constexpr int L_V = 0, L_K = NSLOT * SHM_V, L_WS = L_K + NSLOT * KSLOT, L_BIAS = L_WS + NW * 64 * 4, L_FLAG = L_BIAS + 1024, L_QT = 0, L_END = L_FLAG + 256;
static_assert(L_END <= RING_BYTES, "attention LDS");
#define SBAR() __builtin_amdgcn_sched_barrier(0)
__device__ __forceinline__ int crow(int r, int hi) { return (r & 3) + 8 * (r >> 2) + 4 * hi; }
template <int RB> __device__ __forceinline__ int kaddr(int row, int blk, int c8) {
    const int sw = (RB == 256) ? (row & 7) : ((row >> 1) & 7);
    return row * RB + blk * 128 + ((c8 ^ sw) << 4);
}
template <int RB> __device__ __forceinline__ int kswz(int row, int colB) { return kaddr<RB>(row, colB >> 7, (colB >> 4) & 7); }
constexpr float THR = 11.0f;
__device__ __forceinline__ void partialSM(f32x16& p0, f32x16& p1, float& m_reg, float& mn, float& alpha) {
    float pmax = p0[0];
#pragma unroll
    for (int r = 1; r < 16; ++r) pmax = fmaxf(pmax, p0[r]);
#pragma unroll
    for (int r = 0; r < 16; ++r) pmax = fmaxf(pmax, p1[r]);
    { auto rr = __builtin_amdgcn_permlane32_swap(__float_as_uint(pmax), __float_as_uint(pmax), false, false);
      pmax = fmaxf(__uint_as_float(rr[0]), __uint_as_float(rr[1])); }
    if (__builtin_expect(__all(pmax - m_reg <= THR), 1)) { mn = m_reg; alpha = 1.f; }
    else { mn = fmaxf(m_reg, pmax); alpha = __builtin_amdgcn_exp2f(m_reg - mn); m_reg = mn; }
#pragma unroll
    for (int r = 0; r < 16; ++r) p0[r] = p0[r] - mn;
#pragma unroll
    for (int r = 0; r < 16; ++r) p1[r] = p1[r] - mn;
#pragma unroll
    for (int r = 0; r < 16; ++r) p0[r] = __builtin_amdgcn_exp2f(p0[r]);
}
#define PK4(P, BASE, OUT) do { unsigned a0 = cvt_pk_bf16(P[BASE + 0], P[BASE + 1]), a1 = cvt_pk_bf16(P[BASE + 2], P[BASE + 3]);   \
    unsigned b0 = cvt_pk_bf16(P[BASE + 4], P[BASE + 5]), b1 = cvt_pk_bf16(P[BASE + 6], P[BASE + 7]);                              \
    auto r0 = __builtin_amdgcn_permlane32_swap(a0, b0, false, false); auto r1 = __builtin_amdgcn_permlane32_swap(a1, b1, false, false); \
    u32x4 w = {r0[0], r1[0], r0[1], r1[1]}; OUT = *reinterpret_cast<bf16x8*>(&w); } while (0)
__device__ __forceinline__ void finishSM(f32x16& p0, f32x16& p1, float alpha, float& l_reg, bf16x8& pa0, bf16x8& pa1, bf16x8& pa2, bf16x8& pa3) {
#pragma unroll
    for (int r = 0; r < 16; ++r) p1[r] = __builtin_amdgcn_exp2f(p1[r]);
    float ps = 0;
#pragma unroll
    for (int r = 0; r < 16; ++r) ps += p0[r];
#pragma unroll
    for (int r = 0; r < 16; ++r) ps += p1[r];
    { auto rr = __builtin_amdgcn_permlane32_swap(__float_as_uint(ps), __float_as_uint(ps), false, false);
      ps = __uint_as_float(rr[0]) + __uint_as_float(rr[1]); }
    l_reg = l_reg * alpha + ps;
    PK4(p0, 0, pa0); PK4(p0, 8, pa1); PK4(p1, 0, pa2); PK4(p1, 8, pa3);
}
template <int DK, int QREG> __device__ __forceinline__ void qkt(f32x16& p0, f32x16& p1, const LAS char* Ks, const bf16x8* qr, const LAS char* qt, int r32, int hi) {
    constexpr int RB = DK * 2;
    p0 = f32x16{}; p1 = f32x16{};
#pragma unroll
    for (int d0 = 0; d0 < DK / 16; ++d0) { const int ka = kaddr<RB>(r32, d0 >> 2, 4 * hi + (d0 & 3));
        const bf16x8 b0 = *(const LAS bf16x8*)(Ks + ka);
        const bf16x8 b1 = *(const LAS bf16x8*)(Ks + ka + 32 * RB);
        bf16x8 qf;
        if (d0 < QREG) qf = qr[d0]; else qf = *(const LAS bf16x8*)(qt + kaddr<128>(r32, (d0 - QREG) >> 2, 4 * hi + (d0 & 3)));
        p0 = __builtin_amdgcn_mfma_f32_32x32x16_bf16(b0, qf, p0, 0, 0, 0);
        p1 = __builtin_amdgcn_mfma_f32_32x32x16_bf16(b1, qf, p1, 0, 0, 0); }
}
__device__ __forceinline__ int v_st(int k, int c) { const int kk = (k & ~0xC) | ((k & 4) << 1) | ((k & 8) >> 1); return ((kk >> 3) * 4 + (c >> 5)) * 512 + ((kk & 7) * 32 + (c & 31)) * 2; }
__device__ __forceinline__ int v_rd_base(int lane) { return ((lane & 3) << 3) | (((lane >> 2) & 3) << 6) | (((lane >> 4) & 1) << 5) | (((lane >> 5) & 1) << 8); }
constexpr int v_rd_off(int d0, int ks, int half) { return d0 * 512 + ks * 4096 + half * 2048; }
template <int OFF> __device__ __forceinline__ s16x4 tr_read(int vb) {
    s16x4 r; asm volatile("ds_read_b64_tr_b16 %0, %1 offset:%2" : "=&v"(r) : "v"(vb), "i"(OFF) : "memory"); return r;
}
template <int D0> __device__ __forceinline__ void pv_one(f32x16& od, int vb, bf16x8 pa0, bf16x8 pa1, bf16x8 pa2, bf16x8 pa3) {
    const s16x4 l0 = tr_read<v_rd_off(D0, 0, 0)>(vb), h0 = tr_read<v_rd_off(D0, 0, 1)>(vb), l1 = tr_read<v_rd_off(D0, 1, 0)>(vb), h1 = tr_read<v_rd_off(D0, 1, 1)>(vb);
    const s16x4 l2 = tr_read<v_rd_off(D0, 2, 0)>(vb), h2 = tr_read<v_rd_off(D0, 2, 1)>(vb), l3 = tr_read<v_rd_off(D0, 3, 0)>(vb), h3 = tr_read<v_rd_off(D0, 3, 1)>(vb);
    asm volatile("s_waitcnt lgkmcnt(0)" ::: "memory"); SBAR();
#define PKV(L, H) (bf16x8){L[0], L[1], L[2], L[3], H[0], H[1], H[2], H[3]}
    od = __builtin_amdgcn_mfma_f32_32x32x16_bf16(pa0, PKV(l0, h0), od, 0, 0, 0);
    od = __builtin_amdgcn_mfma_f32_32x32x16_bf16(pa1, PKV(l1, h1), od, 0, 0, 0);
    od = __builtin_amdgcn_mfma_f32_32x32x16_bf16(pa2, PKV(l2, h2), od, 0, 0, 0);
    od = __builtin_amdgcn_mfma_f32_32x32x16_bf16(pa3, PKV(l3, h3), od, 0, 0, 0);
#undef PKV
}
__device__ __forceinline__ void pv_d0(f32x16* o, int vb, bf16x8 pa0, bf16x8 pa1, bf16x8 pa2, bf16x8 pa3) {
    pv_one<0>(o[0], vb, pa0, pa1, pa2, pa3); pv_one<1>(o[1], vb, pa0, pa1, pa2, pa3); pv_one<2>(o[2], vb, pa0, pa1, pa2, pa3); pv_one<3>(o[3], vb, pa0, pa1, pa2, pa3);
}

struct KVSrc { const bf16* k0; int ldk0; const bf16* k1; int ldk1; const bf16* v; int ldv; };

template <int DK, int DK0> struct Stager {
    static constexpr int NK0 = DK0 / 64, NK1 = (DK - DK0) / 64, NKC = NK0 + NK1;
    static constexpr int CPR0 = DK0 / 8, CPR1 = (DK - DK0) / 8 > 0 ? (DK - DK0) / 8 : 1;
    const bf16* kb[NKC]; int kstride[NKC];
    int koff[NKC]; int klds[NKC];
    const bf16* vb; int vstride; int voff0, voff1, vst0, vst1;
    __device__ __forceinline__ void init(const KVSrc& s, int tid) {
#pragma unroll
        for (int i = 0; i < NK0; ++i) { const int c = tid + 512 * i, row = c / CPR0, ch = c % CPR0;
            kb[i] = s.k0; kstride[i] = 64 * s.ldk0; koff[i] = row * s.ldk0 + ch * 8; klds[i] = kswz<DK * 2>(row, ch * 16); }
#pragma unroll
        for (int i = 0; i < NK1; ++i) { const int c = tid + 512 * i, row = c / CPR1, ch = c % CPR1;
            kb[NK0 + i] = s.k1; kstride[NK0 + i] = 64 * s.ldk1; koff[NK0 + i] = row * s.ldk1 + ch * 8; klds[NK0 + i] = kswz<DK * 2>(row, DK0 * 2 + ch * 16); }
        const int sr = tid >> 4, sc = (tid & 15) * 8;
        vb = s.v; vstride = 64 * s.ldv; voff0 = sr * s.ldv + sc; voff1 = (32 + sr) * s.ldv + sc;
        vst0 = v_st(sr, sc); vst1 = v_st(32 + sr, sc);
    }
    __device__ __forceinline__ bf16x8 ldk(int i, int t) const { return *reinterpret_cast<const bf16x8*>(kb[i] + (size_t)t * kstride[i] + koff[i]); }
    __device__ __forceinline__ bf16x8 ldv0(int t) const { return *reinterpret_cast<const bf16x8*>(vb + (size_t)t * vstride + voff0); }
    __device__ __forceinline__ bf16x8 ldv1(int t) const { return *reinterpret_cast<const bf16x8*>(vb + (size_t)t * vstride + voff1); }
};

template <bool F32> __device__ __forceinline__ void store_o_staged(const f32x16 (&o)[4], const float* rl, LAS char* stg, float* Of, bf16* Ob, int ldo, int le) {
    const int r32e = le & 31, hie = le >> 5, rr0 = le >> 4, ch = le & 15;
    if constexpr (!F32) {
        LAS bf16* st = (LAS bf16*)stg;
#pragma unroll
        for (int r = 0; r < 16; ++r) { const int ro = (r & 3) + 8 * (r >> 2) + 4 * hie;
#pragma unroll
            for (int d0 = 0; d0 < 4; ++d0) { const float v = rl ? o[d0][r] * rl[r] : o[d0][r]; st[ro * 128 + d0 * 32 + r32e] = (bf16)(cvt_pk_bf16(v, v) & 0xffffu); } }
#pragma unroll
        for (int i = 0; i < 8; ++i) { const int row = i * 4 + rr0; const u32x4 v = *(const LAS u32x4*)(stg + row * 256 + ch * 16); *(u32x4*)(Ob + (size_t)row * ldo + ch * 8) = v; }
    } else {
        LAS float* st = (LAS float*)stg;
#pragma unroll
        for (int p = 0; p < 2; ++p) {
#pragma unroll
            for (int r = 0; r < 16; ++r) { const int ro = (r & 3) + 8 * (r >> 2) + 4 * hie;
#pragma unroll
                for (int dd = 0; dd < 2; ++dd) { const float v = rl ? o[2 * p + dd][r] * rl[r] : o[2 * p + dd][r]; st[ro * 64 + dd * 32 + r32e] = v; } }
#pragma unroll
            for (int i = 0; i < 8; ++i) { const int row = i * 4 + rr0; const f32x4 v = *(const LAS f32x4*)(stg + row * 256 + ch * 16); *(f32x4*)(Of + (size_t)row * ldo + p * 64 + ch * 4) = v; }
        }
    }
}
typedef short v4i16_t __attribute__((ext_vector_type(4)));
__device__ __forceinline__ s16x4 vtr(const LAS char* p) { return __builtin_bit_cast(s16x4, __builtin_amdgcn_ds_read_tr16_b64_v4i16((LAS v4i16_t*)p)); }
struct DaFin { const float* other; unsigned* cnt; float lam; const float* gsub; float omli; bool own_first; };
struct QPrep { const float* g; const float* rc; const float* rs; };
template <int DK, int DK0, bool BIAS, bool OUTF32, bool NEGM_, bool ILB, bool NOMAX = false, bool QPREP = false>
__device__ __forceinline__ void softmax_unit_v3(LAS char* lds, const bf16* Qb, int ldq, const KVSrc kv, int q0, float* Of, bf16* Ob, int ldo, const int wv, const DaFin fin = DaFin{}, const QPrep qp = QPrep{}) {
    constexpr int RB = DK * 2, NKCH = DK / 64, NQ = DK / 16, NM = 2 * NQ;
    constexpr bool NEGM = NEGM_ && !NOMAX;
    int tid = MYTID(wv); asm volatile("" : "+v"(tid));
    const int lane = tid & 63, r32 = lane & 31, hi = lane >> 5; const int wid = __builtin_amdgcn_readfirstlane(tid >> 6);
    LAS char* V_lds = lds + L_V; LAS char* K_lds = lds + L_K;
    LAS float* ws = (LAS float*)(lds + L_WS) + wid * 64; LAS float* li_l = ws; LAS float* al_l = ws + 32;
    const LAS float* tbl = (const LAS float*)(lds + L_BIAS);
    const bf16* kptr[NKCH]; int kstr[NKCH]; const bf16* vptr[2]; const int vstr = 64 * kv.ldv;
#pragma unroll
    for (int i = 0; i < NKCH; ++i) { const int p = (wid + 8 * i) * 1024 + lane * 16, row = p / RB, within = p - row * RB, blk = within >> 7;
        const int sw = (RB == 256) ? (row & 7) : ((row >> 1) & 7); const int c8 = ((within >> 4) & 7) ^ sw, col = (blk * 8 + c8) * 8;
        if (col < DK0) { kptr[i] = kv.k0 + (size_t)row * kv.ldk0 + col; kstr[i] = 64 * kv.ldk0; }
        else { kptr[i] = kv.k1 + (size_t)row * kv.ldk1 + (col - DK0); kstr[i] = 64 * kv.ldk1; } }
#pragma unroll
    for (int i = 0; i < 2; ++i) { const int p = (wid + 8 * i) * 1024 + lane * 16, sub = p >> 9, within = p & 511;
        const int kk = (sub >> 2) * 8 + (within >> 6), c = (sub & 3) * 32 + ((within & 63) >> 1);
        vptr[i] = kv.v + (size_t)kk * kv.ldv + c; }

#define DMA_TILE(slot) do { \
    _Pragma("unroll") for (int i_ = 0; i_ < NKCH; ++i_) { __builtin_amdgcn_global_load_lds((const unsigned*)kptr[i_], (LAS unsigned*)(K_lds + (slot) * KSLOT + (wid + 8 * i_) * 1024), 16, 0, 0); kptr[i_] += kstr[i_]; } \
    _Pragma("unroll") for (int i_ = 0; i_ < 2; ++i_) { __builtin_amdgcn_global_load_lds((const unsigned*)vptr[i_], (LAS unsigned*)(V_lds + (slot) * SHM_V + (wid + 8 * i_) * 1024), 16, 0, 0); vptr[i_] += vstr; } } while (0)
#define WAIT_BAR() asm volatile("s_waitcnt vmcnt(0) lgkmcnt(0)\n\ts_barrier" ::: "memory")
    DMA_TILE(0); DMA_TILE(1);
    float m_reg, l_reg = 0.f; f32x16 o[4] = {}; bf16x8 qr[NQ];
    const bf16* Qw = Qb + (size_t)(wid * QBLK + r32) * ldq + hi * 32;
#pragma unroll
    for (int d0 = 0; d0 < NQ; ++d0) qr[d0] = *reinterpret_cast<const bf16x8*>(Qw + (d0 >> 2) * 64 + (d0 & 3) * 8);
    if constexpr (QPREP) {
        static_assert(!QPREP || DK == 192, "QPREP: MLA head layout");
        float ssn = 0.f, ssp = 0.f;
#pragma unroll
        for (int d0 = 0; d0 < 12; ++d0)
#pragma unroll
            for (int e = 0; e < 8; ++e) { const float x = bf1((bf16)qr[d0][e]); if (d0 < 8) ssn += x * x; else ssp += x * x; }
        const float rn = rsq(half_sum(ssn) * (1.f / 128.f) + EPS) * SC_MLA, rp = rsq(half_sum(ssp) * (1.f / 64.f) + EPS) * SC_MLA;
        const int prow = q0 + wid * QBLK + r32;
#pragma unroll
        for (int d0 = 0; d0 < 12; ++d0) { const int col = (d0 >> 2) * 64 + hi * 32 + (d0 & 3) * 8;
            const f32x4 ga = *(const f32x4*)(qp.g + col), gb = *(const f32x4*)(qp.g + col + 4);
            float y[8];
#pragma unroll
            for (int e = 0; e < 8; ++e) y[e] = bf1((bf16)qr[d0][e]) * (d0 < 8 ? rn : rp) * (e < 4 ? ga[e] : gb[e - 4]);
            if (d0 >= 8) { const int i0 = (d0 & 3) * 8;
                const f32x4 ca = *(const f32x4*)(qp.rc + (size_t)prow * 32 + i0), cb = *(const f32x4*)(qp.rc + (size_t)prow * 32 + i0 + 4);
                const f32x4 sa = *(const f32x4*)(qp.rs + (size_t)prow * 32 + i0), sb = *(const f32x4*)(qp.rs + (size_t)prow * 32 + i0 + 4);
#pragma unroll
                for (int e = 0; e < 8; ++e) { auto rr = __builtin_amdgcn_permlane32_swap(__float_as_uint(y[e]), __float_as_uint(y[e]), false, false);
                    const float yp = __uint_as_float(hi ? rr[0] : rr[1]); const float c = e < 4 ? ca[e] : cb[e - 4], sn = e < 4 ? sa[e] : sb[e - 4];
                    y[e] = hi ? (yp * sn + y[e] * c) : (y[e] * c - yp * sn); } }
            u32x4 w; w.x = cvt_pk_bf16(y[0], y[1]); w.y = cvt_pk_bf16(y[2], y[3]); w.z = cvt_pk_bf16(y[4], y[5]); w.w = cvt_pk_bf16(y[6], y[7]);
            qr[d0] = __builtin_bit_cast(bf16x8, w); }
    }
    const LAS char* vrd = V_lds + v_rd_base(lane);
    const LAS char* krd[4];
#pragma unroll
    for (int j = 0; j < 4; ++j) krd[j] = K_lds + kaddr<RB>(r32, 0, 4 * hi + j);
    const int NT = q0 / KVBLK + 4;
    const int cw = q0 / KVBLK + (wid >> 1);
    const int tq = q0 + wid * QBLK + r32 + 64 - 4 * hi;
#define POST(P0, P1, jj) do { if ((jj) > cw) { float ni_ = -1e30f; asm volatile("" : "+v"(ni_));     \
        _Pragma("unroll") for (int r = 0; r < 16; ++r) { P0[r] = ni_; P1[r] = ni_; } } \
    else if (BIAS && (jj) >= cw - 2) { const int tb_ = tq - 64 * (jj); \
        _Pragma("unroll") for (int r = 0; r < 16; ++r) { const int kk_ = (r & 3) + 8 * (r >> 2); P0[r] += tbl[tb_ - kk_]; P1[r] += tbl[tb_ - kk_ - 32]; } } } while (0)
#define ROWMAX(P0, P1) ({ float a_ = fmaxf(fmaxf(P0[0], P0[1]), P1[0]), b_ = fmaxf(fmaxf(P0[2], P0[3]), P1[1]); a_ = fmaxf(fmaxf(a_, P1[2]), P1[3]); \
    _Pragma("unroll") for (int r = 4; r < 16; r += 4) { a_ = fmaxf(fmaxf(a_, P0[r]), P0[r + 1]); b_ = fmaxf(fmaxf(b_, P0[r + 2]), P0[r + 3]); a_ = fmaxf(fmaxf(a_, P1[r]), P1[r + 1]); b_ = fmaxf(fmaxf(b_, P1[r + 2]), P1[r + 3]); } \
    float m_ = fmaxf(a_, b_); auto rr_ = __builtin_amdgcn_permlane32_swap(__float_as_uint(m_), __float_as_uint(m_), false, false); fmaxf(__uint_as_float(rr_[0]), __uint_as_float(rr_[1])); })
    f32x16 pA0, pA1, pB0, pB1; u32x4 pw[4];
    WAIT_BAR();
    { pA0 = f32x16{}; pA1 = f32x16{};
#pragma unroll
      for (int d0 = 0; d0 < NQ; ++d0) { const bf16x8 b0 = *(const LAS bf16x8*)(krd[d0 & 3] + (d0 >> 2) * 128), b1 = *(const LAS bf16x8*)(krd[d0 & 3] + (d0 >> 2) * 128 + 32 * RB);
          pA0 = __builtin_amdgcn_mfma_f32_32x32x16_bf16(b0, qr[d0], pA0, 0, 0, 0); pA1 = __builtin_amdgcn_mfma_f32_32x32x16_bf16(b1, qr[d0], pA1, 0, 0, 0); }
      POST(pA0, pA1, 0);
      if constexpr (NOMAX) m_reg = 0.f; else m_reg = ROWMAX(pA0, pA1);
#pragma unroll
      for (int r = 0; r < 16; ++r) { pA0[r] = __builtin_amdgcn_exp2f(NOMAX ? pA0[r] : pA0[r] - m_reg); pA1[r] = __builtin_amdgcn_exp2f(NOMAX ? pA1[r] : pA1[r] - m_reg); } }
    f32x16 negm;
    if constexpr (NEGM) {
#pragma unroll
        for (int r = 0; r < 16; ++r) negm[r] = -m_reg;
        asm volatile("" : "+v"(negm)); }
    int s_prev = 0, s_cur = 1, s_next = 2;
#define ROT() do { const int t_ = s_prev; s_prev = s_cur; s_cur = s_next; s_next = t_; } while (0)
    unsigned ta0, ta1;
#define SLICE(Y0, Y1, s_) do { constexpr int g_ = (s_) >> 1, bs_ = (g_ & 1) * 8 + ((s_) & 1) * 4; \
        const float y0_ = (g_ < 2) ? Y0[bs_] : Y1[bs_], y1_ = (g_ < 2) ? Y0[bs_ + 1] : Y1[bs_ + 1], y2_ = (g_ < 2) ? Y0[bs_ + 2] : Y1[bs_ + 2], y3_ = (g_ < 2) ? Y0[bs_ + 3] : Y1[bs_ + 3]; \
        sacc0 += y0_; sacc1 += y1_; sacc0 += y2_; sacc1 += y3_; \
        if (((s_) & 1) == 0) { ta0 = cvt_pk_bf16(y0_, y1_); ta1 = cvt_pk_bf16(y2_, y3_); } \
        else { const unsigned tb0_ = cvt_pk_bf16(y0_, y1_), tb1_ = cvt_pk_bf16(y2_, y3_); \
               pw[g_] = (u32x4){ta0, ta1, tb0_, tb1_}; } } while (0)
#define PIN(x) asm volatile("" : "+v"(x))
#define KFRAG(i_) (*(const LAS bf16x8*)(krd[((i_) >> 1) & 3] + kso_ + ((i_) >> 3) * 128 + ((i_) & 1) * 32 * RB))
#define VLO(i_) vtr(vb_ + v_rd_off((i_) & 3, (i_) >> 2, 0))
#define VHI(i_) vtr(vb_ + v_rd_off((i_) & 3, (i_) >> 2, 1))
#define EXPX(XV, e_) XV[e_] = __builtin_amdgcn_exp2f((NEGM || NOMAX) ? XV[e_] : XV[e_] - m_reg)
#define PVX(D0, XV, B_, vba) do { \
        const s16x4 l0_ = tr_read<v_rd_off(D0, 0, 0)>(vba), h0_ = tr_read<v_rd_off(D0, 0, 1)>(vba), l1_ = tr_read<v_rd_off(D0, 1, 0)>(vba), h1_ = tr_read<v_rd_off(D0, 1, 1)>(vba); \
        const s16x4 l2_ = tr_read<v_rd_off(D0, 2, 0)>(vba), h2_ = tr_read<v_rd_off(D0, 2, 1)>(vba), l3_ = tr_read<v_rd_off(D0, 3, 0)>(vba), h3_ = tr_read<v_rd_off(D0, 3, 1)>(vba); \
        asm volatile("s_waitcnt lgkmcnt(0)" ::: "memory"); SBAR(); \
        o[D0] = __builtin_amdgcn_mfma_f32_32x32x16_bf16(__builtin_bit_cast(bf16x8, pw[0]), (bf16x8){l0_[0], l0_[1], l0_[2], l0_[3], h0_[0], h0_[1], h0_[2], h0_[3]}, o[D0], 0, 0, 0); EXPX(XV, B_ + 0); EXPX(XV, B_ + 1); PIN(XV); SBAR(); \
        o[D0] = __builtin_amdgcn_mfma_f32_32x32x16_bf16(__builtin_bit_cast(bf16x8, pw[1]), (bf16x8){l1_[0], l1_[1], l1_[2], l1_[3], h1_[0], h1_[1], h1_[2], h1_[3]}, o[D0], 0, 0, 0); EXPX(XV, B_ + 2); EXPX(XV, B_ + 3); PIN(XV); SBAR(); \
        o[D0] = __builtin_amdgcn_mfma_f32_32x32x16_bf16(__builtin_bit_cast(bf16x8, pw[2]), (bf16x8){l2_[0], l2_[1], l2_[2], l2_[3], h2_[0], h2_[1], h2_[2], h2_[3]}, o[D0], 0, 0, 0); EXPX(XV, B_ + 4); EXPX(XV, B_ + 5); PIN(XV); SBAR(); \
        o[D0] = __builtin_amdgcn_mfma_f32_32x32x16_bf16(__builtin_bit_cast(bf16x8, pw[3]), (bf16x8){l3_[0], l3_[1], l3_[2], l3_[3], h3_[0], h3_[1], h3_[2], h3_[3]}, o[D0], 0, 0, 0); EXPX(XV, B_ + 6); EXPX(XV, B_ + 7); PIN(XV); SBAR(); } while (0)
#define TRF(i_, vba) do { tl_[i_] = tr_read<v_rd_off((i_) >> 2, (i_) & 3, 0)>(vba); th_[i_] = tr_read<v_rd_off((i_) >> 2, (i_) & 3, 1)>(vba); } while (0)
#define PVM(i_, XV, B_, vba) do { \
        if ((i_) + 2 < 16) { TRF(((i_) + 2 < 16 ? (i_) + 2 : 15), vba); asm volatile("s_waitcnt lgkmcnt(4)" ::: "memory"); } \
        else if ((i_) + 1 < 16) asm volatile("s_waitcnt lgkmcnt(2)" ::: "memory"); else asm volatile("s_waitcnt lgkmcnt(0)" ::: "memory"); \
        SBAR(); \
        o[(i_) >> 2] = __builtin_amdgcn_mfma_f32_32x32x16_bf16(__builtin_bit_cast(bf16x8, pw[(i_) & 3]), (bf16x8){tl_[i_][0], tl_[i_][1], tl_[i_][2], tl_[i_][3], th_[i_][0], th_[i_][1], th_[i_][2], th_[i_][3]}, o[(i_) >> 2], 0, 0, 0); \
        EXPX(XV, B_); EXPX(XV, B_ + 1); PIN(XV); SBAR(); } while (0)
#define STEP(X0, X1, Y0, Y1, jj, HASNEXT) do { \
        const int kso_ = s_cur * KSLOT; const LAS char* vb_ = vrd + s_prev * SHM_V; \
        float sacc0 = 0.f, sacc1 = 0.f; \
        bf16x8 kf_[NM]; s16x4 vl_[16], vh_[16]; \
        SBAR(); \
        kf_[0] = KFRAG(0); kf_[1] = KFRAG(1); kf_[2] = KFRAG(2); SBAR(); \
          \
        _Pragma("unroll") for (int i_ = 0; i_ < NM; ++i_) { const int d0_ = i_ >> 1; \
            if (i_ + 3 < NM) kf_[i_ + 3] = KFRAG(i_ + 3); \
            if ((i_ & 1) == 0) X0 = __builtin_amdgcn_mfma_f32_32x32x16_bf16(kf_[i_], qr[d0_], (d0_ == 0) ? (NEGM ? negm : f32x16{}) : X0, 0, 0, 0); \
            else               X1 = __builtin_amdgcn_mfma_f32_32x32x16_bf16(kf_[i_], qr[d0_], (d0_ == 0) ? (NEGM ? negm : f32x16{}) : X1, 0, 0, 0); \
            if ((0 * NM) / 8 == i_) SLICE(Y0, Y1, 0); if ((1 * NM) / 8 == i_) SLICE(Y0, Y1, 1); if ((2 * NM) / 8 == i_) SLICE(Y0, Y1, 2); if ((3 * NM) / 8 == i_) SLICE(Y0, Y1, 3); \
            if ((4 * NM) / 8 == i_) SLICE(Y0, Y1, 4); if ((5 * NM) / 8 == i_) SLICE(Y0, Y1, 5); if ((6 * NM) / 8 == i_) SLICE(Y0, Y1, 6); if ((7 * NM) / 8 == i_) SLICE(Y0, Y1, 7); \
            PIN(sacc0); PIN(sacc1); SBAR(); } \
        l_reg += sacc0 + sacc1; \
        POST(X0, X1, jj); \
          \
        bool resc_ = false; \
        if constexpr (!NOMAX) { const float rm_ = ROWMAX(X0, X1); \
          if constexpr (NEGM) {              \
            if (__builtin_expect(__any(rm_ > THR), 0)) { const float dl_ = fmaxf(rm_, 0.f); const float al_ = __builtin_amdgcn_exp2f(-dl_); m_reg += dl_; l_reg *= al_; \
                _Pragma("unroll") for (int r = 0; r < 16; ++r) { X0[r] -= dl_; X1[r] -= dl_; negm[r] = -m_reg; } \
                { const int l2_ = lane_id(); if ((l2_ >> 5) == 0) al_l[l2_ & 31] = al_; } resc_ = true; } \
          } else { \
            if (__builtin_expect(__any(rm_ - m_reg > THR), 0)) { const float mn_ = fmaxf(m_reg, rm_); const float al_ = __builtin_amdgcn_exp2f(m_reg - mn_); m_reg = mn_; l_reg *= al_; \
                { const int l2_ = lane_id(); if ((l2_ >> 5) == 0) al_l[l2_ & 31] = al_; } resc_ = true; } } } \
        if (HASNEXT) DMA_TILE(s_next);     \
        PIN(X0); PIN(X1); SBAR(); \
        if constexpr (ILB) { \
        vl_[0] = VLO(0); vh_[0] = VHI(0); vl_[1] = VLO(1); vh_[1] = VHI(1); vl_[2] = VLO(2); vh_[2] = VHI(2); SBAR(); \
          \
        _Pragma("unroll") for (int i_ = 0; i_ < 16; ++i_) { const int ks_ = i_ >> 2, d0_ = i_ & 3; \
            if (i_ + 3 < 16) { vl_[i_ + 3] = VLO(i_ + 3); vh_[i_ + 3] = VHI(i_ + 3); } \
            const bf16x8 vf_ = (bf16x8){vl_[i_][0], vl_[i_][1], vl_[i_][2], vl_[i_][3], vh_[i_][0], vh_[i_][1], vh_[i_][2], vh_[i_][3]}; \
            o[d0_] = __builtin_amdgcn_mfma_f32_32x32x16_bf16(__builtin_bit_cast(bf16x8, pw[ks_]), vf_, o[d0_], 0, 0, 0); \
            if (i_ < 8) { X0[2 * i_] = __builtin_amdgcn_exp2f(NEGM ? X0[2 * i_] : X0[2 * i_] - m_reg); X0[2 * i_ + 1] = __builtin_amdgcn_exp2f(NEGM ? X0[2 * i_ + 1] : X0[2 * i_ + 1] - m_reg); PIN(X0); } \
            else { X1[2 * i_ - 16] = __builtin_amdgcn_exp2f(NEGM ? X1[2 * i_ - 16] : X1[2 * i_ - 16] - m_reg); X1[2 * i_ - 15] = __builtin_amdgcn_exp2f(NEGM ? X1[2 * i_ - 15] : X1[2 * i_ - 15] - m_reg); PIN(X1); } \
            SBAR(); } \
        } else { \
        const int vba_ = (int)(unsigned)(uintptr_t)vrd + s_prev * SHM_V; \
        s16x4 tl_[16], th_[16]; \
        TRF(0, vba_); TRF(1, vba_); \
        PVM(0, X0, 0, vba_); PVM(1, X0, 2, vba_); PVM(2, X0, 4, vba_); PVM(3, X0, 6, vba_); PVM(4, X0, 8, vba_); PVM(5, X0, 10, vba_); PVM(6, X0, 12, vba_); PVM(7, X0, 14, vba_); \
        PVM(8, X1, 0, vba_); PVM(9, X1, 2, vba_); PVM(10, X1, 4, vba_); PVM(11, X1, 6, vba_); PVM(12, X1, 8, vba_); PVM(13, X1, 10, vba_); PVM(14, X1, 12, vba_); PVM(15, X1, 14, vba_); } \
        if (resc_) { asm volatile("s_waitcnt lgkmcnt(0)" ::: "memory"); \
            const int h2_ = lane_id() >> 5;     \
            _Pragma("unroll") for (int d = 0; d < 4; ++d) _Pragma("unroll") for (int r = 0; r < 16; ++r) o[d][r] *= al_l[crow(r, h2_)]; } \
        WAIT_BAR(); ROT(); } while (0)
    for (int j = 1; j + 1 < NT; j += 2) {
        STEP(pB0, pB1, pA0, pA1, j, true);
        STEP(pA0, pA1, pB0, pB1, j + 1, true);
    }
    STEP(pB0, pB1, pA0, pA1, NT - 1, false);
    { float sacc0 = 0.f, sacc1 = 0.f;
      SLICE(pB0, pB1, 0); SLICE(pB0, pB1, 1); SLICE(pB0, pB1, 2); SLICE(pB0, pB1, 3); SLICE(pB0, pB1, 4); SLICE(pB0, pB1, 5); SLICE(pB0, pB1, 6); SLICE(pB0, pB1, 7);
      l_reg += sacc0 + sacc1;
      const LAS char* vb_ = vrd + s_prev * SHM_V;
#pragma unroll
      for (int i_ = 0; i_ < 16; ++i_) { const int ks_ = i_ >> 2, d0_ = i_ & 3;
          const s16x4 vl_ = vtr(vb_ + v_rd_off(d0_, ks_, 0)), vh_ = vtr(vb_ + v_rd_off(d0_, ks_, 1));
          const bf16x8 vf_ = (bf16x8){vl_[0], vl_[1], vl_[2], vl_[3], vh_[0], vh_[1], vh_[2], vh_[3]};
          o[d0_] = __builtin_amdgcn_mfma_f32_32x32x16_bf16(__builtin_bit_cast(bf16x8, pw[ks_]), vf_, o[d0_], 0, 0, 0); } }
    l_reg = half_sum(l_reg);
    { const int l3_ = lane_id(); if ((l3_ >> 5) == 0) li_l[l3_ & 31] = l_reg; } asm volatile("s_waitcnt lgkmcnt(0)" ::: "memory");
    { const int le = lane_id(), hie = le >> 5;
      float rl[16];
#pragma unroll
      for (int r = 0; r < 16; ++r) rl[r] = __builtin_amdgcn_rcpf(li_l[(r & 3) + 8 * (r >> 2) + 4 * hie]);
      if constexpr (!OUTF32) store_o_staged<false>(o, rl, K_lds + wid * 8192, nullptr, Ob + (size_t)(wid * QBLK) * ldo, ldo, le);
      else {
#pragma unroll
        for (int d0 = 0; d0 < 4; ++d0)
#pragma unroll
            for (int r = 0; r < 16; ++r) o[d0][r] *= rl[r];
        float* so = Of + (size_t)wid * 4096 + le * 4;
#pragma unroll
        for (int d0 = 0; d0 < 4; ++d0)
#pragma unroll
            for (int rq = 0; rq < 4; ++rq) *(f32x4*)(so + (4 * d0 + rq) * 256) = (f32x4){o[d0][4 * rq], o[d0][4 * rq + 1], o[d0][4 * rq + 2], o[d0][4 * rq + 3]};
        volatile LAS unsigned* flg = (volatile LAS unsigned*)(lds + L_FLAG);
        asm volatile("s_waitcnt vmcnt(0)" ::: "memory");
        __syncthreads();
        if (wid == 0 && le == 0) { __builtin_amdgcn_fence(__ATOMIC_RELEASE, "agent");
            const unsigned old = __hip_atomic_fetch_add(fin.cnt, 1u, __ATOMIC_RELAXED, __HIP_MEMORY_SCOPE_AGENT);
            if (old & 1u) __builtin_amdgcn_fence(__ATOMIC_ACQUIRE, "agent");
            flg[8] = old & 1u; }
        __syncthreads();
        if (flg[8]) {
            const float* po = fin.other + (size_t)wid * 4096 + le * 4;
            f32x4 pv[4][4];
#pragma unroll
            for (int d0 = 0; d0 < 4; ++d0)
#pragma unroll
                for (int rq = 0; rq < 4; ++rq) pv[d0][rq] = *(const f32x4*)(po + (4 * d0 + rq) * 256);
            float gs[4];
#pragma unroll
            for (int d0 = 0; d0 < 4; ++d0) gs[d0] = fin.gsub[32 * d0 + (le & 31)] * fin.omli;
#pragma unroll
            for (int r = 0; r < 16; ++r) { float ss = 0.f;
#pragma unroll
                for (int d0 = 0; d0 < 4; ++d0) { const float pp = pv[d0][r >> 2][r & 3]; const float dv = fin.own_first ? o[d0][r] - fin.lam * pp : pp - fin.lam * o[d0][r]; o[d0][r] = dv; ss += dv * dv; }
                ss += swz<1>(ss); ss += swz<2>(ss); ss += swz<4>(ss); ss += swz<8>(ss); ss += swz<16>(ss);
                const float rn = rsq(ss * (1.f / 128.f) + EPS);
#pragma unroll
                for (int d0 = 0; d0 < 4; ++d0) o[d0][r] = o[d0][r] * rn * gs[d0]; }
            store_o_staged<false>(o, nullptr, K_lds + wid * 8192, nullptr, Ob + (size_t)(wid * QBLK) * ldo, ldo, le);
        }
      } }
    asm volatile("s_waitcnt lgkmcnt(0)\n\ts_barrier" ::: "memory");
#undef DMA_TILE
#undef WAIT_BAR
#undef POST
#undef ROWMAX
#undef ROT
#undef SLICE
#undef STEP
#undef PVX
#undef PVM
#undef TRF
#undef EXPX
#undef PIN
#undef KFRAG
#undef VLO
#undef VHI
}

__device__ __forceinline__ void sb_unit(LAS char* lds, const bf16* Qb, int ldq, const KVSrc kv, int q0, bf16* Ob, int ldo, const int wv) {
    constexpr int DK = 128, SHM_K = 64 * DK * 2;
    int tid = MYTID(wv); asm volatile("" : "+v"(tid));
    const int lane = tid & 63, r32 = lane & 31, hi = lane >> 5; const int wid = __builtin_amdgcn_readfirstlane(tid >> 6);
    LAS char* V_lds = lds + L_V; LAS char* K_lds = lds + L_K;
    volatile LAS unsigned* flags = (volatile LAS unsigned*)(lds + L_FLAG);
    f32x16 o[4] = {}; bf16x8 qr[8];
    const bf16* Qw = Qb + (size_t)(wid * QBLK + r32) * ldq + hi * 32;
#pragma unroll
    for (int d0 = 0; d0 < 8; ++d0) qr[d0] = *reinterpret_cast<const bf16x8*>(Qw + (d0 >> 2) * 64 + (d0 & 3) * 8);
    Stager<128, 128> st; st.init(kv, tid);
    const int vb0 = (int)(unsigned)(uintptr_t)V_lds + v_rd_base(lane);
    const int cw = q0 / KVBLK + (wid >> 1);
    const int lim = 32 * (wid & 1) + r32;
    float R = 0.f; bool alive = true;
    bf16x8 vs0, vs1, ks0, ks1;
    int j = q0 / KVBLK + 3;
    vs0 = st.ldv0(j); vs1 = st.ldv1(j); ks0 = st.ldk(0, j); ks1 = st.ldk(1, j);
    for (; j >= 0; --j) {
        __syncthreads();
        *(LAS bf16x8*)(V_lds + st.vst0) = vs0; *(LAS bf16x8*)(V_lds + st.vst1) = vs1; *(LAS bf16x8*)(K_lds + st.klds[0]) = ks0; *(LAS bf16x8*)(K_lds + st.klds[1]) = ks1;
        __syncthreads();
        if (j > 0) { const int jn = j - 1;
            vs0 = st.ldv0(jn); vs1 = st.ldv1(jn); ks0 = st.ldk(0, jn); ks1 = st.ldk(1, jn); }
        if (j <= cw && alive) {
            f32x16 z0, z1, m0, m1;
            qkt<128, 8>(z0, z1, K_lds, qr, K_lds, r32, hi);
#pragma unroll
            for (int r = 0; r < 16; ++r) { z0[r] *= SC_SB; z1[r] *= SC_SB; }
            const bool diag = (j == cw);
#pragma unroll
            for (int r = 0; r < 16; ++r) {
                { const float zl = z0[r], e = __builtin_amdgcn_exp2f(-fabsf(zl)); const float l1p = (e < 2.44140625e-4f) ? e * LOG2E * (1.f - 0.5f * e) : __builtin_amdgcn_logf(1.f + e);
                  m0[r] = -(fmaxf(zl, 0.f) + l1p); }
                { const float zl = z1[r], e = __builtin_amdgcn_exp2f(-fabsf(zl)); const float l1p = (e < 2.44140625e-4f) ? e * LOG2E * (1.f - 0.5f * e) : __builtin_amdgcn_logf(1.f + e);
                  m1[r] = -(fmaxf(zl, 0.f) + l1p); }
            }
            if (diag) {
#pragma unroll
                for (int r = 0; r < 16; ++r) { const int kk = crow(r, hi);
                    if (!(kk < lim)) { m0[r] = 0.f; z0[r] = -1e30f; }
                    if (!(kk + 32 < lim)) { m1[r] = 0.f; z1[r] = -1e30f; } }
            }
            float Glo[8], Ghi[8];
#pragma unroll
            for (int i = 0; i < 8; ++i) { const float gs = (i < 4) ? (m0[4 * i] + m0[4 * i + 1]) + (m0[4 * i + 2] + m0[4 * i + 3])
                                                                   : (m1[4 * (i - 4)] + m1[4 * (i - 4) + 1]) + (m1[4 * (i - 4) + 2] + m1[4 * (i - 4) + 3]);
                auto rr = __builtin_amdgcn_permlane32_swap(__float_as_uint(gs), __float_as_uint(gs), false, false);
                Glo[i] = __uint_as_float(rr[0]); Ghi[i] = __uint_as_float(rr[1]); }
            float sa_odd = 0.f, sa_even = Ghi[7]; float base[8];
            base[7] = R + (hi ? sa_odd : sa_even);
#pragma unroll
            for (int i = 6; i >= 0; --i) { sa_odd = sa_even + Glo[i + 1]; sa_even = sa_odd + Ghi[i]; base[i] = R + (hi ? sa_odd : sa_even); }
            const float total = sa_even + Glo[0];
#pragma unroll
            for (int i = 0; i < 8; ++i) {
                if (i < 4) { const int b = 4 * i; float bt = base[i];
                    const float w3 = __builtin_amdgcn_exp2f(z0[b + 3] + m0[b + 3] + bt); bt += m0[b + 3];
                    const float w2 = __builtin_amdgcn_exp2f(z0[b + 2] + m0[b + 2] + bt); bt += m0[b + 2];
                    const float w1 = __builtin_amdgcn_exp2f(z0[b + 1] + m0[b + 1] + bt); bt += m0[b + 1];
                    const float w0 = __builtin_amdgcn_exp2f(z0[b] + m0[b] + bt);
                    z0[b] = w0; z0[b + 1] = w1; z0[b + 2] = w2; z0[b + 3] = w3; }
                else { const int b = 4 * (i - 4); float bt = base[i];
                    const float w3 = __builtin_amdgcn_exp2f(z1[b + 3] + m1[b + 3] + bt); bt += m1[b + 3];
                    const float w2 = __builtin_amdgcn_exp2f(z1[b + 2] + m1[b + 2] + bt); bt += m1[b + 2];
                    const float w1 = __builtin_amdgcn_exp2f(z1[b + 1] + m1[b + 1] + bt); bt += m1[b + 1];
                    const float w0 = __builtin_amdgcn_exp2f(z1[b] + m1[b] + bt);
                    z1[b] = w0; z1[b + 1] = w1; z1[b + 2] = w2; z1[b + 3] = w3; }
            }
            R += total;
            bf16x8 pa0, pa1, pa2, pa3;
            PK4(z0, 0, pa0); PK4(z0, 8, pa1); PK4(z1, 0, pa2); PK4(z1, 8, pa3);
            SBAR();
            pv_d0(o, vb0, pa0, pa1, pa2, pa3);
            alive = __any(R > SB_DEAD);
        }
        if (lane == 0) flags[wid] = alive ? 1u : 0u;
        __syncthreads();
        unsigned any_alive = 0;
#pragma unroll
        for (int w = 0; w < NW; ++w) any_alive |= flags[w];
        if (!any_alive) break;
    }
    { const int le = lane_id(); store_o_staged<false>(o, nullptr, K_lds + wid * 8192, nullptr, Ob + (size_t)(wid * QBLK) * ldo, ldo, le); }
    __syncthreads();
}
#undef PK4
#undef SBAR
}

typedef GAS unsigned gu32;
#define RLX_AGENT __ATOMIC_RELAXED, __HIP_MEMORY_SCOPE_AGENT
#define XB_TMO      128
#define XB_XCNT(j)  (256  + 64 * (j))
#define XB_XSUB(j)  (1280 + 64 * (j))
#define XB_XGEN(j)  (2304 + 64 * (j))
#define XB_TOP      3328
#define XB_TOPGEN   3392
#define XCD_BAR_WORDS 3456
#define XB_SPIN_CAP (1u << 18)
__device__ __forceinline__ unsigned xb_ld(unsigned* p)              { return __hip_atomic_load(p, __ATOMIC_RELAXED, __HIP_MEMORY_SCOPE_AGENT); }
__device__ __forceinline__ unsigned xb_add(unsigned* p, unsigned v) { return __hip_atomic_fetch_add(p, v, __ATOMIC_RELAXED, __HIP_MEMORY_SCOPE_AGENT); }
__device__ __forceinline__ unsigned xb_xcc_id() { return (unsigned)__builtin_amdgcn_s_getreg((3 << 11) | 20) & 0xFu; }
#define XB_SPIN(cond, bar) do { unsigned _sp = 0; while (cond) { __builtin_amdgcn_s_sleep(1); \
    if ((++_sp & 255u) == 0u) { if (xb_ld(&(bar)[XB_TMO])) break; if (_sp > XB_SPIN_CAP) { atomicAdd(&(bar)[XB_TMO], 1u); break; } } } } while (0)
struct XcdBarrier { unsigned* bar; unsigned x; volatile LAS unsigned* st; };
__device__ __forceinline__ XcdBarrier xcd_barrier_post(unsigned* bar, volatile LAS unsigned* st, const int wv) {
    XcdBarrier b; b.bar = bar; b.x = xb_xcc_id(); b.st = st;
    if (MYTID(wv) == 0) (void)xb_add(&bar[XB_XCNT(b.x)], 1u);
    return b;
}
__device__ __forceinline__ void xcd_barrier_complete(unsigned* bar, unsigned x, unsigned& nloc, unsigned& nx) {
    const unsigned G = gridDim.x * gridDim.y * gridDim.z;
    unsigned sum, cnt, mine, sp = 0u;
    for (;;) {
        sum = 0u; cnt = 0u; mine = 0u;
#pragma unroll
        for (unsigned j = 0; j < 16; ++j) { const unsigned c = xb_ld(&bar[XB_XCNT(j)]); sum += c; cnt += (c > 0u) ? 1u : 0u; mine = (j == x) ? c : mine; }
        if (sum == G) break;
        __builtin_amdgcn_s_sleep(1);
        if ((++sp & 255u) == 0u) { if (xb_ld(&bar[XB_TMO])) break; if (sp > XB_SPIN_CAP) { atomicAdd(&bar[XB_TMO], 1u); break; } }
    }
    nloc = mine > 0u ? mine : 1u; nx = cnt > 0u ? cnt : 1u;
}
__device__ __forceinline__ void xcd_barrier(const XcdBarrier& b, const int wv) {
    asm volatile("s_waitcnt vmcnt(0)" ::: "memory");
    __syncthreads();
    if (MYTID(wv) == 0) {
        GAS unsigned* barg_ = (GAS unsigned*)b.bar; asm volatile("" : "+s"(barg_)); unsigned* bar = (unsigned*)barg_; unsigned bx_ = b.x; asm volatile("" : "+s"(bx_));
        __builtin_amdgcn_s_waitcnt(0);
        unsigned nloc = b.st[0], nx = b.st[1];
        if (nloc == 0u) { xcd_barrier_complete(bar, bx_, nloc, nx); b.st[0] = nloc; b.st[1] = nx; }
        const unsigned old = xb_add(&bar[XB_XSUB(bx_)], 1u);
        const unsigned gen = old / nloc;
        if (old + 1u == (gen + 1u) * nloc) {
            __builtin_amdgcn_fence(__ATOMIC_RELEASE, "agent");
            asm volatile("s_waitcnt vmcnt(0)" ::: "memory");
            const unsigned og = xb_add(&bar[XB_TOP], 1u);
            const unsigned tg = og / nx;
            if (og + 1u == (tg + 1u) * nx) xb_add(&bar[XB_TOPGEN], 1u);
            else XB_SPIN(xb_ld(&bar[XB_TOPGEN]) == tg, bar);
            __builtin_amdgcn_fence(__ATOMIC_ACQUIRE, "agent");
            xb_add(&bar[XB_XGEN(bx_)], 1u);
            asm volatile("s_waitcnt vmcnt(0)" ::: "memory");
        } else {
            XB_SPIN(xb_ld(&bar[XB_XGEN(bx_)]) == gen, bar);
            __builtin_amdgcn_fence(__ATOMIC_ACQUIRE, "agent");
            asm volatile("s_waitcnt vmcnt(0)" ::: "memory");
        }
    }
    __syncthreads();
}

struct Args { const float* in[20]; float* out; unsigned char* ws; int ph_lo, ph_hi, dup, pad; };
enum { I_X = 0, I_C, I_WADA, I_BADA, I_GMIX, I_GMLP, I_WIN, I_DQKG, I_DLAM, I_DSUB, I_T5, I_MQG, I_MKVG, I_WQUP, I_WKVUP, I_MQKG, I_WBR, I_WOUT, I_WM1, I_WM2 };
constexpr int NWAVES = 8, NTHR = 512;
constexpr int PH_PER_LAYER = 12, NPHASE = 1 + DEPTH * PH_PER_LAYER;

struct ConvDesc { const float* src; int N; bf16* dst; int ldk; const float* gk; const float* sk; };
__device__ __forceinline__ ConvDesc conv_make(const float* W, int K, int N, bf16* WT, int row_off, int item, int lane, int ldk, const float* g = nullptr, const float* sc = nullptr) {
    const int nblk = N / 32, kb = item / nblk, nb = item % nblk, k0 = 64 * kb, n0 = 32 * nb;
    ConvDesc d; d.src = W + (size_t)(k0 + (lane >> 3)) * N + n0 + 4 * (lane & 7); d.N = N; d.dst = WT + (size_t)(row_off + n0) * ldk + k0; d.ldk = ldk;
    d.gk = g ? g + k0 : nullptr; d.sk = sc ? sc + k0 : nullptr; return d;
}
__device__ __forceinline__ void conv_load(const ConvDesc& d, f32x4 (&v)[8]) {
#pragma unroll
    for (int i = 0; i < 8; ++i) v[i] = __builtin_nontemporal_load((const f32x4*)(d.src + (size_t)(8 * i) * d.N));
}
__device__ __forceinline__ void conv_finish(const ConvDesc& d, const f32x4 (&v)[8], LAS float* scr, int lane, const float* shk = nullptr, float* bacc = nullptr) {
#pragma unroll
    for (int i = 0; i < 8; ++i) { LAS float* p = scr + (8 * i + (lane >> 3)) * 33 + 4 * (lane & 7); p[0] = v[i].x; p[1] = v[i].y; p[2] = v[i].z; p[3] = v[i].w; }
    asm volatile("s_waitcnt lgkmcnt(0)" ::: "memory");
    const int c = lane & 7;
    float gm[8] = {1.f, 1.f, 1.f, 1.f, 1.f, 1.f, 1.f, 1.f};
    if (d.gk) { const f32x4 g0 = *(const f32x4*)(d.gk + 8 * c), g1 = *(const f32x4*)(d.gk + 8 * c + 4); f32x4 s0 = {0.f, 0.f, 0.f, 0.f}, s1 = {0.f, 0.f, 0.f, 0.f};
        if (d.sk) { s0 = *(const f32x4*)(d.sk + 8 * c); s1 = *(const f32x4*)(d.sk + 8 * c + 4); }
#pragma unroll
        for (int e = 0; e < 4; ++e) { gm[e] = g0[e] * (1.f + s0[e]); gm[4 + e] = g1[e] * (1.f + s1[e]); } }
    float sh8[8] = {0.f, 0.f, 0.f, 0.f, 0.f, 0.f, 0.f, 0.f};
    if (bacc) { const f32x4 h0 = *(const f32x4*)(shk + 8 * c), h1 = *(const f32x4*)(shk + 8 * c + 4);
#pragma unroll
        for (int e = 0; e < 4; ++e) { sh8[e] = h0[e]; sh8[4 + e] = h1[e]; } }
#pragma unroll
    for (int j = 0; j < 4; ++j) { const int n = (lane >> 3) + 8 * j; const LAS float* sp = scr + (8 * c) * 33 + n;
        if (bacc) bacc[j] += ((sp[0 * 33] * sh8[0] + sp[1 * 33] * sh8[1]) + (sp[2 * 33] * sh8[2] + sp[3 * 33] * sh8[3])) + ((sp[4 * 33] * sh8[4] + sp[5 * 33] * sh8[5]) + (sp[6 * 33] * sh8[6] + sp[7 * 33] * sh8[7]));
        u32x4 o; o.x = cvt_pk_bf16(sp[0 * 33] * gm[0], sp[1 * 33] * gm[1]); o.y = cvt_pk_bf16(sp[2 * 33] * gm[2], sp[3 * 33] * gm[3]); o.z = cvt_pk_bf16(sp[4 * 33] * gm[4], sp[5 * 33] * gm[5]); o.w = cvt_pk_bf16(sp[6 * 33] * gm[6], sp[7 * 33] * gm[7]);
        *(u32x4*)(d.dst + (size_t)n * d.ldk + 8 * c) = o; }
    asm volatile("s_waitcnt lgkmcnt(0)" ::: "memory");
}

__device__ __forceinline__ void ada_item(const Args& a, unsigned char* ws, LAS unsigned char* lds, int l, int cb, int tid) {
    const int lane = tid & 63, wave = tid >> 6;
    LAS float* red = (LAS float*)lds;
    const float* cvec = a.in[I_C];
    float* modf = (float*)(ws + WS_MODF);
    const float* W = a.in[I_WADA] + (size_t)l * DM * (NMOD * DM) + cb * 256 + 4 * lane;
    f32x4 acc = {0.f, 0.f, 0.f, 0.f};
    const int kbeg = wave * 256;
#pragma unroll 32
    for (int k = 0; k < 256; ++k) { const f32x4 w = __builtin_nontemporal_load((const f32x4*)(W + (size_t)(kbeg + k) * (NMOD * DM))); const float cv = cvec[kbeg + k]; acc += w * cv; }
    *(LAS f32x4*)(red + wave * 256 + 4 * lane) = acc;
    __syncthreads();
    if (tid < 256) { float s = 0.f;
#pragma unroll
        for (int w = 0; w < 8; ++w) s += red[w * 256 + tid];
        const int j = cb * 256 + tid; modf[l * (NMOD * DM) + j] = s + a.in[I_BADA][l * (NMOD * DM) + j]; }
    asm volatile("s_waitcnt vmcnt(0)" ::: "memory");
    __syncthreads();
    if (tid == 0) { __builtin_amdgcn_fence(__ATOMIC_RELEASE, "agent"); (void)__hip_atomic_fetch_add((unsigned*)(ws + WS_CTL) + CW_ADA + 64 * l, 1u, __ATOMIC_RELAXED, __HIP_MEMORY_SCOPE_AGENT); }
}
__device__ __forceinline__ void wait_ada(unsigned char* ws, int l, int tid) {
    if (tid == 0) { unsigned* p = (unsigned*)(ws + WS_CTL) + CW_ADA + 64 * l;
        while (__hip_atomic_load(p, __ATOMIC_RELAXED, __HIP_MEMORY_SCOPE_AGENT) < 48u) __builtin_amdgcn_s_sleep(4);
        __builtin_amdgcn_fence(__ATOMIC_ACQUIRE, "agent"); }
    __syncthreads();
}
constexpr int CI_IN = (DM / 64) * (IN_COLS / 32), CI_Q = (512 / 64) * (1536 / 32), CI_KV = (256 / 64) * (2048 / 32), CI_BR1 = (1024 / 64) * (2048 / 32),
              CI_O = (DM / 64) * (DM / 32), CI_1 = (DM / 64) * (DFF / 32), CI_2 = (DFF / 64) * (DM / 32);
constexpr int CONV_PER_LAYER = CI_IN + CI_Q + CI_KV + 3 * CI_BR1 + CI_O + CI_1 + CI_2;
constexpr int CONV_CHUNK = 128, CONV_NCHUNK = (CONV_PER_LAYER + CONV_CHUNK - 1) / CONV_CHUNK;
constexpr int CONV_NDEP = CI_Q + CI_KV + 3 * CI_BR1 + CI_O + CI_2;
__device__ __forceinline__ ConvDesc conv_desc(const Args& a, unsigned char* ws, int l, int r, int lane) {
    unsigned char* wl = ws + WS_W + (size_t)l * W_LAYER;
    if (r < CI_Q) return conv_make(a.in[I_WQUP] + (size_t)l * 512 * 1536, 512, 1536, (bf16*)(wl + W_QUP), 0, r, lane, 512, a.in[I_MQG] + l * 512); r -= CI_Q;
    if (r < CI_KV) return conv_make(a.in[I_WKVUP] + (size_t)l * 256 * 2048, 256, 2048, (bf16*)(wl + W_KVUP), 0, r, lane, 256, a.in[I_MKVG] + l * 256); r -= CI_KV;
    if (r < 3 * CI_BR1) { const int n = r / CI_BR1; r -= n * CI_BR1;
        return conv_make(a.in[I_WBR] + ((size_t)l * 3 + n) * 1024 * 2048, 1024, 2048, (bf16*)(wl + W_BR) + (size_t)n * 1024, 0, r, lane, 3072); } r -= 3 * CI_BR1;
    if (r < CI_O) return conv_make(a.in[I_WOUT] + (size_t)l * DM * DM, DM, DM, (bf16*)(wl + W_OUT), 0, r, lane, DM); r -= CI_O;
    return conv_make(a.in[I_WM2] + (size_t)l * DFF * DM, DFF, DM, (bf16*)(wl + W_M2), 0, r, lane, DFF);
}
__device__ __forceinline__ void conv_item(const Args& a, unsigned char* ws, int l, int r, LAS float* scr, int lane) {
    const ConvDesc d = conv_desc(a, ws, l, r, lane); f32x4 v[8]; conv_load(d, v); conv_finish(d, v, scr, lane);
}
__device__ __forceinline__ void conv_pair(const Args& a, unsigned char* ws, int l, int r0, int r1, LAS float* scr, int lane) {
    const ConvDesc d0 = conv_desc(a, ws, l, r0, lane), d1 = conv_desc(a, ws, l, r1, lane); f32x4 v0[8], v1[8];
    conv_load(d0, v0); conv_load(d1, v1); conv_finish(d0, v0, scr, lane); conv_finish(d1, v1, scr, lane);
}
__device__ __forceinline__ void conv_quad(const Args& a, unsigned char* ws, int l, int r0, LAS float* scr, int lane) {
    const ConvDesc d0 = conv_desc(a, ws, l, r0, lane), d1 = conv_desc(a, ws, l, r0 + 1, lane), d2 = conv_desc(a, ws, l, r0 + 2, lane), d3 = conv_desc(a, ws, l, r0 + 3, lane);
    f32x4 v0[8], v1[8], v2[8], v3[8];
    conv_load(d0, v0); conv_load(d1, v1); conv_load(d2, v2); conv_load(d3, v3);
    conv_finish(d0, v0, scr, lane); conv_finish(d1, v1, scr, lane); conv_finish(d2, v2, scr, lane); conv_finish(d3, v3, scr, lane);
}
constexpr int CC_IN = IN_COLS / 32, CC_1 = DFF / 32, CONV_COLS = CC_IN + CC_1;
__device__ __forceinline__ void conv_col(const Args& a, unsigned char* ws, int l, int ci, LAS float* scr, int lane) {
    unsigned char* wl = ws + WS_W + (size_t)l * W_LAYER;
    const float* modl = (const float*)(ws + WS_MODF) + (size_t)l * (NMOD * DM);
    const bool first = ci < CC_IN; const int nb = first ? ci : ci - CC_IN, N = first ? IN_COLS : DFF, nblk = N / 32;
    const float* W = first ? a.in[I_WIN] + (size_t)l * DM * IN_COLS : a.in[I_WM1] + (size_t)l * DM * DFF;
    bf16* WT = (bf16*)(wl + (first ? W_IN : W_M1));
    const int roff = (first && 32 * nb >= SRC_PAD_AT) ? PADW : 0;
    const float* g = first ? a.in[I_GMIX] + l * DM : a.in[I_GMLP] + l * DM; const float* sc = modl + (first ? 1 : 4) * DM; const float* sh = modl + (first ? 0 : 3) * DM;
    float bacc[4] = {0.f, 0.f, 0.f, 0.f};
    for (int kb = 0; kb < DM / 64; kb += 4) {
        const ConvDesc d0 = conv_make(W, DM, N, WT, roff, kb * nblk + nb, lane, DM, g, sc), d1 = conv_make(W, DM, N, WT, roff, (kb + 1) * nblk + nb, lane, DM, g, sc);
        const ConvDesc d2 = conv_make(W, DM, N, WT, roff, (kb + 2) * nblk + nb, lane, DM, g, sc), d3 = conv_make(W, DM, N, WT, roff, (kb + 3) * nblk + nb, lane, DM, g, sc);
        f32x4 v0[8], v1[8], v2[8], v3[8];
        conv_load(d0, v0); conv_load(d1, v1); conv_load(d2, v2); conv_load(d3, v3);
        conv_finish(d0, v0, scr, lane, sh + 64 * kb, bacc); conv_finish(d1, v1, scr, lane, sh + 64 * (kb + 1), bacc); conv_finish(d2, v2, scr, lane, sh + 64 * (kb + 2), bacc); conv_finish(d3, v3, scr, lane, sh + 64 * (kb + 3), bacc);
    }
    float* bias = (float*)(ws + WS_CTL + WS_BIAS) + (size_t)l * BIAS_PER_LAYER + (first ? roff : PN) + 32 * nb;
#pragma unroll
    for (int j = 0; j < 4; ++j) { float b = bacc[j]; b += swz<1>(b); b += swz<2>(b); b += swz<4>(b); if ((lane & 7) == 0) bias[(lane >> 3) + 8 * j] = b; }
}
constexpr int PREP_CHUNK = 64, PREP_NCHUNK = (CONV_NDEP + PREP_CHUNK - 1) / PREP_CHUNK, PREP_NCOL = (CONV_COLS + NWAVES - 1) / NWAVES, PREP_ITEMS = 48 + PREP_NCHUNK + PREP_NCOL, PREP_LEAD = 100, PREP_TAIL = 64;
static_assert(PREP_LEAD <= PREP_NCHUNK, "prep order");
__device__ __forceinline__ void prep_item(const Args& a, unsigned char* ws, LAS unsigned char* lds, int l, int idx, int tid) {
    if (idx < 48) { ada_item(a, ws, lds, l, idx, tid); return; }
    int ch = idx - 48; const int lane = tid & 63, wave = tid >> 6; LAS float* scr = (LAS float*)(lds + wave * 16384);
    if (ch >= PREP_LEAD && ch < PREP_LEAD + PREP_NCOL) { wait_ada(ws, l, tid); const int ci = (ch - PREP_LEAD) * NWAVES + wave; if (ci < CONV_COLS) conv_col(a, ws, l, ci, scr, lane); __syncthreads(); return; }
    if (ch >= PREP_LEAD + PREP_NCOL) ch -= PREP_NCOL;
    const int beg = ch * PREP_CHUNK, end = (beg + PREP_CHUNK < CONV_NDEP) ? beg + PREP_CHUNK : CONV_NDEP;
    for (int r = beg + 4 * wave; r < end; r += 4 * NWAVES) { if (r + 3 < end) conv_quad(a, ws, l, r, scr, lane); else for (int q = r; q < end && q < r + 4; ++q) conv_item(a, ws, l, q, scr, lane); }
    __syncthreads();
}

__device__ __forceinline__ void prologue(const Args& a, LAS unsigned char* lds, int G, const int wv) {
    int tid = MYTID(wv); asm volatile("" : "+v"(tid));
    const int lane = tid & 63, wave = tid >> 6;
    GAS unsigned char* wsg_ = (GAS unsigned char*)a.ws; asm volatile("" : "+s"(wsg_)); unsigned char* ws = (unsigned char*)wsg_;
    for (int it = blockIdx.x; it < 48; it += G) ada_item(a, ws, lds, 0, it, tid);
    {
        float* rc = (float*)(ws + WS_ROPE); float* rs = rc + S * 32;
        for (int e = blockIdx.x * NTHR + tid; e < S * 32; e += G * NTHR) {
            const int pos = e >> 5, i = e & 31;
            const float inv = exp2f(-(float)i * (13.287712379549449f / 32.0f));
            const float ang = (float)pos * inv;
            const double rev = (double)ang * 0.15915494309189535; const float fr = (float)(rev - rint(rev));
            rc[e] = __builtin_amdgcn_cosf(fr); rs[e] = __builtin_amdgcn_sinf(fr);
        }
    }
    {
        const float* x = a.in[I_X]; bf16* XB = (bf16*)(ws + WS_ACT + A_XB); float* RQ = (float*)(ws + WS_ACT + A_RSQA);
        for (int row = blockIdx.x * NWAVES + wave; row < S; row += G * NWAVES) {
            const f32x4* xr = (const f32x4*)(x + (size_t)row * DM) + lane; f32x4 v[8]; float sq = 0.f;
#pragma unroll
            for (int j = 0; j < 8; ++j) v[j] = xr[64 * j];
            u32x2* o8 = (u32x2*)(XB + (size_t)row * DM) + lane;
#pragma unroll
            for (int j = 0; j < 8; ++j) { sq += (v[j].x * v[j].x + v[j].y * v[j].y) + (v[j].z * v[j].z + v[j].w * v[j].w);
                u32x2 w; w.x = cvt_pk_bf16(v[j].x, v[j].y); w.y = cvt_pk_bf16(v[j].z, v[j].w); o8[64 * j] = w; }
            sq = wave_sum(sq);
            if (lane < 8) RQ[(size_t)row * 8 + lane] = (lane == 0) ? sq : 0.f;
        }
    }
    {
        LAS float* scr = (LAS float*)(lds + wave * 16384);
        const int NA = 48, X = (G > NA) ? (G - NA) * NWAVES * 2 : 0;
        if ((int)blockIdx.x >= NA) for (int it = ((int)blockIdx.x - NA) * NWAVES + wave; it < X; it += (G - NA) * NWAVES) conv_item(a, ws, 0, it, scr, lane);
        for (int it = X + (int)blockIdx.x * NWAVES + wave; it < CONV_NDEP; it += G * NWAVES) conv_item(a, ws, 0, it, scr, lane);
        __syncthreads();
        wait_ada(ws, 0, tid);
        for (int ci = (int)blockIdx.x + G * wave; ci < CONV_COLS; ci += G * NWAVES) conv_col(a, ws, 0, ci, scr, lane);
    }
}

__device__ __forceinline__ void ld16f(const bf16* p, float* x) {
    const u32x4 a = *(const u32x4*)p, b = *(const u32x4*)(p + 8);
    x[0] = bf_lo(a.x); x[1] = bf_hi(a.x); x[2] = bf_lo(a.y); x[3] = bf_hi(a.y); x[4] = bf_lo(a.z); x[5] = bf_hi(a.z); x[6] = bf_lo(a.w); x[7] = bf_hi(a.w);
    x[8] = bf_lo(b.x); x[9] = bf_hi(b.x); x[10] = bf_lo(b.y); x[11] = bf_hi(b.y); x[12] = bf_lo(b.z); x[13] = bf_hi(b.z); x[14] = bf_lo(b.w); x[15] = bf_hi(b.w);
}
__device__ __forceinline__ void st16f(bf16* p, const float* x) {
    u32x4 a, b; a.x = cvt_pk_bf16(x[0], x[1]); a.y = cvt_pk_bf16(x[2], x[3]); a.z = cvt_pk_bf16(x[4], x[5]); a.w = cvt_pk_bf16(x[6], x[7]);
    b.x = cvt_pk_bf16(x[8], x[9]); b.y = cvt_pk_bf16(x[10], x[11]); b.z = cvt_pk_bf16(x[12], x[13]); b.w = cvt_pk_bf16(x[14], x[15]);
    *(u32x4*)p = a; *(u32x4*)(p + 8) = b;
}
__device__ __forceinline__ void ld8f(const bf16* p, float* x) {
    const u32x4 a = *(const u32x4*)p;
    x[0] = bf_lo(a.x); x[1] = bf_hi(a.x); x[2] = bf_lo(a.y); x[3] = bf_hi(a.y); x[4] = bf_lo(a.z); x[5] = bf_hi(a.z); x[6] = bf_lo(a.w); x[7] = bf_hi(a.w);
}
__device__ __forceinline__ void st8f(bf16* p, const float* x) {
    u32x4 a; a.x = cvt_pk_bf16(x[0], x[1]); a.y = cvt_pk_bf16(x[2], x[3]); a.z = cvt_pk_bf16(x[4], x[5]); a.w = cvt_pk_bf16(x[6], x[7]); *(u32x4*)p = a;
}

__device__ __forceinline__ void post1_phase(const Args& a, int l, int G, const int wv) {
    int tid = MYTID(wv); asm volatile("" : "+v"(tid));
    const int lane = tid & 63, wave = tid >> 6;
    GAS unsigned char* wsg_ = (GAS unsigned char*)a.ws; asm volatile("" : "+s"(wsg_)); unsigned char* ws = (unsigned char*)wsg_;
    const bf16* proj = (const bf16*)(ws + WS_ACT + A_PROJ);
    bf16* QA = (bf16*)(ws + WS_ACT + A_QA); bf16* KA = (bf16*)(ws + WS_ACT + A_KA); bf16* KPE = (bf16*)(ws + WS_ACT + A_KPE);
    const float* rc = (const float*)(ws + WS_ROPE); const float* rs = rc + S * 32;
    const float* gq = a.in[I_DQKG] + l * 128; const float* gk = gq + 64;
    const float* gkpe = a.in[I_MQKG] + l * 384 + 192 + 128;
    float gqv[16], gkv[16];
#pragma unroll
    for (int e = 0; e < 16; ++e) { gqv[e] = gq[16 * (lane & 3) + e] * SC_DA; gkv[e] = gk[16 * (lane & 3) + e]; }
    const float gpe = gkpe[lane];
    int rbeg = (int)blockIdx.x * NWAVES + wave, rend = S, rstep = G * NWAVES;
    if (G == 256) { const int b_ = (int)blockIdx.x; const int r0_ = b_ < 192 ? 26 * b_ : 4992 + 50 * (b_ - 192), nr_ = b_ < 192 ? 26 : 50; rbeg = r0_ + wave; rend = r0_ + nr_; rstep = NWAVES; }
    for (int row = rbeg; row < rend; row += rstep) {
        const bf16* P = proj + (size_t)row * PN;
        float x[16];
        { ld16f(P + C_DAQ + 16 * lane, x); float s = 0.f;
#pragma unroll
          for (int e = 0; e < 16; ++e) s += x[e] * x[e];
          s += swz<1>(s); s += swz<2>(s); const float r = rsq(s * (1.f / 64.f) + EPS);
#pragma unroll
          for (int e = 0; e < 16; ++e) x[e] = x[e] * r * gqv[e];
          st16f(QA + (size_t)row * 1024 + 16 * lane, x); }
        { ld16f(P + C_DAK + 16 * lane, x); float s = 0.f;
#pragma unroll
          for (int e = 0; e < 16; ++e) s += x[e] * x[e];
          s += swz<1>(s); s += swz<2>(s); const float r = rsq(s * (1.f / 64.f) + EPS);
#pragma unroll
          for (int e = 0; e < 16; ++e) x[e] = x[e] * r * gkv[e];
          st16f(KA + (size_t)row * 1024 + 16 * lane, x); }
        { const float v = bf1(P[C_KPE + lane]); const float r = rsq(wave_sum(v * v) * (1.f / 64.f) + EPS);
          const float y = v * r * gpe; float yp; { auto rr = __builtin_amdgcn_permlane32_swap(__float_as_uint(y), __float_as_uint(y), false, false); yp = __uint_as_float(lane < 32 ? rr[1] : rr[0]); }
          const int i = lane & 31; const float c = rc[row * 32 + i], sn = rs[row * 32 + i];
          const float o = (lane < 32) ? (y * c - yp * sn) : (yp * sn + y * c);
          KPE[(size_t)row * 64 + lane] = (bf16)(cvt_pk_bf16(o, o) & 0xffffu); }
    }
}


#ifndef ATT_MASK
#define ATT_MASK 7
#endif
__device__ __forceinline__ void attn_phase(const Args& a, int l, int layer, LAS unsigned char* ldsl, volatile LAS unsigned* MISC, const int wv) {
    GAS unsigned char* wsg_ = (GAS unsigned char*)a.ws; asm volatile("" : "+s"(wsg_)); unsigned char* ws = (unsigned char*)wsg_;
    LAS char* lds = (LAS char*)ldsl;
    const bf16* proj = (const bf16*)(ws + WS_ACT + A_PROJ);
    const bf16* QA = (const bf16*)(ws + WS_ACT + A_QA); const bf16* KA = (const bf16*)(ws + WS_ACT + A_KA); const bf16* KPE = (const bf16*)(ws + WS_ACT + A_KPE);
    const bf16* KVRAW = (const bf16*)(ws + WS_ACT + A_KVRAW); const bf16* QRAW = (const bf16*)(ws + WS_ACT + A_QRAW); const bf16* KNOPE = (const bf16*)(ws + WS_ACT + A_KNOPE);
    float* OD = (float*)(ws + WS_ACT + A_OD); bf16* YA = (bf16*)(ws + WS_ACT + A_YA); bf16* YB = YA + 1024; bf16* YC = YA + 2048;
    unsigned* qhead = (unsigned*)(ws + WS_CTL) + CW_QUEUE + 28 * 64 * l;
    const int xcd = (int)(xb_xcc_id() & 7u);
#define CLAIMP(qp) ({ if (MYTID(wv) == 0) MISC[16] = __hip_atomic_fetch_add((qp), 1u, RLX_AGENT); __syncthreads(); const int v_ = (int)MISC[16]; __syncthreads(); v_; })
#define CLAIMX(t_, N_, qsel) ({ \
        if (wv == 0) { const int ln_ = lane_id(); int res_ = -1, qx_ = 0; \
            for (;;) { const unsigned hv_ = (ln_ < 8) ? __hip_atomic_load(qhead + 64 * ((t_) * 8 + ((xcd + ln_) & 7)), RLX_AGENT) : 0xffffffffu; \
                const unsigned long long mk_ = __ballot(hv_ < (unsigned)(N_)); if (mk_ == 0ull) break; \
                const int i_ = __builtin_ctzll(mk_); qx_ = (xcd + i_) & 7; unsigned tk_ = 0u; \
                if (ln_ == 0) tk_ = __hip_atomic_fetch_add(qhead + 64 * ((t_) * 8 + qx_), 1u, RLX_AGENT); \
                tk_ = (unsigned)__builtin_amdgcn_readfirstlane((int)tk_); if (tk_ < (unsigned)(N_)) { res_ = (int)tk_; break; } } \
            if (ln_ == 0) { MISC[16] = (unsigned)res_; MISC[17] = (unsigned)qx_; } } \
        __syncthreads(); const int v_ = (int)MISC[16]; qsel = (int)MISC[17]; __syncthreads(); v_; })
#define CLAIM(qi) CLAIMP(qhead + 64 * (24 + (qi) - 3))
    bool prep_left = (layer + 1 < DEPTH);
#define PREP_ONE() do { if (prep_left) { const int pi_ = CLAIM(4); if (pi_ < PREP_ITEMS - PREP_TAIL) prep_item(a, ws, ldsl, layer + 1, pi_, MYTID(wv)); else prep_left = false; } } while (0)
    if (ATT_MASK & 1) { for (;;) { int h;
        const int ui = CLAIMX(0, 32, h); if (ui < 0) break;
        const int qb = 31 - ui, q0 = qb * 256;
        att::KVSrc kv{KNOPE + h * 128, 1024, KPE, 64, KVRAW + h * 256 + 128, 2048};
        const att::QPrep qp{a.in[I_MQKG] + layer * 384, (const float*)(ws + WS_ROPE), (const float*)(ws + WS_ROPE) + S * 32};
        bool nomax;
        { const float* g0_ = a.in[I_MQKG] + layer * 384; const float* g1_ = g0_ + 192; const int ln2_ = lane_id();
          const float q_n = wave_max(fmaxf(fabsf(g0_[ln2_]), fabsf(g0_[64 + ln2_]))), q_p = wave_max(fabsf(g0_[128 + ln2_]));
          const float k_n = wave_max(fmaxf(fabsf(g1_[ln2_]), fabsf(g1_[64 + ln2_]))), k_p = wave_max(fabsf(g1_[128 + ln2_]));
          const float bnd = 1.02f * SC_MLA * sqrtf(128.f * q_n * q_n + 64.f * q_p * q_p) * sqrtf(128.f * k_n * k_n + 64.f * k_p * k_p);
          nomax = __builtin_amdgcn_readfirstlane((int)(bnd <= SMAX_BOUND)) != 0; }
        if (nomax) att::softmax_unit_v3<192, 128, false, false, false, false, true, true>(lds, QRAW + (size_t)q0 * 1536 + h * 192, 1536, kv, q0, nullptr, YB + (size_t)q0 * 3072 + h * 128, 3072, wv, att::DaFin{}, qp);
        else att::softmax_unit_v3<192, 128, false, false, false, false, false, true>(lds, QRAW + (size_t)q0 * 1536 + h * 192, 1536, kv, q0, nullptr, YB + (size_t)q0 * 3072 + h * 128, 3072, wv, att::DaFin{}, qp);
        PREP_ONE();
      } }
    int npass = 2; asm volatile("" : "+s"(npass));
    for (int pass = 0; pass < npass; ++pass) {
    if (ATT_MASK & 2) { for (;;) { int h, hc, qb;
        if (pass == 0) { const int ui = CLAIMX(1, 56, h); if (ui < 0) break; hc = 2 * h + (ui & 1); qb = 31 - (ui >> 1); }
        else { const int u_ = CLAIM(6); if (u_ >= 64) break; hc = u_ & 15; qb = 3 - (u_ >> 4); h = hc >> 1; }
        const int q0 = qb * 256;
        { const int tid = MYTID(wv); if (tid < 256) { const int rel = 64 - tid, n = rel < 0 ? -rel : rel;
            int large = 8 + (int)(logf((float)(n < 1 ? 1 : n) / 8.0f) / 2.772588722239781f * 8.0f); large = large < 15 ? large : 15;
            const int bucket = (rel > 0 ? 16 : 0) + (n < 8 ? n : large);
            ((LAS float*)(lds + att::L_BIAS))[tid] = (a.in[I_T5][bucket * 8 + h] - a.in[I_T5][15 * 8 + h]) * LOG2E; } }
        __syncthreads();
        att::KVSrc kv{KA + hc * 64, 1024, KA, 1024, proj + C_DAV + h * 128, PN};
        const float* lp = a.in[I_DLAM] + layer * 256; const int ln_ = lane_id();
        const float lam_init = 0.8f - 0.6f * expf(-0.3f * (float)layer);
        float lam = expf(wave_sum(lp[ln_] * lp[64 + ln_])) - expf(wave_sum(lp[128 + ln_] * lp[192 + ln_])) + lam_init;
        lam = __int_as_float(__builtin_amdgcn_readfirstlane(__float_as_int(lam))); const float omli = __int_as_float(__builtin_amdgcn_readfirstlane(__float_as_int(1.f - lam_init)));
        att::DaFin fin{OD + (size_t)(((hc ^ 1) * 32 + qb) * 8) * 4096, (unsigned*)(ws + WS_CTL) + CW_DAC + (l * 8 + h) * 32 + qb, lam, a.in[I_DSUB] + layer * 128, omli, (hc & 1) == 0};
        bool nomax;
        { const float* gq_ = a.in[I_DQKG] + layer * 128; const float gqm = wave_max(fabsf(gq_[ln_])), gkm = wave_max(fabsf(gq_[64 + ln_]));
          const float tm = wave_max(ln_ < 32 ? fabsf(a.in[I_T5][ln_ * 8 + h]) : 0.f);
          const float bnd = 1.02f * SC_DA * 64.f * gqm * gkm + 2.f * LOG2E * tm;
          nomax = __builtin_amdgcn_readfirstlane((int)(bnd <= SMAX_BOUND)) != 0; }
        if (nomax) att::softmax_unit_v3<64, 64, true, true, true, false, true>(lds, QA + (size_t)q0 * 1024 + hc * 64, 1024, kv, q0, OD + (size_t)((hc * 32 + qb) * 8) * 4096, YA + (size_t)q0 * 3072 + h * 128, 3072, wv, fin);
        else att::softmax_unit_v3<64, 64, true, true, true, false>(lds, QA + (size_t)q0 * 1024 + hc * 64, 1024, kv, q0, OD + (size_t)((hc * 32 + qb) * 8) * 4096, YA + (size_t)q0 * 3072 + h * 128, 3072, wv, fin);
        PREP_ONE();
      } }
    if (pass == 0) {
    if (ATT_MASK & 4) { for (;;) { int h;
        const int ui = CLAIMX(2, 32, h); if (ui < 0) break;
        const int qb = 31 - ui, q0 = qb * 256;
        att::KVSrc kv{proj + C_SBK + h * 128, PN, proj, PN, proj + C_SBV + h * 128, PN};
        att::sb_unit(lds, proj + (size_t)q0 * PN + C_SBQ + h * 128, PN, kv, q0, YC + (size_t)q0 * 3072 + h * 128, 3072, wv);
      } }
    {
        __syncthreads();
        const bf16* Hh = (const bf16*)(ws + WS_ACT + A_XB); const bf16* Wi = (const bf16*)(ws + WS_W + (size_t)layer * W_LAYER + W_IN); bf16* PJ = (bf16*)(ws + WS_ACT + A_PROJ);
        const float* RQ = (const float*)(ws + WS_ACT + A_RSQA); const float* B1 = (const float*)(ws + WS_CTL + WS_BIAS) + (size_t)layer * BIAS_PER_LAYER;
        constexpr int NFILL = (PN / 256 - GIN_TILES) * (S / 256);
        for (;;) { const int ui = CLAIM(3); if (ui >= NFILL) break;
            pg8::Gemm g{Hh, Wi, S, PN, DM, DM}; pg8::OneUnit So; So.u0.pm = ui & 31; So.u0.pn = GIN_TILES + (ui >> 5);
            pg8::EpiBf16N<3> E{PJ, PN, C_GATE / 256, RQ, B1, 1.f / DM, nullptr, nullptr}; pg8::gemm_phase(ldsl, g, So, E, wv); }
    }
    while (prep_left) PREP_ONE();
    } }
    if (layer + 1 < DEPTH) for (;;) { const int pi_ = CLAIM(5); if (pi_ >= PREP_TAIL) break; prep_item(a, ws, ldsl, layer + 1, PREP_ITEMS - PREP_TAIL + pi_, MYTID(wv)); }
    __syncthreads();
#undef PREP_ONE
#undef CLAIM
#undef CLAIMP
#undef CLAIMX
}

__global__ void __launch_bounds__(NTHR, 2) mk_fwd(Args args) {
    extern __shared__ __attribute__((aligned(16))) unsigned char lds_raw[];
    LAS unsigned char* lds = (LAS unsigned char*)lds_raw;
    volatile LAS unsigned* MISC = (volatile LAS unsigned*)(lds + MISC_OFF);
    const int wv = __builtin_amdgcn_readfirstlane((int)threadIdx.x >> 6);
    const int tid = MYTID(wv), G = gridDim.x;
    unsigned char* ws = args.ws;
    for (int u = tid; u < (LDS_BYTES - LDSCTL_OFF) / 4; u += NTHR) ((LAS unsigned*)(lds + LDSCTL_OFF))[u] = 0u;
    __syncthreads();
    XcdBarrier bar; bar.bar = (unsigned*)(ws + WS_CTL) + CW_BAR; bar.x = 0; bar.st = nullptr;
    if (!MK_SPLIT) bar = xcd_barrier_post((unsigned*)(ws + WS_CTL) + CW_BAR, MISC + 8, wv);
    const int lo = args.ph_lo, hi = args.ph_hi;
#ifndef PH_MASK
#define PH_MASK 0x1FFF
#endif
#if MK_SPLIT
#define IN(k) (lo <= (k) && (k) < hi)
#else
#define IN(k) true
#endif
#define INL(c) (((PH_MASK >> (1 + (c))) & 1) && IN(pb + (c)))
#define SEAM(k) do { if (IN((k) + 1)) xcd_barrier(bar, wv); } while (0)
#if DUP_MASK
#define REP(c) for (int rep_ = ((args.dup >> (c)) & 1); rep_ >= 0; --rep_)
#else
#define REP(c) for (int rep_ = 0; rep_ >= 0; --rep_)
#endif
#define RSEAM() do { if (rep_ > 0) xcd_barrier(bar, wv); } while (0)

    if ((PH_MASK & 1) && IN(0)) { REP(12) { prologue(args, lds, G, wv); RSEAM(); } SEAM(0); }

    for (int l = 0; l < DEPTH; ++l) {
        const int pb = 1 + l * PH_PER_LAYER;
        LAS float* PART = (LAS float*)(lds + RS_OFF);
        {
        GAS unsigned char* wsg_ = (GAS unsigned char*)args.ws; asm volatile("" : "+s"(wsg_)); unsigned char* ws = (unsigned char*)wsg_;
        bf16* PROJ = (bf16*)(ws + WS_ACT + A_PROJ); bf16* XB = (bf16*)(ws + WS_ACT + A_XB);
        float* RQA = (float*)(ws + WS_ACT + A_RSQA); float* RQCQ = (float*)(ws + WS_ACT + A_RSQCQ); float* RQCKV = (float*)(ws + WS_ACT + A_RSQCKV); const float* BIAS = (const float*)(ws + WS_CTL + WS_BIAS) + (size_t)l * BIAS_PER_LAYER;
        bf16* QRAW = (bf16*)(ws + WS_ACT + A_QRAW); bf16* KVRAW = (bf16*)(ws + WS_ACT + A_KVRAW);
        unsigned char* wl = ws + WS_W + (size_t)l * W_LAYER;
        if (INL(1)) { pg8::Gemm g{XB, (const bf16*)(wl + W_IN), S, GIN_TILES * 256, DM, DM}; pg8::StaticOrder So; So.init(S, GIN_TILES * 256, G, (int)blockIdx.x);
            pg8::EpiBf16N<3, true> E{PROJ, PN, C_GATE / 256, RQA, BIAS, 1.f / DM, RQCQ, RQCKV}; REP(1) { pg8::gemm_phase(lds, g, So, E, wv); RSEAM(); } SEAM(pb + 1); }
        if (INL(2)) { REP(2) {
            const float* ZERO = (const float*)(ws + WS_CTL + WS_ZERO);
            if ((blockIdx.x & 1) == 0) post1_phase(args, l, G, wv);
            { pg8::Gemm g{PROJ + C_CQ, (const bf16*)(wl + W_QUP), S, 1536, 512, PN}; pg8::StaticOrder So; So.init(S, 1536, G, (int)blockIdx.x);
              pg8::EpiBf16N<0> E{QRAW, 1536, 0, RQCQ, ZERO, 1.f / 512.f, nullptr, nullptr}; pg8::gemm_phase(lds, g, So, E, wv); }
            { pg8::Gemm g{PROJ + C_CKV, (const bf16*)(wl + W_KVUP), S, 2048, 256, PN}; pg8::StaticOrder So; So.init(S, 2048, G, (int)blockIdx.x);
              pg8::EpiKvUp E{(bf16*)(ws + WS_ACT + A_KNOPE), args.in[I_MQKG] + l * 384 + 192, RQCKV}; pg8::gemm_phase(lds, g, So, E, wv); }
            if ((blockIdx.x & 1) != 0) post1_phase(args, l, G, wv);
            RSEAM(); } SEAM(pb + 3); }
        if (INL(5)) { REP(5) { attn_phase(args, 2 * l + rep_, l, lds, MISC, wv); RSEAM(); } SEAM(pb + 5); }
        }
        {
        GAS unsigned char* wsg_ = (GAS unsigned char*)args.ws; asm volatile("" : "+s"(wsg_)); unsigned char* ws = (unsigned char*)wsg_;
        bf16* PROJ = (bf16*)(ws + WS_ACT + A_PROJ); bf16* XB = (bf16*)(ws + WS_ACT + A_XB); bf16* XB2 = (bf16*)(ws + WS_ACT + A_XB2);
        float* RQA = (float*)(ws + WS_ACT + A_RSQA); float* RQB = (float*)(ws + WS_ACT + A_RSQB); const float* BIAS = (const float*)(ws + WS_CTL + WS_BIAS) + (size_t)l * BIAS_PER_LAYER;
        bf16* YA = (bf16*)(ws + WS_ACT + A_YA); float* MF = (float*)(ws + WS_ACT + A_MF); bf16* MG = (bf16*)(ws + WS_ACT + A_MG); bf16* U = (bf16*)(ws + WS_ACT + A_U);
        const float* modl = (const float*)(ws + WS_MODF) + l * (NMOD * DM);
        unsigned char* wl = ws + WS_W + (size_t)l * W_LAYER;
        if (INL(7)) { REP(7) {
            pg8::Gemm g{YA, (const bf16*)(wl + W_BR), S, DM, 3072, 3072}; pg8::StaticOrder So; So.init(S, DM, G, (int)blockIdx.x);
            pg8::EpiBranchRatio E{PROJ + C_GATE, PN, MG}; pg8::gemm_phase(lds, g, So, E, wv);
            RSEAM(); } SEAM(pb + 7); }
        if (INL(8)) { pg8::Gemm g{MG, (const bf16*)(wl + W_OUT), S, DM, DM, DM}; pg8::StaticOrder So; So.init(S, DM, G, (int)blockIdx.x);
            REP(8) { if (l == 0) { pg8::EpiResid<false, true> E{args.in[I_X], rep_ ? (void*)MF : (void*)XB2, modl + 2 * DM, RQB, PART}; pg8::gemm_phase(lds, g, So, E, wv); }
                     else { pg8::EpiResid<true, true> E{XB, rep_ ? (void*)MF : (void*)XB2, modl + 2 * DM, RQB, PART}; pg8::gemm_phase(lds, g, So, E, wv); } RSEAM(); } SEAM(pb + 8); }
        if (INL(10)) { pg8::Gemm g{XB2, (const bf16*)(wl + W_M1), S, DFF, DM, DM}; pg8::StaticOrder So; So.init(S, DFF, G, (int)blockIdx.x);
            pg8::EpiBf16N<2> E{U, DFF, 0, RQB, BIAS + PN, 1.f / DM, nullptr, nullptr}; REP(10) { pg8::gemm_phase(lds, g, So, E, wv); RSEAM(); } SEAM(pb + 10); }
        if (INL(11)) { pg8::Gemm g{U, (const bf16*)(wl + W_M2), S, DM, DFF, DFF}; pg8::StaticOrder So; So.init(S, DM, G, (int)blockIdx.x);
            REP(11) { if (l == DEPTH - 1) { pg8::EpiResid<true, false> E{XB2, rep_ ? (void*)MF : (void*)args.out, modl + 5 * DM, nullptr, PART}; pg8::gemm_phase(lds, g, So, E, wv); }
                      else { pg8::EpiResid<true, true> E{XB2, rep_ ? (void*)MF : (void*)XB, modl + 5 * DM, RQA, PART}; pg8::gemm_phase(lds, g, So, E, wv); } RSEAM(); } SEAM(pb + 11); }
        }
    }
#undef IN
#undef INL
#undef SEAM
#undef REP
#undef RSEAM
}

extern "C" void kernel_launch(void* const* d_in, const int* in_sizes, int n_in, void* d_out, int out_size, void* d_ws, size_t ws_size, hipStream_t stream) {
    static int grid = 0;
    if (grid == 0) {
        if (n_in != 20 || in_sizes[0] != S * DM || out_size != S * DM || ws_size < WS_END) {
            fprintf(stderr, "kernel_launch: shape mismatch: n_in %d in0 %d out %d ws %zu (need %zu)\n", n_in, n_in > 0 ? in_sizes[0] : -1, out_size, ws_size, (size_t)WS_END); grid = -1; return; }
        int dev = 0, cus = 0, per_cu = 0;
        if (hipGetDevice(&dev) != hipSuccess || hipDeviceGetAttribute(&cus, hipDeviceAttributeMultiprocessorCount, dev) != hipSuccess) { grid = -1; return; }
        if (hipFuncSetAttribute((const void*)mk_fwd, hipFuncAttributeMaxDynamicSharedMemorySize, LDS_BYTES) != hipSuccess) { fprintf(stderr, "kernel_launch: hipFuncSetAttribute failed\n"); grid = -1; return; }
        if (hipOccupancyMaxActiveBlocksPerMultiprocessor(&per_cu, (const void*)mk_fwd, NTHR, LDS_BYTES) != hipSuccess || per_cu < 1)
            fprintf(stderr, "kernel_launch: note: occupancy query reports %d workgroups per CU\n", per_cu);
        (void)hipGetLastError();
        grid = cus;
    }
    if (grid < 0) return;
    if (hipMemsetAsync((char*)d_ws + WS_CTL, 0, CTL_ZERO_BYTES, stream) != hipSuccess) { fprintf(stderr, "kernel_launch: memset failed\n"); return; }
    Args a{};
    for (int i = 0; i < 20; ++i) a.in[i] = (const float*)d_in[i];
    a.out = (float*)d_out; a.ws = (unsigned char*)d_ws; a.dup = DUP_MASK;
#if MK_SPLIT
    for (int p = 0; p < NPHASE; ++p) { a.ph_lo = p; a.ph_hi = p + 1; hipLaunchKernelGGL(mk_fwd, dim3(grid), dim3(NTHR), LDS_BYTES, stream, a); }
#else
    a.ph_lo = 0; a.ph_hi = NPHASE;
    hipLaunchKernelGGL(mk_fwd, dim3(grid), dim3(NTHR), LDS_BYTES, stream, a);
#endif
    const hipError_t le = hipPeekAtLastError();
    if (le != hipSuccess) fprintf(stderr, "kernel_launch: launch failed: %s\n", hipGetErrorName(le));
}
```

```cpp
#include <hip/hip_runtime.h>
#include <cstdio>
#include <cstdint>

#ifndef DUP_MASK
#define DUP_MASK 0
#endif
#ifndef MK_SPLIT
#define MK_SPLIT 0
#endif

#define GAS __attribute__((address_space(1)))
#define LAS __attribute__((address_space(3)))
typedef unsigned short bf16;
typedef short bf16x8 __attribute__((ext_vector_type(8)));
typedef short s16x4 __attribute__((ext_vector_type(4)));
typedef float f32x4 __attribute__((ext_vector_type(4)));
typedef float f32x2 __attribute__((ext_vector_type(2)));
typedef float f32x16 __attribute__((ext_vector_type(16)));
typedef unsigned u32x4 __attribute__((ext_vector_type(4)));
typedef unsigned u32x2 __attribute__((ext_vector_type(2)));

constexpr int S = 8192, DM = 2048, DEPTH = 4, DFF = 8192, NMOD = 6;
constexpr int IN_COLS = 13120, PN = 13312;
constexpr int C_DAQ = 0, C_DAK = 1024, C_DAV = 2048, C_CQ = 3072, C_CKV = 3584, C_KPE = 3840, C_SBQ = 4096, C_SBK = 5120, C_SBV = 6144, C_GATE = 7168;
constexpr int SRC_PAD_AT = 3904, PADW = 192;
constexpr float EPS = 1e-6f;
constexpr float LOG2E = 1.4426950408889634f;
constexpr float SC_DA = 0.125f * LOG2E;
constexpr float SC_MLA = 0.07216878364870323f * LOG2E;
constexpr float SC_SB = 0.08838834764831845f * LOG2E;
constexpr int GIN_TILES = 32;
constexpr float SB_DEAD = -150.0f;

constexpr size_t MiB = 1u << 20;
constexpr size_t WS_CTL = 0, CTL_ZERO_BYTES = 1 * MiB;
constexpr size_t WS_MODF = 1 * MiB;
constexpr size_t WS_ROPE = 2 * MiB;
constexpr size_t WS_W = 4 * MiB;
constexpr size_t W_IN = 0, W_QUP = W_IN + (size_t)PN * DM * 2, W_KVUP = W_QUP + (size_t)1536 * 512 * 2, W_BR = W_KVUP + (size_t)2048 * 256 * 2,
                 W_OUT = W_BR + (size_t)3 * 2048 * 1024 * 2, W_M1 = W_OUT + (size_t)DM * DM * 2, W_M2 = W_M1 + (size_t)DFF * DM * 2, W_LAYER = W_M2 + (size_t)DM * DFF * 2;
constexpr size_t WS_ACT = WS_W + DEPTH * W_LAYER;
constexpr size_t A_H = 0, A_PROJ = A_H + (size_t)S * DM * 2, A_QA = A_PROJ + (size_t)S * PN * 2, A_KA = A_QA + (size_t)S * 1024 * 2,
                 A_CQN = A_KA + (size_t)S * 1024 * 2, A_CKVN = A_CQN + (size_t)S * 512 * 2, A_KPE = A_CKVN + (size_t)S * 256 * 2,
                 A_QRAW = A_KPE + (size_t)S * 64 * 2, A_KVRAW = A_QRAW + (size_t)S * 1536 * 2, A_QH = A_KVRAW + (size_t)S * 2048 * 2,
                 A_KNOPE = A_QH + (size_t)S * 1536 * 2, A_OD = A_KNOPE + (size_t)S * 1024 * 2, A_YA = A_OD + (size_t)S * 2048 * 4,
                 A_YB = A_YA + (size_t)S * 1024 * 2, A_YC = A_YB + (size_t)S * 1024 * 2, A_MF = A_YC + (size_t)S * 1024 * 2,
                 A_MG = A_MF + (size_t)S * DM * 4, A_U = A_MG + (size_t)S * DM * 2, A_XB = A_U + (size_t)S * DFF * 2, A_XB2 = A_XB + (size_t)S * DM * 2, A_END = A_XB2 + (size_t)S * DM * 2;
constexpr size_t WS_END = WS_ACT + A_END;
constexpr int CW_BAR = 4096;
constexpr int CW_QUEUE = 16384;
constexpr int CW_DAC = 32768;
constexpr int CW_ADA = 8192;
constexpr size_t WS_BIAS = 512 * 1024;
constexpr int BIAS_PER_LAYER = PN + DFF;
constexpr size_t A_RSQA = A_H, A_RSQB = A_H + (size_t)1 * MiB;
constexpr size_t A_RSQCQ = A_H + (size_t)2 * MiB, A_RSQCKV = A_H + (size_t)3 * MiB;
constexpr size_t WS_ZERO = 256 * 1024;

constexpr int RING_BYTES = 131072;
constexpr int LDSCTL_OFF = RING_BYTES, MISC_OFF = LDSCTL_OFF + 320;
constexpr int LDS_BYTES = 147456;
constexpr int RS_OFF = MISC_OFF + 256;

__device__ __forceinline__ unsigned cvt_pk_bf16(float lo, float hi) { unsigned r; asm volatile("v_cvt_pk_bf16_f32 %0, %1, %2" : "=v"(r) : "v"(lo), "v"(hi)); return r; }
__device__ __forceinline__ float bf_lo(unsigned w) { return __uint_as_float(w << 16); }
__device__ __forceinline__ float bf_hi(unsigned w) { return __uint_as_float(w & 0xffff0000u); }
__device__ __forceinline__ float bf1(bf16 h) { return __uint_as_float((unsigned)h << 16); }
template <int M> __device__ __forceinline__ float swz(float v) {
    return __int_as_float(__builtin_amdgcn_ds_swizzle(__float_as_int(v), (M << 10) | 0x1F));
}
__device__ __forceinline__ float half_sum(float v) {
    auto rr = __builtin_amdgcn_permlane32_swap(__float_as_uint(v), __float_as_uint(v), false, false);
    return __uint_as_float(rr[0]) + __uint_as_float(rr[1]);
}
__device__ __forceinline__ float wave_sum(float v) {
    v += swz<1>(v); v += swz<2>(v); v += swz<4>(v); v += swz<8>(v); v += swz<16>(v);
    return half_sum(v);
}
__device__ __forceinline__ float rsq(float x) { return 1.0f / sqrtf(x); }
__device__ __forceinline__ float wave_max(float v) {
    v = fmaxf(v, swz<1>(v)); v = fmaxf(v, swz<2>(v)); v = fmaxf(v, swz<4>(v)); v = fmaxf(v, swz<8>(v)); v = fmaxf(v, swz<16>(v));
    auto rr = __builtin_amdgcn_permlane32_swap(__float_as_uint(v), __float_as_uint(v), false, false);
    return fmaxf(__uint_as_float(rr[0]), __uint_as_float(rr[1]));
}
constexpr float SMAX_BOUND = 40.f;

__device__ __forceinline__ int lane_id() { int l; asm volatile("v_mbcnt_lo_u32_b32 %0, -1, 0\n\tv_mbcnt_hi_u32_b32 %0, -1, %0" : "=v"(l)); return l; }
#define MYTID(wv) ((wv) * 64 + lane_id())

namespace pg8 {
constexpr int BM = 256, BK = 64, HALF = 128, HTB = HALF * BK * 2, STAGE_BYTES = 8 * HTB, NXCD = 8, WGM = 8;
__host__ __device__ __forceinline__ int lds_byte(int r, int c) { const int st = (r >> 4) * 2 + (c >> 5), rr = r & 15, cc = c & 31, ob = rr * 64 + cc * 2; return st * 1024 + (ob ^ (((ob >> 9) & 1) << 5)); }
__host__ __device__ __forceinline__ void stage_rc(int b, int& R, int& C) { const int st = b / 1024, sb = b % 1024, swz = sb ^ (((sb >> 9) & 1) << 5); R = (st >> 1) * 16 + swz / 64; C = (st & 1) * 32 + (swz % 64) / 2; }
__host__ __device__ __forceinline__ int perm32(int rho) { const int n = rho >> 4, i = rho & 15; return 8 * (i >> 2) + 4 * n + (i & 3); }

struct Unit { int pm, pn; };
struct Gemm { const bf16* A; const bf16* Bt; int M, N, K, lda; };

struct StaticOrder {
    int nM, nN, nwg, G, c;
    __device__ void init(int M, int N, int G_, int c_) { nM = M / BM; nN = N / BM; nwg = nM * nN; G = G_; c = c_; }
    __device__ bool next(int i, Unit& u) const {
        const long L = (long)i * G + c; if (L >= nwg) return false;
        int wgid = (int)L; { const int q = nwg / NXCD, r = nwg % NXCD, xcd = wgid % NXCD, off = wgid / NXCD; wgid = (xcd < r ? xcd * (q + 1) : r * (q + 1) + (xcd - r) * q) + off; }
        const int nig = WGM * nN, gid = wgid / nig, fm = gid * WGM, gsz = (nM - fm) < WGM ? (nM - fm) : WGM;
        u.pm = fm + ((wgid % nig) % gsz); u.pn = (wgid % nig) / gsz; return true;
    }
    __device__ __forceinline__ void a_ready(const Unit&) const {}
    __device__ __forceinline__ void done(const Unit&) const {}
};

struct OneUnit {
    Unit u0;
    __device__ bool next(int i, Unit& u) const { if (i > 0) return false; u = u0; return true; }
    __device__ __forceinline__ void a_ready(const Unit&) const {}
    __device__ __forceinline__ void done(const Unit&) const {}
};
template <int ACT  > struct EpiBf16 {
    static constexpr bool PERM = true, HAS_MID = false, RS = false, RSQ_OUT = false;
    bf16* O; int ldc; int sig_pn0;
    __device__ __forceinline__ void operator()(const f32x4 (&acc)[2][2][4][2], const Unit& u, int wr, int wc, int fr, int fq) const {
        const int row0 = u.pm * BM + wr * 64 + fr; const int col0 = u.pn * BM + wc * 32 + 8 * fq;
#pragma unroll
        for (int ai = 0; ai < 2; ++ai)
#pragma unroll
            for (int m = 0; m < 4; ++m) { bf16* rowp = O + (size_t)(row0 + ai * HALF + m * 16) * ldc + col0;
#pragma unroll
                for (int bj = 0; bj < 2; ++bj) { f32x4 v0 = acc[ai][bj][m][0], v1 = acc[ai][bj][m][1];
                    if (ACT == 2) {
#pragma unroll
                        for (int e = 0; e < 4; ++e) { const float a = fmaxf(v0[e], 0.f), b = fmaxf(v1[e], 0.f); v0[e] = a * a; v1[e] = b * b; } }
                    if (ACT == 3) { if (u.pn >= sig_pn0) {
#pragma unroll
                        for (int e = 0; e < 4; ++e) { v0[e] = __builtin_amdgcn_rcpf(1.f + __builtin_amdgcn_exp2f(-LOG2E * v0[e])); v1[e] = __builtin_amdgcn_rcpf(1.f + __builtin_amdgcn_exp2f(-LOG2E * v1[e])); } } }
                    u32x4 w; w.x = cvt_pk_bf16(v0[0], v0[1]); w.y = cvt_pk_bf16(v0[2], v0[3]); w.z = cvt_pk_bf16(v1[0], v1[1]); w.w = cvt_pk_bf16(v1[2], v1[3]);
                    *(u32x4*)(rowp + bj * HALF) = w; } }
    }
};
template <int ACT, bool RSO_ = false> struct EpiBf16N {
    static constexpr bool PERM = true, HAS_MID = false, RS = true, RSQ_OUT = false, RSO = RSO_, NO_BIAS = false;
    bf16* O; int ldc; int sig_pn0; const float* rsqp; const float* bias; float inv_n; float* rq_cq; float* rq_ckv;
    __device__ __forceinline__ void operator()(const f32x4 (&acc)[2][2][4][2], const Unit& u, int wr, int wc, int fr, int fq, const LAS float* raw, const LAS float* bl, LAS float* part) const {
        const int row0 = u.pm * BM + wr * 64 + fr; const int col0 = u.pn * BM + wc * 32 + 8 * fq;
        const bool want = RSO && u.pn >= C_CQ / 256 && u.pn <= C_CKV / 256;
        f32x4 bv[2][2];
#pragma unroll
        for (int bj = 0; bj < 2; ++bj)
#pragma unroll
            for (int n = 0; n < 2; ++n) bv[bj][n] = *(const LAS f32x4*)(bl + bj * HALF + wc * 32 + 8 * fq + 4 * n);
#pragma unroll
        for (int ai = 0; ai < 2; ++ai)
#pragma unroll
            for (int m = 0; m < 4; ++m) { bf16* rowp = O + (size_t)(row0 + ai * HALF + m * 16) * ldc + col0;
                const LAS float* rp = raw + (ai * HALF + wr * 64 + m * 16 + fr) * 8;
                const f32x4 p0 = *(const LAS f32x4*)rp, p1 = *(const LAS f32x4*)(rp + 4);
                const float rstd = __builtin_amdgcn_rsqf(((p0[0] + p0[1]) + (p0[2] + p0[3]) + (p1[0] + p1[1]) + (p1[2] + p1[3])) * inv_n + EPS);
                float ss = 0.f;
#pragma unroll
                for (int bj = 0; bj < 2; ++bj) { f32x4 v0 = acc[ai][bj][m][0] * rstd + bv[bj][0], v1 = acc[ai][bj][m][1] * rstd + bv[bj][1];
                    if (RSO) ss += ((v0[0] * v0[0] + v0[1] * v0[1]) + (v0[2] * v0[2] + v0[3] * v0[3])) + ((v1[0] * v1[0] + v1[1] * v1[1]) + (v1[2] * v1[2] + v1[3] * v1[3]));
                    if (ACT == 2) {
#pragma unroll
                        for (int e = 0; e < 4; ++e) { const float a = fmaxf(v0[e], 0.f), b = fmaxf(v1[e], 0.f); v0[e] = a * a; v1[e] = b * b; } }
                    if (ACT == 3) { if (u.pn >= sig_pn0) {
#pragma unroll
                        for (int e = 0; e < 4; ++e) { v0[e] = __builtin_amdgcn_rcpf(1.f + __builtin_amdgcn_exp2f(-LOG2E * v0[e])); v1[e] = __builtin_amdgcn_rcpf(1.f + __builtin_amdgcn_exp2f(-LOG2E * v1[e])); } } }
                    u32x4 w; w.x = cvt_pk_bf16(v0[0], v0[1]); w.y = cvt_pk_bf16(v0[2], v0[3]); w.z = cvt_pk_bf16(v1[0], v1[1]); w.w = cvt_pk_bf16(v1[2], v1[3]);
                    *(u32x4*)(rowp + bj * HALF) = w; }
                if (RSO) { if (want) { ss += swz<16>(ss); ss = half_sum(ss); if (fq == 0) part[wc * BM + ai * HALF + wr * 64 + m * 16 + fr] = ss; } } }
    }
};
struct EpiKvUp {
    static constexpr bool PERM = true, HAS_MID = false, RS = true, RSQ_OUT = false, RSO = false, NO_BIAS = true;
    bf16* KN; const float* gk; const float* rsqp;
    static constexpr float inv_n = 1.f / 256.f;
    __device__ __forceinline__ void operator()(const f32x4 (&acc)[2][2][4][2], const Unit& u, int wr, int wc, int fr_, int fq_, const LAS float* raw, const LAS float* bl, LAS float* part) const {
        const int ln_ = lane_id(), fr = ln_ & 15, fq = ln_ >> 4;
        const int row0 = u.pm * BM + wr * 64 + fr; const int cl = wc * 32 + 8 * fq;
        float rl[2][4];
#pragma unroll
        for (int ai = 0; ai < 2; ++ai)
#pragma unroll
            for (int m = 0; m < 4; ++m) { const int rloc = ai * HALF + wr * 64 + m * 16 + fr; const LAS float* rp = raw + rloc * 8;
                const f32x4 p0 = *(const LAS f32x4*)rp, p1 = *(const LAS f32x4*)(rp + 4);
                const float rstd = __builtin_amdgcn_rsqf(((p0[0] + p0[1]) + (p0[2] + p0[3]) + (p1[0] + p1[1]) + (p1[2] + p1[3])) * inv_n + EPS); rl[ai][m] = rstd;
                const f32x4 v0 = acc[ai][0][m][0] * rstd, v1 = acc[ai][0][m][1] * rstd;
                float ss = ((v0[0] * v0[0] + v0[1] * v0[1]) + (v0[2] * v0[2] + v0[3] * v0[3])) + ((v1[0] * v1[0] + v1[1] * v1[1]) + (v1[2] * v1[2] + v1[3] * v1[3]));
                ss += swz<16>(ss); ss = half_sum(ss);
                if (fq == 0) part[wc * BM + rloc] = ss; }
        asm volatile("s_waitcnt lgkmcnt(0)" ::: "memory"); __builtin_amdgcn_s_barrier();
        const f32x4 g0 = *(const f32x4*)(gk + cl), g1 = *(const f32x4*)(gk + cl + 4);
#pragma unroll
        for (int ai = 0; ai < 2; ++ai)
#pragma unroll
            for (int m = 0; m < 4; ++m) { const int rloc = ai * HALF + wr * 64 + m * 16 + fr; const size_t row = (size_t)(row0 + ai * HALF + m * 16);
                const float rk = __builtin_amdgcn_rsqf(((part[rloc] + part[BM + rloc]) + (part[2 * BM + rloc] + part[3 * BM + rloc])) * (1.f / 128.f) + EPS) * rl[ai][m];
                { const f32x4 v0 = acc[ai][0][m][0] * rk * g0, v1 = acc[ai][0][m][1] * rk * g1;
                  u32x4 w; w.x = cvt_pk_bf16(v0[0], v0[1]); w.y = cvt_pk_bf16(v0[2], v0[3]); w.z = cvt_pk_bf16(v1[0], v1[1]); w.w = cvt_pk_bf16(v1[2], v1[3]);
                  *(u32x4*)(KN + row * 1024 + u.pn * 128 + cl) = w; }
                { const f32x4 v0 = acc[ai][1][m][0] * rl[ai][m], v1 = acc[ai][1][m][1] * rl[ai][m];
                  u32x4 w; w.x = cvt_pk_bf16(v0[0], v0[1]); w.y = cvt_pk_bf16(v0[2], v0[3]); w.z = cvt_pk_bf16(v1[0], v1[1]); w.w = cvt_pk_bf16(v1[2], v1[3]);
                  *(u32x4*)((bf16*)((char*)KN + ((ptrdiff_t)A_KVRAW - (ptrdiff_t)A_KNOPE)) + row * 2048 + u.pn * 256 + 128 + cl) = w; } }
    }
};
template <int PASS> struct EpiBranch {
    static constexpr bool PERM = true;
    const bf16* G; int ldg; float* MF; bf16* MG;
    __device__ __forceinline__ void operator()(const f32x4 (&acc)[2][2][4][2], const Unit& u, int wr, int wc, int fr, int fq) const {
        const int row0 = u.pm * BM + wr * 64 + fr; const int col0 = u.pn * BM + wc * 32 + 8 * fq;
#pragma unroll
        for (int ai = 0; ai < 2; ++ai)
#pragma unroll
            for (int m = 0; m < 4; ++m) { const size_t row = (size_t)(row0 + ai * HALF + m * 16);
#pragma unroll
                for (int bj = 0; bj < 2; ++bj) { const int col = col0 + bj * HALF;
                    const u32x4 gw = *(const u32x4*)(G + row * ldg + col);
                    float g[8] = {bf_lo(gw.x), bf_hi(gw.x), bf_lo(gw.y), bf_hi(gw.y), bf_lo(gw.z), bf_hi(gw.z), bf_lo(gw.w), bf_hi(gw.w)};
                    f32x4 v0, v1;
#pragma unroll
                    for (int e = 0; e < 4; ++e) { v0[e] = acc[ai][bj][m][0][e] * __builtin_amdgcn_rcpf(1.f + __builtin_amdgcn_exp2f(-LOG2E * g[e]));
                                                  v1[e] = acc[ai][bj][m][1][e] * __builtin_amdgcn_rcpf(1.f + __builtin_amdgcn_exp2f(-LOG2E * g[4 + e])); }
                    float* mp = MF + row * DM + col;
                    if (PASS > 0) { v0 += *(const f32x4*)mp; v1 += *(const f32x4*)(mp + 4); }
                    if (PASS < 2) { *(f32x4*)mp = v0; *(f32x4*)(mp + 4) = v1; }
                    else { u32x4 w; w.x = cvt_pk_bf16(v0[0], v0[1]); w.y = cvt_pk_bf16(v0[2], v0[3]); w.z = cvt_pk_bf16(v1[0], v1[1]); w.w = cvt_pk_bf16(v1[2], v1[3]);
                           *(u32x4*)(MG + row * DM + col) = w; } } }
    }
};
struct EpiBranchRatio {
    static constexpr bool PERM = true, HAS_MID = true, RS = false, RSQ_OUT = false;
    const bf16* G; int ldg; bf16* MG;
    __device__ __forceinline__ void mid(f32x4 (&acc)[2][2][4][2], const Unit& u, int seg, int wr, int wc, int fr, int fq) const {
        const int row0 = u.pm * BM + wr * 64 + fr; const int col0 = u.pn * BM + wc * 32 + 8 * fq;
        const bf16* Ga = G + (seg - 1) * DM; const bf16* Gb = G + seg * DM;
#pragma unroll
        for (int ai = 0; ai < 2; ++ai)
#pragma unroll
            for (int mp = 0; mp < 2; ++mp) {
                u32x4 ga[2][2], gb[2][2];
#pragma unroll
                for (int mm = 0; mm < 2; ++mm)
#pragma unroll
                    for (int bj = 0; bj < 2; ++bj) { const size_t off = (size_t)(row0 + ai * HALF + (2 * mp + mm) * 16) * ldg + col0 + bj * HALF;
                        ga[mm][bj] = *(const u32x4*)(Ga + off); gb[mm][bj] = *(const u32x4*)(Gb + off); }
#pragma unroll
                for (int mm = 0; mm < 2; ++mm)
#pragma unroll
                    for (int bj = 0; bj < 2; ++bj) { const int m = 2 * mp + mm; const u32x4 a_ = ga[mm][bj], b_ = gb[mm][bj];
                        const float sa[8] = {bf_lo(a_.x), bf_hi(a_.x), bf_lo(a_.y), bf_hi(a_.y), bf_lo(a_.z), bf_hi(a_.z), bf_lo(a_.w), bf_hi(a_.w)};
                        const float sb[8] = {bf_lo(b_.x), bf_hi(b_.x), bf_lo(b_.y), bf_hi(b_.y), bf_lo(b_.z), bf_hi(b_.z), bf_lo(b_.w), bf_hi(b_.w)};
#pragma unroll
                        for (int e = 0; e < 4; ++e) { acc[ai][bj][m][0][e] *= sa[e] * __builtin_amdgcn_rcpf(fmaxf(sb[e], 1e-30f)); acc[ai][bj][m][1][e] *= sa[4 + e] * __builtin_amdgcn_rcpf(fmaxf(sb[4 + e], 1e-30f)); } }
            }
    }
    __device__ __forceinline__ void operator()(const f32x4 (&acc)[2][2][4][2], const Unit& u, int wr, int wc, int fr, int fq) const {
        const int row0 = u.pm * BM + wr * 64 + fr; const int col0 = u.pn * BM + wc * 32 + 8 * fq;
        const bf16* Gc = G + 2 * DM;
#pragma unroll
        for (int ai = 0; ai < 2; ++ai)
#pragma unroll
            for (int mp = 0; mp < 2; ++mp) {
                u32x4 gc[2][2];
#pragma unroll
                for (int mm = 0; mm < 2; ++mm)
#pragma unroll
                    for (int bj = 0; bj < 2; ++bj) gc[mm][bj] = *(const u32x4*)(Gc + (size_t)(row0 + ai * HALF + (2 * mp + mm) * 16) * ldg + col0 + bj * HALF);
#pragma unroll
                for (int mm = 0; mm < 2; ++mm)
#pragma unroll
                    for (int bj = 0; bj < 2; ++bj) { const int m = 2 * mp + mm; const u32x4 c_ = gc[mm][bj];
                        const float sc[8] = {bf_lo(c_.x), bf_hi(c_.x), bf_lo(c_.y), bf_hi(c_.y), bf_lo(c_.z), bf_hi(c_.z), bf_lo(c_.w), bf_hi(c_.w)};
                        f32x4 v0, v1;
#pragma unroll
                        for (int e = 0; e < 4; ++e) { v0[e] = acc[ai][bj][m][0][e] * sc[e]; v1[e] = acc[ai][bj][m][1][e] * sc[4 + e]; }
                        u32x4 w; w.x = cvt_pk_bf16(v0[0], v0[1]); w.y = cvt_pk_bf16(v0[2], v0[3]); w.z = cvt_pk_bf16(v1[0], v1[1]); w.w = cvt_pk_bf16(v1[2], v1[3]);
                        *(u32x4*)(MG + (size_t)(row0 + ai * HALF + m * 16) * DM + col0 + bj * HALF) = w; }
            }
    }
};
template <bool XIN16, bool XOUT16> struct EpiResid {
    static constexpr bool PERM = true, HAS_MID = false, RS = false, RSQ_OUT = XOUT16;
    const void* xin; void* out; const float* gvec; float* rsqp; LAS float* part;
    __device__ __forceinline__ void operator()(const f32x4 (&acc)[2][2][4][2], const Unit& u, int wr, int wc, int fr, int fq) const {
        const int row0 = u.pm * BM + wr * 64 + fr; const int col0 = u.pn * BM + wc * 32 + 8 * fq;
        f32x4 gv[2][2];
#pragma unroll
        for (int bj = 0; bj < 2; ++bj)
#pragma unroll
            for (int n = 0; n < 2; ++n) gv[bj][n] = *(const f32x4*)(gvec + col0 + bj * HALF + n * 4);
#pragma unroll
        for (int ai = 0; ai < 2; ++ai)
#pragma unroll
            for (int mp = 0; mp < 2; ++mp) {
                f32x4 xv[2][2][2];
#pragma unroll
                for (int mm = 0; mm < 2; ++mm) { const size_t off = (size_t)(row0 + ai * HALF + (2 * mp + mm) * 16) * DM + col0;
#pragma unroll
                    for (int bj = 0; bj < 2; ++bj) {
                        if (XIN16) { const u32x4 w_ = *(const u32x4*)((const bf16*)xin + off + bj * HALF);
                            xv[mm][bj][0] = (f32x4){bf_lo(w_.x), bf_hi(w_.x), bf_lo(w_.y), bf_hi(w_.y)}; xv[mm][bj][1] = (f32x4){bf_lo(w_.z), bf_hi(w_.z), bf_lo(w_.w), bf_hi(w_.w)}; }
                        else { xv[mm][bj][0] = *(const f32x4*)((const float*)xin + off + bj * HALF); xv[mm][bj][1] = *(const f32x4*)((const float*)xin + off + bj * HALF + 4); } } }
#pragma unroll
                for (int mm = 0; mm < 2; ++mm) { const int m = 2 * mp + mm; const size_t off = (size_t)(row0 + ai * HALF + m * 16) * DM + col0; float ss = 0.f;
#pragma unroll
                    for (int bj = 0; bj < 2; ++bj) { const f32x4 v0 = xv[mm][bj][0] + gv[bj][0] * acc[ai][bj][m][0], v1 = xv[mm][bj][1] + gv[bj][1] * acc[ai][bj][m][1];
                        if (XOUT16) ss += ((v0[0] * v0[0] + v0[1] * v0[1]) + (v0[2] * v0[2] + v0[3] * v0[3])) + ((v1[0] * v1[0] + v1[1] * v1[1]) + (v1[2] * v1[2] + v1[3] * v1[3]));
                        if (XOUT16) { u32x4 w; w.x = cvt_pk_bf16(v0[0], v0[1]); w.y = cvt_pk_bf16(v0[2], v0[3]); w.z = cvt_pk_bf16(v1[0], v1[1]); w.w = cvt_pk_bf16(v1[2], v1[3]);
                            *(u32x4*)((bf16*)out + off + bj * HALF) = w; }
                        else { *(f32x4*)((float*)out + off + bj * HALF) = v0; *(f32x4*)((float*)out + off + bj * HALF + 4) = v1; } }
                    if (XOUT16) { ss += swz<16>(ss); ss = half_sum(ss);
                        if (fq == 0) part[wc * BM + ai * HALF + wr * 64 + m * 16 + fr] = ss; } }
            }
    }
};

template <class Epi, class Sched>
__device__ __forceinline__ void gemm_phase(LAS unsigned char* lds, const Gemm g, const Sched& S, const Epi& E, const int wv) {
    int tid = MYTID(wv); asm volatile("" : "+v"(tid));
    const int wid = __builtin_amdgcn_readfirstlane(tid >> 6), lane = tid & 63, wr = wid >> 2, wc = wid & 3, fr = lane & 15, fq = lane >> 4;
    const int K = g.K, nt = K / BK, lda = g.lda;
    const int thook = nt >= 6 ? 4 : nt - 2;
    unsigned voffA[2], voffB[2];
#pragma unroll
    for (int i = 0; i < 2; ++i) { int R, C; stage_rc(tid * 16 + i * 8192, R, C); const int Rb = Epi::PERM ? ((R & ~31) + perm32(R & 31)) : R;
        voffA[i] = (unsigned)(R * lda + C) * 2u; voffB[i] = (unsigned)(Rb * K + C) * 2u; }
    const size_t kstep = (size_t)(BK * 2);
    const size_t hsA = (size_t)HALF * lda * 2, hsB = (size_t)HALF * K * 2;
    const size_t tsA = 2 * hsA, tsB = 2 * hsB;
    const unsigned ldsw = (unsigned)wid * 1024u;
    const int aoff = lds_byte(wr * 64 + fr, fq * 8), boff = lds_byte(wc * 32 + fr, fq * 8);
#define PG8_SA(b, h) (((b) * 2 + (h)) * HTB)
#define PG8_SB(b, h) ((4 + (b) * 2 + (h)) * HTB)
#define PG8_STAGE(bufoff, gbase, voff) do { _Pragma("unroll") for (int _i = 0; _i < 2; ++_i) \
        __builtin_amdgcn_global_load_lds((const unsigned*)((const char*)(gbase) + (voff)[_i]), (LAS unsigned*)(lds + (bufoff) + ldsw + _i * 8192), 16, 0, 0); } while (0)
#define PG8_LDA(dst, b, h) do { _Pragma("unroll") for (int m = 0; m < 4; ++m) _Pragma("unroll") for (int k = 0; k < 2; ++k) dst[m][k] = *(const LAS bf16x8*)(lds + PG8_SA(b, h) + aoff + m * 2048 + k * 1024); } while (0)
#define PG8_LDB(dst, b, h) do { _Pragma("unroll") for (int n = 0; n < 2; ++n) _Pragma("unroll") for (int k = 0; k < 2; ++k) dst[n][k] = *(const LAS bf16x8*)(lds + PG8_SB(b, h) + boff + n * 2048 + k * 1024); } while (0)
#define PG8_MMA(ai, bj, At, Bt) do { __builtin_amdgcn_s_setprio(1); _Pragma("unroll") for (int m = 0; m < 4; ++m) _Pragma("unroll") for (int n = 0; n < 2; ++n) _Pragma("unroll") for (int k = 0; k < 2; ++k) \
        acc[ai][bj][m][n] = __builtin_amdgcn_mfma_f32_16x16x32_bf16(Bt[n][k], At[m][k], acc[ai][bj][m][n], 0, 0, 0); __builtin_amdgcn_s_setprio(0); } while (0)
#define PG8_WAIT_V(n) asm volatile("s_waitcnt vmcnt(" #n ")" ::: "memory")
#define PG8_WAIT_L(n) asm volatile("s_waitcnt lgkmcnt(" #n ")" ::: "memory")
#define PG8_BAR __builtin_amdgcn_s_barrier()
#define PG8_SCHED __builtin_amdgcn_sched_barrier(0)
    Unit cur, nxt; int ui = 0;
    if (!S.next(0, cur)) return;
    f32x4 acc[2][2][4][2];
#pragma unroll
    for (int a = 0; a < 2; ++a)
#pragma unroll
        for (int b = 0; b < 2; ++b)
#pragma unroll
            for (int m = 0; m < 4; ++m)
#pragma unroll
                for (int n = 0; n < 2; ++n) acc[a][b][m][n] = (f32x4){0.f, 0.f, 0.f, 0.f};
    bf16x8 At[4][2], B0[2][2], B1[2][2];
    const char* cA = (const char*)g.A + (size_t)cur.pm * tsA; const char* cB = (const char*)g.Bt + (size_t)cur.pn * tsB;
    S.a_ready(cur);
    PG8_STAGE(PG8_SB(0, 0), cB, voffB); PG8_STAGE(PG8_SB(0, 1), cB + hsB, voffB); PG8_STAGE(PG8_SA(0, 0), cA, voffA); PG8_STAGE(PG8_SA(0, 1), cA + hsA, voffA);
    if (wr == 1) PG8_BAR;
    PG8_WAIT_V(2); PG8_BAR;
    PG8_STAGE(PG8_SB(1, 0), cB + kstep, voffB); PG8_STAGE(PG8_SA(1, 0), cA + kstep, voffA); PG8_STAGE(PG8_SB(1, 1), cB + hsB + kstep, voffB);
    PG8_WAIT_V(6); PG8_BAR;
    for (;;) {
        const bool has_next = S.next(ui + 1, nxt);
        const char* nA = has_next ? (const char*)g.A + (size_t)nxt.pm * tsA : cA; const char* nB = has_next ? (const char*)g.Bt + (size_t)nxt.pn * tsB : cB;
        for (int t = 0; t < nt; t += 2) {
            const bool last = (t == nt - 2);
            const char* a1 = cA + (size_t)(t + 1) * kstep;
            const char* a2 = last ? nA : cA + (size_t)(t + 2) * kstep; const char* b2 = last ? nB : cB + (size_t)(t + 2) * kstep;
            const char* a3 = a2 + kstep; const char* b3 = b2 + kstep;
            if (last && has_next) S.a_ready(nxt);
            if constexpr (Epi::HAS_MID) { if (t > 0 && (t & 15) == 0) E.mid(acc, cur, t >> 4, wr, wc, fr, fq); }
            if constexpr (Epi::RS) { if (t == thook) {
                const int ln_ = lane_id();
                __builtin_amdgcn_global_load_lds((const unsigned*)((const char*)(E.rsqp + (size_t)cur.pm * BM * 8) + ldsw + ln_ * 16), (LAS unsigned*)(lds + RS_OFF + ldsw), 16, 0, 0);
                if constexpr (!Epi::NO_BIAS) { if (wid == 0) __builtin_amdgcn_global_load_lds((const unsigned*)((const char*)(E.bias + cur.pn * BM) + ln_ * 16), (LAS unsigned*)(lds + RS_OFF + 8192), 16, 0, 0); } } }
            PG8_LDB(B0, 0, 0); PG8_LDB(B1, 0, 1); PG8_SCHED; PG8_LDA(At, 0, 0); PG8_STAGE(PG8_SA(1, 1), a1 + hsA, voffA);
            PG8_WAIT_V(8); PG8_WAIT_L(0); PG8_BAR; PG8_MMA(0, 0, At, B0); PG8_MMA(0, 1, At, B1); PG8_BAR; PG8_SCHED;
            PG8_LDA(At, 0, 1); PG8_STAGE(PG8_SB(0, 0), b2, voffB); PG8_STAGE(PG8_SB(0, 1), b2 + hsB, voffB); PG8_STAGE(PG8_SA(0, 0), a2, voffA);
            PG8_WAIT_V(8); PG8_WAIT_L(0); PG8_BAR; PG8_MMA(1, 0, At, B0); PG8_MMA(1, 1, At, B1); PG8_BAR; PG8_SCHED;
            PG8_LDB(B0, 1, 0); PG8_LDB(B1, 1, 1); PG8_SCHED; PG8_LDA(At, 1, 0); PG8_STAGE(PG8_SA(0, 1), a2 + hsA, voffA);
            PG8_WAIT_V(8); PG8_WAIT_L(0); PG8_BAR; PG8_MMA(0, 0, At, B0); PG8_MMA(0, 1, At, B1); PG8_BAR; PG8_SCHED;
            PG8_LDA(At, 1, 1); PG8_STAGE(PG8_SB(1, 0), b3, voffB); PG8_STAGE(PG8_SB(1, 1), b3 + hsB, voffB); PG8_STAGE(PG8_SA(1, 0), a3, voffA);
            PG8_WAIT_V(8); PG8_WAIT_L(0); PG8_BAR; PG8_MMA(1, 0, At, B0); PG8_MMA(1, 1, At, B1); PG8_BAR; PG8_SCHED;
        }
        if (wr == 0) PG8_BAR;
        if constexpr (Epi::RS) E(acc, cur, wr, wc, fr, fq, (const LAS float*)(lds + RS_OFF), (const LAS float*)(lds + RS_OFF + 8192), (LAS float*)(lds + RS_OFF + 9216)); else E(acc, cur, wr, wc, fr, fq);
        S.done(cur);
        if constexpr (Epi::RS) { if constexpr (Epi::RSO) { if (cur.pn >= C_CQ / 256 && cur.pn <= C_CKV / 256) {
            asm volatile("s_waitcnt lgkmcnt(0)" ::: "memory"); PG8_BAR;
            const int t2 = wid * 64 + lane_id();
            if (t2 < BM) { const LAS float* pp = (const LAS float*)(lds + RS_OFF + 9216) + t2; const float sm = (pp[0] + pp[BM]) + (pp[2 * BM] + pp[3 * BM]);
                const bool ckv = cur.pn == C_CKV / 256; const int slot = ckv ? 0 : cur.pn - C_CQ / 256; float* rq = (ckv ? E.rq_ckv : E.rq_cq) + (size_t)(cur.pm * BM + t2) * 8;
                rq[slot] = sm;
                if (slot == 0) {
                    float zf; asm volatile("v_mov_b32 %0, 0" : "=v"(zf));
                    if (ckv) rq[1] = zf;
#pragma unroll
                    for (int z = 2; z < 8; ++z) rq[z] = zf; } } } } }
        if constexpr (Epi::RSQ_OUT) {
            asm volatile("s_waitcnt lgkmcnt(0)" ::: "memory"); PG8_BAR;
            const int t2 = wid * 64 + lane_id();
            if (t2 < BM) { const LAS float* pp = (const LAS float*)(lds + RS_OFF) + t2; E.rsqp[(size_t)(cur.pm * BM + t2) * 8 + cur.pn] = (pp[0] + pp[BM]) + (pp[2 * BM] + pp[3 * BM]); } }
        if (!has_next) break;
#pragma unroll
        for (int a = 0; a < 2; ++a)
#pragma unroll
            for (int b = 0; b < 2; ++b)
#pragma unroll
                for (int m = 0; m < 4; ++m)
#pragma unroll
                    for (int n = 0; n < 2; ++n) acc[a][b][m][n] = (f32x4){0.f, 0.f, 0.f, 0.f};
        cur = nxt; cA = nA; cB = nB; ++ui;
        if (wr == 1) PG8_BAR;
    }
    PG8_WAIT_V(0);
    PG8_BAR;
#undef PG8_SA
#undef PG8_SB
#undef PG8_STAGE
#undef PG8_LDA
#undef PG8_LDB
#undef PG8_MMA
#undef PG8_WAIT_V
#undef PG8_WAIT_L
#undef PG8_BAR
#undef PG8_SCHED
}
}

namespace att {
constexpr int NW = 8, QBLK = 32, KVBLK = 64, QB = 256;
constexpr int SHM_V = KVBLK * 128 * 2;
constexpr int NSLOT = 3, KSLOT = 64 * 192 * 2;
constexpr int L_V = 0, L_K = NSLOT * SHM_V, L_WS = L_K + NSLOT * KSLOT, L_BIAS = L_WS + NW * 64 * 4, L_FLAG = L_BIAS + 1024, L_QT = 0, L_END = L_FLAG + 256;
static_assert(L_END <= RING_BYTES, "attention LDS");
#define SBAR() __builtin_amdgcn_sched_barrier(0)
__device__ __forceinline__ int crow(int r, int hi) { return (r & 3) + 8 * (r >> 2) + 4 * hi; }
template <int RB> __device__ __forceinline__ int kaddr(int row, int blk, int c8) {
    const int sw = (RB == 256) ? (row & 7) : ((row >> 1) & 7);
    return row * RB + blk * 128 + ((c8 ^ sw) << 4);
}
template <int RB> __device__ __forceinline__ int kswz(int row, int colB) { return kaddr<RB>(row, colB >> 7, (colB >> 4) & 7); }
constexpr float THR = 11.0f;
__device__ __forceinline__ void partialSM(f32x16& p0, f32x16& p1, float& m_reg, float& mn, float& alpha) {
    float pmax = p0[0];
#pragma unroll
    for (int r = 1; r < 16; ++r) pmax = fmaxf(pmax, p0[r]);
#pragma unroll
    for (int r = 0; r < 16; ++r) pmax = fmaxf(pmax, p1[r]);
    { auto rr = __builtin_amdgcn_permlane32_swap(__float_as_uint(pmax), __float_as_uint(pmax), false, false);
      pmax = fmaxf(__uint_as_float(rr[0]), __uint_as_float(rr[1])); }
    if (__builtin_expect(__all(pmax - m_reg <= THR), 1)) { mn = m_reg; alpha = 1.f; }
    else { mn = fmaxf(m_reg, pmax); alpha = __builtin_amdgcn_exp2f(m_reg - mn); m_reg = mn; }
#pragma unroll
    for (int r = 0; r < 16; ++r) p0[r] = p0[r] - mn;
#pragma unroll
    for (int r = 0; r < 16; ++r) p1[r] = p1[r] - mn;
#pragma unroll
    for (int r = 0; r < 16; ++r) p0[r] = __builtin_amdgcn_exp2f(p0[r]);
}
#define PK4(P, BASE, OUT) do { unsigned a0 = cvt_pk_bf16(P[BASE + 0], P[BASE + 1]), a1 = cvt_pk_bf16(P[BASE + 2], P[BASE + 3]);   \
    unsigned b0 = cvt_pk_bf16(P[BASE + 4], P[BASE + 5]), b1 = cvt_pk_bf16(P[BASE + 6], P[BASE + 7]);                              \
    auto r0 = __builtin_amdgcn_permlane32_swap(a0, b0, false, false); auto r1 = __builtin_amdgcn_permlane32_swap(a1, b1, false, false); \
    u32x4 w = {r0[0], r1[0], r0[1], r1[1]}; OUT = *reinterpret_cast<bf16x8*>(&w); } while (0)
__device__ __forceinline__ void finishSM(f32x16& p0, f32x16& p1, float alpha, float& l_reg, bf16x8& pa0, bf16x8& pa1, bf16x8& pa2, bf16x8& pa3) {
#pragma unroll
    for (int r = 0; r < 16; ++r) p1[r] = __builtin_amdgcn_exp2f(p1[r]);
    float ps = 0;
#pragma unroll
    for (int r = 0; r < 16; ++r) ps += p0[r];
#pragma unroll
    for (int r = 0; r < 16; ++r) ps += p1[r];
    { auto rr = __builtin_amdgcn_permlane32_swap(__float_as_uint(ps), __float_as_uint(ps), false, false);
      ps = __uint_as_float(rr[0]) + __uint_as_float(rr[1]); }
    l_reg = l_reg * alpha + ps;
    PK4(p0, 0, pa0); PK4(p0, 8, pa1); PK4(p1, 0, pa2); PK4(p1, 8, pa3);
}
template <int DK, int QREG> __device__ __forceinline__ void qkt(f32x16& p0, f32x16& p1, const LAS char* Ks, const bf16x8* qr, const LAS char* qt, int r32, int hi) {
    constexpr int RB = DK * 2;
    p0 = f32x16{}; p1 = f32x16{};
#pragma unroll
    for (int d0 = 0; d0 < DK / 16; ++d0) { const int ka = kaddr<RB>(r32, d0 >> 2, 4 * hi + (d0 & 3));
        const bf16x8 b0 = *(const LAS bf16x8*)(Ks + ka);
        const bf16x8 b1 = *(const LAS bf16x8*)(Ks + ka + 32 * RB);
        bf16x8 qf;
        if (d0 < QREG) qf = qr[d0]; else qf = *(const LAS bf16x8*)(qt + kaddr<128>(r32, (d0 - QREG) >> 2, 4 * hi + (d0 & 3)));
        p0 = __builtin_amdgcn_mfma_f32_32x32x16_bf16(b0, qf, p0, 0, 0, 0);
        p1 = __builtin_amdgcn_mfma_f32_32x32x16_bf16(b1, qf, p1, 0, 0, 0); }
}
__device__ __forceinline__ int v_st(int k, int c) { const int kk = (k & ~0xC) | ((k & 4) << 1) | ((k & 8) >> 1); return ((kk >> 3) * 4 + (c >> 5)) * 512 + ((kk & 7) * 32 + (c & 31)) * 2; }
__device__ __forceinline__ int v_rd_base(int lane) { return ((lane & 3) << 3) | (((lane >> 2) & 3) << 6) | (((lane >> 4) & 1) << 5) | (((lane >> 5) & 1) << 8); }
constexpr int v_rd_off(int d0, int ks, int half) { return d0 * 512 + ks * 4096 + half * 2048; }
template <int OFF> __device__ __forceinline__ s16x4 tr_read(int vb) {
    s16x4 r; asm volatile("ds_read_b64_tr_b16 %0, %1 offset:%2" : "=&v"(r) : "v"(vb), "i"(OFF) : "memory"); return r;
}
template <int D0> __device__ __forceinline__ void pv_one(f32x16& od, int vb, bf16x8 pa0, bf16x8 pa1, bf16x8 pa2, bf16x8 pa3) {
    const s16x4 l0 = tr_read<v_rd_off(D0, 0, 0)>(vb), h0 = tr_read<v_rd_off(D0, 0, 1)>(vb), l1 = tr_read<v_rd_off(D0, 1, 0)>(vb), h1 = tr_read<v_rd_off(D0, 1, 1)>(vb);
    const s16x4 l2 = tr_read<v_rd_off(D0, 2, 0)>(vb), h2 = tr_read<v_rd_off(D0, 2, 1)>(vb), l3 = tr_read<v_rd_off(D0, 3, 0)>(vb), h3 = tr_read<v_rd_off(D0, 3, 1)>(vb);
    asm volatile("s_waitcnt lgkmcnt(0)" ::: "memory"); SBAR();
#define PKV(L, H) (bf16x8){L[0], L[1], L[2], L[3], H[0], H[1], H[2], H[3]}
    od = __builtin_amdgcn_mfma_f32_32x32x16_bf16(pa0, PKV(l0, h0), od, 0, 0, 0);
    od = __builtin_amdgcn_mfma_f32_32x32x16_bf16(pa1, PKV(l1, h1), od, 0, 0, 0);
    od = __builtin_amdgcn_mfma_f32_32x32x16_bf16(pa2, PKV(l2, h2), od, 0, 0, 0);
    od = __builtin_amdgcn_mfma_f32_32x32x16_bf16(pa3, PKV(l3, h3), od, 0, 0, 0);
#undef PKV
}
__device__ __forceinline__ void pv_d0(f32x16* o, int vb, bf16x8 pa0, bf16x8 pa1, bf16x8 pa2, bf16x8 pa3) {
    pv_one<0>(o[0], vb, pa0, pa1, pa2, pa3); pv_one<1>(o[1], vb, pa0, pa1, pa2, pa3); pv_one<2>(o[2], vb, pa0, pa1, pa2, pa3); pv_one<3>(o[3], vb, pa0, pa1, pa2, pa3);
}

struct KVSrc { const bf16* k0; int ldk0; const bf16* k1; int ldk1; const bf16* v; int ldv; };

template <int DK, int DK0> struct Stager {
    static constexpr int NK0 = DK0 / 64, NK1 = (DK - DK0) / 64, NKC = NK0 + NK1;
    static constexpr int CPR0 = DK0 / 8, CPR1 = (DK - DK0) / 8 > 0 ? (DK - DK0) / 8 : 1;
    const bf16* kb[NKC]; int kstride[NKC];
    int koff[NKC]; int klds[NKC];
    const bf16* vb; int vstride; int voff0, voff1, vst0, vst1;
    __device__ __forceinline__ void init(const KVSrc& s, int tid) {
#pragma unroll
        for (int i = 0; i < NK0; ++i) { const int c = tid + 512 * i, row = c / CPR0, ch = c % CPR0;
            kb[i] = s.k0; kstride[i] = 64 * s.ldk0; koff[i] = row * s.ldk0 + ch * 8; klds[i] = kswz<DK * 2>(row, ch * 16); }
#pragma unroll
        for (int i = 0; i < NK1; ++i) { const int c = tid + 512 * i, row = c / CPR1, ch = c % CPR1;
            kb[NK0 + i] = s.k1; kstride[NK0 + i] = 64 * s.ldk1; koff[NK0 + i] = row * s.ldk1 + ch * 8; klds[NK0 + i] = kswz<DK * 2>(row, DK0 * 2 + ch * 16); }
        const int sr = tid >> 4, sc = (tid & 15) * 8;
        vb = s.v; vstride = 64 * s.ldv; voff0 = sr * s.ldv + sc; voff1 = (32 + sr) * s.ldv + sc;
        vst0 = v_st(sr, sc); vst1 = v_st(32 + sr, sc);
    }
    __device__ __forceinline__ bf16x8 ldk(int i, int t) const { return *reinterpret_cast<const bf16x8*>(kb[i] + (size_t)t * kstride[i] + koff[i]); }
    __device__ __forceinline__ bf16x8 ldv0(int t) const { return *reinterpret_cast<const bf16x8*>(vb + (size_t)t * vstride + voff0); }
    __device__ __forceinline__ bf16x8 ldv1(int t) const { return *reinterpret_cast<const bf16x8*>(vb + (size_t)t * vstride + voff1); }
};

template <bool F32> __device__ __forceinline__ void store_o_staged(const f32x16 (&o)[4], const float* rl, LAS char* stg, float* Of, bf16* Ob, int ldo, int le) {
    const int r32e = le & 31, hie = le >> 5, rr0 = le >> 4, ch = le & 15;
    if constexpr (!F32) {
        LAS bf16* st = (LAS bf16*)stg;
#pragma unroll
        for (int r = 0; r < 16; ++r) { const int ro = (r & 3) + 8 * (r >> 2) + 4 * hie;
#pragma unroll
            for (int d0 = 0; d0 < 4; ++d0) { const float v = rl ? o[d0][r] * rl[r] : o[d0][r]; st[ro * 128 + d0 * 32 + r32e] = (bf16)(cvt_pk_bf16(v, v) & 0xffffu); } }
#pragma unroll
        for (int i = 0; i < 8; ++i) { const int row = i * 4 + rr0; const u32x4 v = *(const LAS u32x4*)(stg + row * 256 + ch * 16); *(u32x4*)(Ob + (size_t)row * ldo + ch * 8) = v; }
    } else {
        LAS float* st = (LAS float*)stg;
#pragma unroll
        for (int p = 0; p < 2; ++p) {
#pragma unroll
            for (int r = 0; r < 16; ++r) { const int ro = (r & 3) + 8 * (r >> 2) + 4 * hie;
#pragma unroll
                for (int dd = 0; dd < 2; ++dd) { const float v = rl ? o[2 * p + dd][r] * rl[r] : o[2 * p + dd][r]; st[ro * 64 + dd * 32 + r32e] = v; } }
#pragma unroll
            for (int i = 0; i < 8; ++i) { const int row = i * 4 + rr0; const f32x4 v = *(const LAS f32x4*)(stg + row * 256 + ch * 16); *(f32x4*)(Of + (size_t)row * ldo + p * 64 + ch * 4) = v; }
        }
    }
}
typedef short v4i16_t __attribute__((ext_vector_type(4)));
__device__ __forceinline__ s16x4 vtr(const LAS char* p) { return __builtin_bit_cast(s16x4, __builtin_amdgcn_ds_read_tr16_b64_v4i16((LAS v4i16_t*)p)); }
struct DaFin { const float* other; unsigned* cnt; float lam; const float* gsub; float omli; bool own_first; };
struct QPrep { const float* g; const float* rc; const float* rs; };
template <int DK, int DK0, bool BIAS, bool OUTF32, bool NEGM_, bool ILB, bool NOMAX = false, bool QPREP = false>
__device__ __forceinline__ void softmax_unit_v3(LAS char* lds, const bf16* Qb, int ldq, const KVSrc kv, int q0, float* Of, bf16* Ob, int ldo, const int wv, const DaFin fin = DaFin{}, const QPrep qp = QPrep{}) {
    constexpr int RB = DK * 2, NKCH = DK / 64, NQ = DK / 16, NM = 2 * NQ;
    constexpr bool NEGM = NEGM_ && !NOMAX;
    int tid = MYTID(wv); asm volatile("" : "+v"(tid));
    const int lane = tid & 63, r32 = lane & 31, hi = lane >> 5; const int wid = __builtin_amdgcn_readfirstlane(tid >> 6);
    LAS char* V_lds = lds + L_V; LAS char* K_lds = lds + L_K;
    LAS float* ws = (LAS float*)(lds + L_WS) + wid * 64; LAS float* li_l = ws; LAS float* al_l = ws + 32;
    const LAS float* tbl = (const LAS float*)(lds + L_BIAS);
    const bf16* kptr[NKCH]; int kstr[NKCH]; const bf16* vptr[2]; const int vstr = 64 * kv.ldv;
#pragma unroll
    for (int i = 0; i < NKCH; ++i) { const int p = (wid + 8 * i) * 1024 + lane * 16, row = p / RB, within = p - row * RB, blk = within >> 7;
        const int sw = (RB == 256) ? (row & 7) : ((row >> 1) & 7); const int c8 = ((within >> 4) & 7) ^ sw, col = (blk * 8 + c8) * 8;
        if (col < DK0) { kptr[i] = kv.k0 + (size_t)row * kv.ldk0 + col; kstr[i] = 64 * kv.ldk0; }
        else { kptr[i] = kv.k1 + (size_t)row * kv.ldk1 + (col - DK0); kstr[i] = 64 * kv.ldk1; } }
#pragma unroll
    for (int i = 0; i < 2; ++i) { const int p = (wid + 8 * i) * 1024 + lane * 16, sub = p >> 9, within = p & 511;
        const int kk = (sub >> 2) * 8 + (within >> 6), c = (sub & 3) * 32 + ((within & 63) >> 1);
        vptr[i] = kv.v + (size_t)kk * kv.ldv + c; }

#define DMA_TILE(slot) do { \
    _Pragma("unroll") for (int i_ = 0; i_ < NKCH; ++i_) { __builtin_amdgcn_global_load_lds((const unsigned*)kptr[i_], (LAS unsigned*)(K_lds + (slot) * KSLOT + (wid + 8 * i_) * 1024), 16, 0, 0); kptr[i_] += kstr[i_]; } \
    _Pragma("unroll") for (int i_ = 0; i_ < 2; ++i_) { __builtin_amdgcn_global_load_lds((const unsigned*)vptr[i_], (LAS unsigned*)(V_lds + (slot) * SHM_V + (wid + 8 * i_) * 1024), 16, 0, 0); vptr[i_] += vstr; } } while (0)
#define WAIT_BAR() asm volatile("s_waitcnt vmcnt(0) lgkmcnt(0)\n\ts_barrier" ::: "memory")
    DMA_TILE(0); DMA_TILE(1);
    float m_reg, l_reg = 0.f; f32x16 o[4] = {}; bf16x8 qr[NQ];
    const bf16* Qw = Qb + (size_t)(wid * QBLK + r32) * ldq + hi * 32;
#pragma unroll
    for (int d0 = 0; d0 < NQ; ++d0) qr[d0] = *reinterpret_cast<const bf16x8*>(Qw + (d0 >> 2) * 64 + (d0 & 3) * 8);
    if constexpr (QPREP) {
        static_assert(!QPREP || DK == 192, "QPREP: MLA head layout");
        float ssn = 0.f, ssp = 0.f;
#pragma unroll
        for (int d0 = 0; d0 < 12; ++d0)
#pragma unroll
            for (int e = 0; e < 8; ++e) { const float x = bf1((bf16)qr[d0][e]); if (d0 < 8) ssn += x * x; else ssp += x * x; }
        const float rn = rsq(half_sum(ssn) * (1.f / 128.f) + EPS) * SC_MLA, rp = rsq(half_sum(ssp) * (1.f / 64.f) + EPS) * SC_MLA;
        const int prow = q0 + wid * QBLK + r32;
#pragma unroll
        for (int d0 = 0; d0 < 12; ++d0) { const int col = (d0 >> 2) * 64 + hi * 32 + (d0 & 3) * 8;
            const f32x4 ga = *(const f32x4*)(qp.g + col), gb = *(const f32x4*)(qp.g + col + 4);
            float y[8];
#pragma unroll
            for (int e = 0; e < 8; ++e) y[e] = bf1((bf16)qr[d0][e]) * (d0 < 8 ? rn : rp) * (e < 4 ? ga[e] : gb[e - 4]);
            if (d0 >= 8) { const int i0 = (d0 & 3) * 8;
                const f32x4 ca = *(const f32x4*)(qp.rc + (size_t)prow * 32 + i0), cb = *(const f32x4*)(qp.rc + (size_t)prow * 32 + i0 + 4);
                const f32x4 sa = *(const f32x4*)(qp.rs + (size_t)prow * 32 + i0), sb = *(const f32x4*)(qp.rs + (size_t)prow * 32 + i0 + 4);
#pragma unroll
                for (int e = 0; e < 8; ++e) { auto rr = __builtin_amdgcn_permlane32_swap(__float_as_uint(y[e]), __float_as_uint(y[e]), false, false);
                    const float yp = __uint_as_float(hi ? rr[0] : rr[1]); const float c = e < 4 ? ca[e] : cb[e - 4], sn = e < 4 ? sa[e] : sb[e - 4];
                    y[e] = hi ? (yp * sn + y[e] * c) : (y[e] * c - yp * sn); } }
            u32x4 w; w.x = cvt_pk_bf16(y[0], y[1]); w.y = cvt_pk_bf16(y[2], y[3]); w.z = cvt_pk_bf16(y[4], y[5]); w.w = cvt_pk_bf16(y[6], y[7]);
            qr[d0] = __builtin_bit_cast(bf16x8, w); }
    }
    const LAS char* vrd = V_lds + v_rd_base(lane);
    const LAS char* krd[4];
#pragma unroll
    for (int j = 0; j < 4; ++j) krd[j] = K_lds + kaddr<RB>(r32, 0, 4 * hi + j);
    const int NT = q0 / KVBLK + 4;
    const int cw = q0 / KVBLK + (wid >> 1);
    const int tq = q0 + wid * QBLK + r32 + 64 - 4 * hi;
#define POST(P0, P1, jj) do { if ((jj) > cw) { float ni_ = -1e30f; asm volatile("" : "+v"(ni_));     \
        _Pragma("unroll") for (int r = 0; r < 16; ++r) { P0[r] = ni_; P1[r] = ni_; } } \
    else if (BIAS && (jj) >= cw - 2) { const int tb_ = tq - 64 * (jj); \
        _Pragma("unroll") for (int r = 0; r < 16; ++r) { const int kk_ = (r & 3) + 8 * (r >> 2); P0[r] += tbl[tb_ - kk_]; P1[r] += tbl[tb_ - kk_ - 32]; } } } while (0)
#define ROWMAX(P0, P1) ({ float a_ = fmaxf(fmaxf(P0[0], P0[1]), P1[0]), b_ = fmaxf(fmaxf(P0[2], P0[3]), P1[1]); a_ = fmaxf(fmaxf(a_, P1[2]), P1[3]); \
    _Pragma("unroll") for (int r = 4; r < 16; r += 4) { a_ = fmaxf(fmaxf(a_, P0[r]), P0[r + 1]); b_ = fmaxf(fmaxf(b_, P0[r + 2]), P0[r + 3]); a_ = fmaxf(fmaxf(a_, P1[r]), P1[r + 1]); b_ = fmaxf(fmaxf(b_, P1[r + 2]), P1[r + 3]); } \
    float m_ = fmaxf(a_, b_); auto rr_ = __builtin_amdgcn_permlane32_swap(__float_as_uint(m_), __float_as_uint(m_), false, false); fmaxf(__uint_as_float(rr_[0]), __uint_as_float(rr_[1])); })
    f32x16 pA0, pA1, pB0, pB1; u32x4 pw[4];
    WAIT_BAR();
    { pA0 = f32x16{}; pA1 = f32x16{};
#pragma unroll
      for (int d0 = 0; d0 < NQ; ++d0) { const bf16x8 b0 = *(const LAS bf16x8*)(krd[d0 & 3] + (d0 >> 2) * 128), b1 = *(const LAS bf16x8*)(krd[d0 & 3] + (d0 >> 2) * 128 + 32 * RB);
          pA0 = __builtin_amdgcn_mfma_f32_32x32x16_bf16(b0, qr[d0], pA0, 0, 0, 0); pA1 = __builtin_amdgcn_mfma_f32_32x32x16_bf16(b1, qr[d0], pA1, 0, 0, 0); }
      POST(pA0, pA1, 0);
      if constexpr (NOMAX) m_reg = 0.f; else m_reg = ROWMAX(pA0, pA1);
#pragma unroll
      for (int r = 0; r < 16; ++r) { pA0[r] = __builtin_amdgcn_exp2f(NOMAX ? pA0[r] : pA0[r] - m_reg); pA1[r] = __builtin_amdgcn_exp2f(NOMAX ? pA1[r] : pA1[r] - m_reg); } }
    f32x16 negm;
    if constexpr (NEGM) {
#pragma unroll
        for (int r = 0; r < 16; ++r) negm[r] = -m_reg;
        asm volatile("" : "+v"(negm)); }
    int s_prev = 0, s_cur = 1, s_next = 2;
#define ROT() do { const int t_ = s_prev; s_prev = s_cur; s_cur = s_next; s_next = t_; } while (0)
    unsigned ta0, ta1;
#define SLICE(Y0, Y1, s_) do { constexpr int g_ = (s_) >> 1, bs_ = (g_ & 1) * 8 + ((s_) & 1) * 4; \
        const float y0_ = (g_ < 2) ? Y0[bs_] : Y1[bs_], y1_ = (g_ < 2) ? Y0[bs_ + 1] : Y1[bs_ + 1], y2_ = (g_ < 2) ? Y0[bs_ + 2] : Y1[bs_ + 2], y3_ = (g_ < 2) ? Y0[bs_ + 3] : Y1[bs_ + 3]; \
        sacc0 += y0_; sacc1 += y1_; sacc0 += y2_; sacc1 += y3_; \
        if (((s_) & 1) == 0) { ta0 = cvt_pk_bf16(y0_, y1_); ta1 = cvt_pk_bf16(y2_, y3_); } \
        else { const unsigned tb0_ = cvt_pk_bf16(y0_, y1_), tb1_ = cvt_pk_bf16(y2_, y3_); \
               pw[g_] = (u32x4){ta0, ta1, tb0_, tb1_}; } } while (0)
#define PIN(x) asm volatile("" : "+v"(x))
#define KFRAG(i_) (*(const LAS bf16x8*)(krd[((i_) >> 1) & 3] + kso_ + ((i_) >> 3) * 128 + ((i_) & 1) * 32 * RB))
#define VLO(i_) vtr(vb_ + v_rd_off((i_) & 3, (i_) >> 2, 0))
#define VHI(i_) vtr(vb_ + v_rd_off((i_) & 3, (i_) >> 2, 1))
#define EXPX(XV, e_) XV[e_] = __builtin_amdgcn_exp2f((NEGM || NOMAX) ? XV[e_] : XV[e_] - m_reg)
#define PVX(D0, XV, B_, vba) do { \
        const s16x4 l0_ = tr_read<v_rd_off(D0, 0, 0)>(vba), h0_ = tr_read<v_rd_off(D0, 0, 1)>(vba), l1_ = tr_read<v_rd_off(D0, 1, 0)>(vba), h1_ = tr_read<v_rd_off(D0, 1, 1)>(vba); \
        const s16x4 l2_ = tr_read<v_rd_off(D0, 2, 0)>(vba), h2_ = tr_read<v_rd_off(D0, 2, 1)>(vba), l3_ = tr_read<v_rd_off(D0, 3, 0)>(vba), h3_ = tr_read<v_rd_off(D0, 3, 1)>(vba); \
        asm volatile("s_waitcnt lgkmcnt(0)" ::: "memory"); SBAR(); \
        o[D0] = __builtin_amdgcn_mfma_f32_32x32x16_bf16(__builtin_bit_cast(bf16x8, pw[0]), (bf16x8){l0_[0], l0_[1], l0_[2], l0_[3], h0_[0], h0_[1], h0_[2], h0_[3]}, o[D0], 0, 0, 0); EXPX(XV, B_ + 0); EXPX(XV, B_ + 1); PIN(XV); SBAR(); \
        o[D0] = __builtin_amdgcn_mfma_f32_32x32x16_bf16(__builtin_bit_cast(bf16x8, pw[1]), (bf16x8){l1_[0], l1_[1], l1_[2], l1_[3], h1_[0], h1_[1], h1_[2], h1_[3]}, o[D0], 0, 0, 0); EXPX(XV, B_ + 2); EXPX(XV, B_ + 3); PIN(XV); SBAR(); \
        o[D0] = __builtin_amdgcn_mfma_f32_32x32x16_bf16(__builtin_bit_cast(bf16x8, pw[2]), (bf16x8){l2_[0], l2_[1], l2_[2], l2_[3], h2_[0], h2_[1], h2_[2], h2_[3]}, o[D0], 0, 0, 0); EXPX(XV, B_ + 4); EXPX(XV, B_ + 5); PIN(XV); SBAR(); \
        o[D0] = __builtin_amdgcn_mfma_f32_32x32x16_bf16(__builtin_bit_cast(bf16x8, pw[3]), (bf16x8){l3_[0], l3_[1], l3_[2], l3_[3], h3_[0], h3_[1], h3_[2], h3_[3]}, o[D0], 0, 0, 0); EXPX(XV, B_ + 6); EXPX(XV, B_ + 7); PIN(XV); SBAR(); } while (0)
#define TRF(i_, vba) do { tl_[i_] = tr_read<v_rd_off((i_) >> 2, (i_) & 3, 0)>(vba); th_[i_] = tr_read<v_rd_off((i_) >> 2, (i_) & 3, 1)>(vba); } while (0)
#define PVM(i_, XV, B_, vba) do { \
        if ((i_) + 2 < 16) { TRF(((i_) + 2 < 16 ? (i_) + 2 : 15), vba); asm volatile("s_waitcnt lgkmcnt(4)" ::: "memory"); } \
        else if ((i_) + 1 < 16) asm volatile("s_waitcnt lgkmcnt(2)" ::: "memory"); else asm volatile("s_waitcnt lgkmcnt(0)" ::: "memory"); \
        SBAR(); \
        o[(i_) >> 2] = __builtin_amdgcn_mfma_f32_32x32x16_bf16(__builtin_bit_cast(bf16x8, pw[(i_) & 3]), (bf16x8){tl_[i_][0], tl_[i_][1], tl_[i_][2], tl_[i_][3], th_[i_][0], th_[i_][1], th_[i_][2], th_[i_][3]}, o[(i_) >> 2], 0, 0, 0); \
        EXPX(XV, B_); EXPX(XV, B_ + 1); PIN(XV); SBAR(); } while (0)
#define STEP(X0, X1, Y0, Y1, jj, HASNEXT) do { \
        const int kso_ = s_cur * KSLOT; const LAS char* vb_ = vrd + s_prev * SHM_V; \
        float sacc0 = 0.f, sacc1 = 0.f; \
        bf16x8 kf_[NM]; s16x4 vl_[16], vh_[16]; \
        SBAR(); \
        kf_[0] = KFRAG(0); kf_[1] = KFRAG(1); kf_[2] = KFRAG(2); SBAR(); \
          \
        _Pragma("unroll") for (int i_ = 0; i_ < NM; ++i_) { const int d0_ = i_ >> 1; \
            if (i_ + 3 < NM) kf_[i_ + 3] = KFRAG(i_ + 3); \
            if ((i_ & 1) == 0) X0 = __builtin_amdgcn_mfma_f32_32x32x16_bf16(kf_[i_], qr[d0_], (d0_ == 0) ? (NEGM ? negm : f32x16{}) : X0, 0, 0, 0); \
            else               X1 = __builtin_amdgcn_mfma_f32_32x32x16_bf16(kf_[i_], qr[d0_], (d0_ == 0) ? (NEGM ? negm : f32x16{}) : X1, 0, 0, 0); \
            if ((0 * NM) / 8 == i_) SLICE(Y0, Y1, 0); if ((1 * NM) / 8 == i_) SLICE(Y0, Y1, 1); if ((2 * NM) / 8 == i_) SLICE(Y0, Y1, 2); if ((3 * NM) / 8 == i_) SLICE(Y0, Y1, 3); \
            if ((4 * NM) / 8 == i_) SLICE(Y0, Y1, 4); if ((5 * NM) / 8 == i_) SLICE(Y0, Y1, 5); if ((6 * NM) / 8 == i_) SLICE(Y0, Y1, 6); if ((7 * NM) / 8 == i_) SLICE(Y0, Y1, 7); \
            PIN(sacc0); PIN(sacc1); SBAR(); } \
        l_reg += sacc0 + sacc1; \
        POST(X0, X1, jj); \
          \
        bool resc_ = false; \
        if constexpr (!NOMAX) { const float rm_ = ROWMAX(X0, X1); \
          if constexpr (NEGM) {              \
            if (__builtin_expect(__any(rm_ > THR), 0)) { const float dl_ = fmaxf(rm_, 0.f); const float al_ = __builtin_amdgcn_exp2f(-dl_); m_reg += dl_; l_reg *= al_; \
                _Pragma("unroll") for (int r = 0; r < 16; ++r) { X0[r] -= dl_; X1[r] -= dl_; negm[r] = -m_reg; } \
                { const int l2_ = lane_id(); if ((l2_ >> 5) == 0) al_l[l2_ & 31] = al_; } resc_ = true; } \
          } else { \
            if (__builtin_expect(__any(rm_ - m_reg > THR), 0)) { const float mn_ = fmaxf(m_reg, rm_); const float al_ = __builtin_amdgcn_exp2f(m_reg - mn_); m_reg = mn_; l_reg *= al_; \
                { const int l2_ = lane_id(); if ((l2_ >> 5) == 0) al_l[l2_ & 31] = al_; } resc_ = true; } } } \
        if (HASNEXT) DMA_TILE(s_next);     \
        PIN(X0); PIN(X1); SBAR(); \
        if constexpr (ILB) { \
        vl_[0] = VLO(0); vh_[0] = VHI(0); vl_[1] = VLO(1); vh_[1] = VHI(1); vl_[2] = VLO(2); vh_[2] = VHI(2); SBAR(); \
          \
        _Pragma("unroll") for (int i_ = 0; i_ < 16; ++i_) { const int ks_ = i_ >> 2, d0_ = i_ & 3; \
            if (i_ + 3 < 16) { vl_[i_ + 3] = VLO(i_ + 3); vh_[i_ + 3] = VHI(i_ + 3); } \
            const bf16x8 vf_ = (bf16x8){vl_[i_][0], vl_[i_][1], vl_[i_][2], vl_[i_][3], vh_[i_][0], vh_[i_][1], vh_[i_][2], vh_[i_][3]}; \
            o[d0_] = __builtin_amdgcn_mfma_f32_32x32x16_bf16(__builtin_bit_cast(bf16x8, pw[ks_]), vf_, o[d0_], 0, 0, 0); \
            if (i_ < 8) { X0[2 * i_] = __builtin_amdgcn_exp2f(NEGM ? X0[2 * i_] : X0[2 * i_] - m_reg); X0[2 * i_ + 1] = __builtin_amdgcn_exp2f(NEGM ? X0[2 * i_ + 1] : X0[2 * i_ + 1] - m_reg); PIN(X0); } \
            else { X1[2 * i_ - 16] = __builtin_amdgcn_exp2f(NEGM ? X1[2 * i_ - 16] : X1[2 * i_ - 16] - m_reg); X1[2 * i_ - 15] = __builtin_amdgcn_exp2f(NEGM ? X1[2 * i_ - 15] : X1[2 * i_ - 15] - m_reg); PIN(X1); } \
            SBAR(); } \
        } else { \
        const int vba_ = (int)(unsigned)(uintptr_t)vrd + s_prev * SHM_V; \
        s16x4 tl_[16], th_[16]; \
        TRF(0, vba_); TRF(1, vba_); \
        PVM(0, X0, 0, vba_); PVM(1, X0, 2, vba_); PVM(2, X0, 4, vba_); PVM(3, X0, 6, vba_); PVM(4, X0, 8, vba_); PVM(5, X0, 10, vba_); PVM(6, X0, 12, vba_); PVM(7, X0, 14, vba_); \
        PVM(8, X1, 0, vba_); PVM(9, X1, 2, vba_); PVM(10, X1, 4, vba_); PVM(11, X1, 6, vba_); PVM(12, X1, 8, vba_); PVM(13, X1, 10, vba_); PVM(14, X1, 12, vba_); PVM(15, X1, 14, vba_); } \
        if (resc_) { asm volatile("s_waitcnt lgkmcnt(0)" ::: "memory"); \
            const int h2_ = lane_id() >> 5;     \
            _Pragma("unroll") for (int d = 0; d < 4; ++d) _Pragma("unroll") for (int r = 0; r < 16; ++r) o[d][r] *= al_l[crow(r, h2_)]; } \
        WAIT_BAR(); ROT(); } while (0)
    for (int j = 1; j + 1 < NT; j += 2) {
        STEP(pB0, pB1, pA0, pA1, j, true);
        STEP(pA0, pA1, pB0, pB1, j + 1, true);
    }
    STEP(pB0, pB1, pA0, pA1, NT - 1, false);
    { float sacc0 = 0.f, sacc1 = 0.f;
      SLICE(pB0, pB1, 0); SLICE(pB0, pB1, 1); SLICE(pB0, pB1, 2); SLICE(pB0, pB1, 3); SLICE(pB0, pB1, 4); SLICE(pB0, pB1, 5); SLICE(pB0, pB1, 6); SLICE(pB0, pB1, 7);
      l_reg += sacc0 + sacc1;
      const LAS char* vb_ = vrd + s_prev * SHM_V;
#pragma unroll
      for (int i_ = 0; i_ < 16; ++i_) { const int ks_ = i_ >> 2, d0_ = i_ & 3;
          const s16x4 vl_ = vtr(vb_ + v_rd_off(d0_, ks_, 0)), vh_ = vtr(vb_ + v_rd_off(d0_, ks_, 1));
          const bf16x8 vf_ = (bf16x8){vl_[0], vl_[1], vl_[2], vl_[3], vh_[0], vh_[1], vh_[2], vh_[3]};
          o[d0_] = __builtin_amdgcn_mfma_f32_32x32x16_bf16(__builtin_bit_cast(bf16x8, pw[ks_]), vf_, o[d0_], 0, 0, 0); } }
    l_reg = half_sum(l_reg);
    { const int l3_ = lane_id(); if ((l3_ >> 5) == 0) li_l[l3_ & 31] = l_reg; } asm volatile("s_waitcnt lgkmcnt(0)" ::: "memory");
    { const int le = lane_id(), hie = le >> 5;
      float rl[16];
#pragma unroll
      for (int r = 0; r < 16; ++r) rl[r] = __builtin_amdgcn_rcpf(li_l[(r & 3) + 8 * (r >> 2) + 4 * hie]);
      if constexpr (!OUTF32) store_o_staged<false>(o, rl, K_lds + wid * 8192, nullptr, Ob + (size_t)(wid * QBLK) * ldo, ldo, le);
      else {
#pragma unroll
        for (int d0 = 0; d0 < 4; ++d0)
#pragma unroll
            for (int r = 0; r < 16; ++r) o[d0][r] *= rl[r];
        float* so = Of + (size_t)wid * 4096 + le * 4;
#pragma unroll
        for (int d0 = 0; d0 < 4; ++d0)
#pragma unroll
            for (int rq = 0; rq < 4; ++rq) *(f32x4*)(so + (4 * d0 + rq) * 256) = (f32x4){o[d0][4 * rq], o[d0][4 * rq + 1], o[d0][4 * rq + 2], o[d0][4 * rq + 3]};
        volatile LAS unsigned* flg = (volatile LAS unsigned*)(lds + L_FLAG);
        asm volatile("s_waitcnt vmcnt(0)" ::: "memory");
        __syncthreads();
        if (wid == 0 && le == 0) { __builtin_amdgcn_fence(__ATOMIC_RELEASE, "agent");
            const unsigned old = __hip_atomic_fetch_add(fin.cnt, 1u, __ATOMIC_RELAXED, __HIP_MEMORY_SCOPE_AGENT);
            if (old & 1u) __builtin_amdgcn_fence(__ATOMIC_ACQUIRE, "agent");
            flg[8] = old & 1u; }
        __syncthreads();
        if (flg[8]) {
            const float* po = fin.other + (size_t)wid * 4096 + le * 4;
            f32x4 pv[4][4];
#pragma unroll
            for (int d0 = 0; d0 < 4; ++d0)
#pragma unroll
                for (int rq = 0; rq < 4; ++rq) pv[d0][rq] = *(const f32x4*)(po + (4 * d0 + rq) * 256);
            float gs[4];
#pragma unroll
            for (int d0 = 0; d0 < 4; ++d0) gs[d0] = fin.gsub[32 * d0 + (le & 31)] * fin.omli;
#pragma unroll
            for (int r = 0; r < 16; ++r) { float ss = 0.f;
#pragma unroll
                for (int d0 = 0; d0 < 4; ++d0) { const float pp = pv[d0][r >> 2][r & 3]; const float dv = fin.own_first ? o[d0][r] - fin.lam * pp : pp - fin.lam * o[d0][r]; o[d0][r] = dv; ss += dv * dv; }
                ss += swz<1>(ss); ss += swz<2>(ss); ss += swz<4>(ss); ss += swz<8>(ss); ss += swz<16>(ss);
                const float rn = rsq(ss * (1.f / 128.f) + EPS);
#pragma unroll
                for (int d0 = 0; d0 < 4; ++d0) o[d0][r] = o[d0][r] * rn * gs[d0]; }
            store_o_staged<false>(o, nullptr, K_lds + wid * 8192, nullptr, Ob + (size_t)(wid * QBLK) * ldo, ldo, le);
        }
      } }
    asm volatile("s_waitcnt lgkmcnt(0)\n\ts_barrier" ::: "memory");
#undef DMA_TILE
#undef WAIT_BAR
#undef POST
#undef ROWMAX
#undef ROT
#undef SLICE
#undef STEP
#undef PVX
#undef PVM
#undef TRF
#undef EXPX
#undef PIN
#undef KFRAG
#undef VLO
#undef VHI
}

__device__ __forceinline__ void sb_unit(LAS char* lds, const bf16* Qb, int ldq, const KVSrc kv, int q0, bf16* Ob, int ldo, const int wv) {
    constexpr int DK = 128, SHM_K = 64 * DK * 2;
    int tid = MYTID(wv); asm volatile("" : "+v"(tid));
    const int lane = tid & 63, r32 = lane & 31, hi = lane >> 5; const int wid = __builtin_amdgcn_readfirstlane(tid >> 6);
    LAS char* V_lds = lds + L_V; LAS char* K_lds = lds + L_K;
    volatile LAS unsigned* flags = (volatile LAS unsigned*)(lds + L_FLAG);
    f32x16 o[4] = {}; bf16x8 qr[8];
    const bf16* Qw = Qb + (size_t)(wid * QBLK + r32) * ldq + hi * 32;
#pragma unroll
    for (int d0 = 0; d0 < 8; ++d0) qr[d0] = *reinterpret_cast<const bf16x8*>(Qw + (d0 >> 2) * 64 + (d0 & 3) * 8);
    Stager<128, 128> st; st.init(kv, tid);
    const int vb0 = (int)(unsigned)(uintptr_t)V_lds + v_rd_base(lane);
    const int cw = q0 / KVBLK + (wid >> 1);
    const int lim = 32 * (wid & 1) + r32;
    float R = 0.f; bool alive = true;
    bf16x8 vs0, vs1, ks0, ks1;
    int j = q0 / KVBLK + 3;
    vs0 = st.ldv0(j); vs1 = st.ldv1(j); ks0 = st.ldk(0, j); ks1 = st.ldk(1, j);
    for (; j >= 0; --j) {
        __syncthreads();
        *(LAS bf16x8*)(V_lds + st.vst0) = vs0; *(LAS bf16x8*)(V_lds + st.vst1) = vs1; *(LAS bf16x8*)(K_lds + st.klds[0]) = ks0; *(LAS bf16x8*)(K_lds + st.klds[1]) = ks1;
        __syncthreads();
        if (j > 0) { const int jn = j - 1;
            vs0 = st.ldv0(jn); vs1 = st.ldv1(jn); ks0 = st.ldk(0, jn); ks1 = st.ldk(1, jn); }
        if (j <= cw && alive) {
            f32x16 z0, z1, m0, m1;
            qkt<128, 8>(z0, z1, K_lds, qr, K_lds, r32, hi);
#pragma unroll
            for (int r = 0; r < 16; ++r) { z0[r] *= SC_SB; z1[r] *= SC_SB; }
            const bool diag = (j == cw);
#pragma unroll
            for (int r = 0; r < 16; ++r) {
                { const float zl = z0[r], e = __builtin_amdgcn_exp2f(-fabsf(zl)); const float l1p = (e < 2.44140625e-4f) ? e * LOG2E * (1.f - 0.5f * e) : __builtin_amdgcn_logf(1.f + e);
                  m0[r] = -(fmaxf(zl, 0.f) + l1p); }
                { const float zl = z1[r], e = __builtin_amdgcn_exp2f(-fabsf(zl)); const float l1p = (e < 2.44140625e-4f) ? e * LOG2E * (1.f - 0.5f * e) : __builtin_amdgcn_logf(1.f + e);
                  m1[r] = -(fmaxf(zl, 0.f) + l1p); }
            }
            if (diag) {
#pragma unroll
                for (int r = 0; r < 16; ++r) { const int kk = crow(r, hi);
                    if (!(kk < lim)) { m0[r] = 0.f; z0[r] = -1e30f; }
                    if (!(kk + 32 < lim)) { m1[r] = 0.f; z1[r] = -1e30f; } }
            }
            float Glo[8], Ghi[8];
#pragma unroll
            for (int i = 0; i < 8; ++i) { const float gs = (i < 4) ? (m0[4 * i] + m0[4 * i + 1]) + (m0[4 * i + 2] + m0[4 * i + 3])
                                                                   : (m1[4 * (i - 4)] + m1[4 * (i - 4) + 1]) + (m1[4 * (i - 4) + 2] + m1[4 * (i - 4) + 3]);
                auto rr = __builtin_amdgcn_permlane32_swap(__float_as_uint(gs), __float_as_uint(gs), false, false);
                Glo[i] = __uint_as_float(rr[0]); Ghi[i] = __uint_as_float(rr[1]); }
            float sa_odd = 0.f, sa_even = Ghi[7]; float base[8];
            base[7] = R + (hi ? sa_odd : sa_even);
#pragma unroll
            for (int i = 6; i >= 0; --i) { sa_odd = sa_even + Glo[i + 1]; sa_even = sa_odd + Ghi[i]; base[i] = R + (hi ? sa_odd : sa_even); }
            const float total = sa_even + Glo[0];
#pragma unroll
            for (int i = 0; i < 8; ++i) {
                if (i < 4) { const int b = 4 * i; float bt = base[i];
                    const float w3 = __builtin_amdgcn_exp2f(z0[b + 3] + m0[b + 3] + bt); bt += m0[b + 3];
                    const float w2 = __builtin_amdgcn_exp2f(z0[b + 2] + m0[b + 2] + bt); bt += m0[b + 2];
                    const float w1 = __builtin_amdgcn_exp2f(z0[b + 1] + m0[b + 1] + bt); bt += m0[b + 1];
                    const float w0 = __builtin_amdgcn_exp2f(z0[b] + m0[b] + bt);
                    z0[b] = w0; z0[b + 1] = w1; z0[b + 2] = w2; z0[b + 3] = w3; }
                else { const int b = 4 * (i - 4); float bt = base[i];
                    const float w3 = __builtin_amdgcn_exp2f(z1[b + 3] + m1[b + 3] + bt); bt += m1[b + 3];
                    const float w2 = __builtin_amdgcn_exp2f(z1[b + 2] + m1[b + 2] + bt); bt += m1[b + 2];
                    const float w1 = __builtin_amdgcn_exp2f(z1[b + 1] + m1[b + 1] + bt); bt += m1[b + 1];
                    const float w0 = __builtin_amdgcn_exp2f(z1[b] + m1[b] + bt);
                    z1[b] = w0; z1[b + 1] = w1; z1[b + 2] = w2; z1[b + 3] = w3; }
            }
            R += total;
            bf16x8 pa0, pa1, pa2, pa3;
            PK4(z0, 0, pa0); PK4(z0, 8, pa1); PK4(z1, 0, pa2); PK4(z1, 8, pa3);
            SBAR();
            pv_d0(o, vb0, pa0, pa1, pa2, pa3);
            alive = __any(R > SB_DEAD);
        }
        if (lane == 0) flags[wid] = alive ? 1u : 0u;
        __syncthreads();
        unsigned any_alive = 0;
#pragma unroll
        for (int w = 0; w < NW; ++w) any_alive |= flags[w];
        if (!any_alive) break;
    }
    { const int le = lane_id(); store_o_staged<false>(o, nullptr, K_lds + wid * 8192, nullptr, Ob + (size_t)(wid * QBLK) * ldo, ldo, le); }
    __syncthreads();
}
#undef PK4
#undef SBAR
}

typedef GAS unsigned gu32;
#define RLX_AGENT __ATOMIC_RELAXED, __HIP_MEMORY_SCOPE_AGENT
#define XB_TMO      128
#define XB_XCNT(j)  (256  + 64 * (j))
#define XB_XSUB(j)  (1280 + 64 * (j))
#define XB_XGEN(j)  (2304 + 64 * (j))
#define XB_TOP      3328
#define XB_TOPGEN   3392
#define XCD_BAR_WORDS 3456
#define XB_SPIN_CAP (1u << 18)
__device__ __forceinline__ unsigned xb_ld(unsigned* p)              { return __hip_atomic_load(p, __ATOMIC_RELAXED, __HIP_MEMORY_SCOPE_AGENT); }
__device__ __forceinline__ unsigned xb_add(unsigned* p, unsigned v) { return __hip_atomic_fetch_add(p, v, __ATOMIC_RELAXED, __HIP_MEMORY_SCOPE_AGENT); }
__device__ __forceinline__ unsigned xb_xcc_id() { return (unsigned)__builtin_amdgcn_s_getreg((3 << 11) | 20) & 0xFu; }
#define XB_SPIN(cond, bar) do { unsigned _sp = 0; while (cond) { __builtin_amdgcn_s_sleep(1); \
    if ((++_sp & 255u) == 0u) { if (xb_ld(&(bar)[XB_TMO])) break; if (_sp > XB_SPIN_CAP) { atomicAdd(&(bar)[XB_TMO], 1u); break; } } } } while (0)
struct XcdBarrier { unsigned* bar; unsigned x; volatile LAS unsigned* st; };
__device__ __forceinline__ XcdBarrier xcd_barrier_post(unsigned* bar, volatile LAS unsigned* st, const int wv) {
    XcdBarrier b; b.bar = bar; b.x = xb_xcc_id(); b.st = st;
    if (MYTID(wv) == 0) (void)xb_add(&bar[XB_XCNT(b.x)], 1u);
    return b;
}
__device__ __forceinline__ void xcd_barrier_complete(unsigned* bar, unsigned x, unsigned& nloc, unsigned& nx) {
    const unsigned G = gridDim.x * gridDim.y * gridDim.z;
    unsigned sum, cnt, mine, sp = 0u;
    for (;;) {
        sum = 0u; cnt = 0u; mine = 0u;
#pragma unroll
        for (unsigned j = 0; j < 16; ++j) { const unsigned c = xb_ld(&bar[XB_XCNT(j)]); sum += c; cnt += (c > 0u) ? 1u : 0u; mine = (j == x) ? c : mine; }
        if (sum == G) break;
        __builtin_amdgcn_s_sleep(1);
        if ((++sp & 255u) == 0u) { if (xb_ld(&bar[XB_TMO])) break; if (sp > XB_SPIN_CAP) { atomicAdd(&bar[XB_TMO], 1u); break; } }
    }
    nloc = mine > 0u ? mine : 1u; nx = cnt > 0u ? cnt : 1u;
}
__device__ __forceinline__ void xcd_barrier(const XcdBarrier& b, const int wv) {
    asm volatile("s_waitcnt vmcnt(0)" ::: "memory");
    __syncthreads();
    if (MYTID(wv) == 0) {
        GAS unsigned* barg_ = (GAS unsigned*)b.bar; asm volatile("" : "+s"(barg_)); unsigned* bar = (unsigned*)barg_; unsigned bx_ = b.x; asm volatile("" : "+s"(bx_));
        __builtin_amdgcn_s_waitcnt(0);
        unsigned nloc = b.st[0], nx = b.st[1];
        if (nloc == 0u) { xcd_barrier_complete(bar, bx_, nloc, nx); b.st[0] = nloc; b.st[1] = nx; }
        const unsigned old = xb_add(&bar[XB_XSUB(bx_)], 1u);
        const unsigned gen = old / nloc;
        if (old + 1u == (gen + 1u) * nloc) {
            __builtin_amdgcn_fence(__ATOMIC_RELEASE, "agent");
            asm volatile("s_waitcnt vmcnt(0)" ::: "memory");
            const unsigned og = xb_add(&bar[XB_TOP], 1u);
            const unsigned tg = og / nx;
            if (og + 1u == (tg + 1u) * nx) xb_add(&bar[XB_TOPGEN], 1u);
            else XB_SPIN(xb_ld(&bar[XB_TOPGEN]) == tg, bar);
            __builtin_amdgcn_fence(__ATOMIC_ACQUIRE, "agent");
            xb_add(&bar[XB_XGEN(bx_)], 1u);
            asm volatile("s_waitcnt vmcnt(0)" ::: "memory");
        } else {
            XB_SPIN(xb_ld(&bar[XB_XGEN(bx_)]) == gen, bar);
            __builtin_amdgcn_fence(__ATOMIC_ACQUIRE, "agent");
            asm volatile("s_waitcnt vmcnt(0)" ::: "memory");
        }
    }
    __syncthreads();
}

struct Args { const float* in[20]; float* out; unsigned char* ws; int ph_lo, ph_hi, dup, pad; };
enum { I_X = 0, I_C, I_WADA, I_BADA, I_GMIX, I_GMLP, I_WIN, I_DQKG, I_DLAM, I_DSUB, I_T5, I_MQG, I_MKVG, I_WQUP, I_WKVUP, I_MQKG, I_WBR, I_WOUT, I_WM1, I_WM2 };
constexpr int NWAVES = 8, NTHR = 512;
constexpr int PH_PER_LAYER = 12, NPHASE = 1 + DEPTH * PH_PER_LAYER;

struct ConvDesc { const float* src; int N; bf16* dst; int ldk; const float* gk; const float* sk; };
__device__ __forceinline__ ConvDesc conv_make(const float* W, int K, int N, bf16* WT, int row_off, int item, int lane, int ldk, const float* g = nullptr, const float* sc = nullptr) {
    const int nblk = N / 32, kb = item / nblk, nb = item % nblk, k0 = 64 * kb, n0 = 32 * nb;
    ConvDesc d; d.src = W + (size_t)(k0 + (lane >> 3)) * N + n0 + 4 * (lane & 7); d.N = N; d.dst = WT + (size_t)(row_off + n0) * ldk + k0; d.ldk = ldk;
    d.gk = g ? g + k0 : nullptr; d.sk = sc ? sc + k0 : nullptr; return d;
}
__device__ __forceinline__ void conv_load(const ConvDesc& d, f32x4 (&v)[8]) {
#pragma unroll
    for (int i = 0; i < 8; ++i) v[i] = __builtin_nontemporal_load((const f32x4*)(d.src + (size_t)(8 * i) * d.N));
}
__device__ __forceinline__ void conv_finish(const ConvDesc& d, const f32x4 (&v)[8], LAS float* scr, int lane, const float* shk = nullptr, float* bacc = nullptr) {
#pragma unroll
    for (int i = 0; i < 8; ++i) { LAS float* p = scr + (8 * i + (lane >> 3)) * 33 + 4 * (lane & 7); p[0] = v[i].x; p[1] = v[i].y; p[2] = v[i].z; p[3] = v[i].w; }
    asm volatile("s_waitcnt lgkmcnt(0)" ::: "memory");
    const int c = lane & 7;
    float gm[8] = {1.f, 1.f, 1.f, 1.f, 1.f, 1.f, 1.f, 1.f};
    if (d.gk) { const f32x4 g0 = *(const f32x4*)(d.gk + 8 * c), g1 = *(const f32x4*)(d.gk + 8 * c + 4); f32x4 s0 = {0.f, 0.f, 0.f, 0.f}, s1 = {0.f, 0.f, 0.f, 0.f};
        if (d.sk) { s0 = *(const f32x4*)(d.sk + 8 * c); s1 = *(const f32x4*)(d.sk + 8 * c + 4); }
#pragma unroll
        for (int e = 0; e < 4; ++e) { gm[e] = g0[e] * (1.f + s0[e]); gm[4 + e] = g1[e] * (1.f + s1[e]); } }
    float sh8[8] = {0.f, 0.f, 0.f, 0.f, 0.f, 0.f, 0.f, 0.f};
    if (bacc) { const f32x4 h0 = *(const f32x4*)(shk + 8 * c), h1 = *(const f32x4*)(shk + 8 * c + 4);
#pragma unroll
        for (int e = 0; e < 4; ++e) { sh8[e] = h0[e]; sh8[4 + e] = h1[e]; } }
#pragma unroll
    for (int j = 0; j < 4; ++j) { const int n = (lane >> 3) + 8 * j; const LAS float* sp = scr + (8 * c) * 33 + n;
        if (bacc) bacc[j] += ((sp[0 * 33] * sh8[0] + sp[1 * 33] * sh8[1]) + (sp[2 * 33] * sh8[2] + sp[3 * 33] * sh8[3])) + ((sp[4 * 33] * sh8[4] + sp[5 * 33] * sh8[5]) + (sp[6 * 33] * sh8[6] + sp[7 * 33] * sh8[7]));
        u32x4 o; o.x = cvt_pk_bf16(sp[0 * 33] * gm[0], sp[1 * 33] * gm[1]); o.y = cvt_pk_bf16(sp[2 * 33] * gm[2], sp[3 * 33] * gm[3]); o.z = cvt_pk_bf16(sp[4 * 33] * gm[4], sp[5 * 33] * gm[5]); o.w = cvt_pk_bf16(sp[6 * 33] * gm[6], sp[7 * 33] * gm[7]);
        *(u32x4*)(d.dst + (size_t)n * d.ldk + 8 * c) = o; }
    asm volatile("s_waitcnt lgkmcnt(0)" ::: "memory");
}

__device__ __forceinline__ void ada_item(const Args& a, unsigned char* ws, LAS unsigned char* lds, int l, int cb, int tid) {
    const int lane = tid & 63, wave = tid >> 6;
    LAS float* red = (LAS float*)lds;
    const float* cvec = a.in[I_C];
    float* modf = (float*)(ws + WS_MODF);
    const float* W = a.in[I_WADA] + (size_t)l * DM * (NMOD * DM) + cb * 256 + 4 * lane;
    f32x4 acc = {0.f, 0.f, 0.f, 0.f};
    const int kbeg = wave * 256;
#pragma unroll 32
    for (int k = 0; k < 256; ++k) { const f32x4 w = __builtin_nontemporal_load((const f32x4*)(W + (size_t)(kbeg + k) * (NMOD * DM))); const float cv = cvec[kbeg + k]; acc += w * cv; }
    *(LAS f32x4*)(red + wave * 256 + 4 * lane) = acc;
    __syncthreads();
    if (tid < 256) { float s = 0.f;
#pragma unroll
        for (int w = 0; w < 8; ++w) s += red[w * 256 + tid];
        const int j = cb * 256 + tid; modf[l * (NMOD * DM) + j] = s + a.in[I_BADA][l * (NMOD * DM) + j]; }
    asm volatile("s_waitcnt vmcnt(0)" ::: "memory");
    __syncthreads();
    if (tid == 0) { __builtin_amdgcn_fence(__ATOMIC_RELEASE, "agent"); (void)__hip_atomic_fetch_add((unsigned*)(ws + WS_CTL) + CW_ADA + 64 * l, 1u, __ATOMIC_RELAXED, __HIP_MEMORY_SCOPE_AGENT); }
}
__device__ __forceinline__ void wait_ada(unsigned char* ws, int l, int tid) {
    if (tid == 0) { unsigned* p = (unsigned*)(ws + WS_CTL) + CW_ADA + 64 * l;
        while (__hip_atomic_load(p, __ATOMIC_RELAXED, __HIP_MEMORY_SCOPE_AGENT) < 48u) __builtin_amdgcn_s_sleep(4);
        __builtin_amdgcn_fence(__ATOMIC_ACQUIRE, "agent"); }
    __syncthreads();
}
constexpr int CI_IN = (DM / 64) * (IN_COLS / 32), CI_Q = (512 / 64) * (1536 / 32), CI_KV = (256 / 64) * (2048 / 32), CI_BR1 = (1024 / 64) * (2048 / 32),
              CI_O = (DM / 64) * (DM / 32), CI_1 = (DM / 64) * (DFF / 32), CI_2 = (DFF / 64) * (DM / 32);
constexpr int CONV_PER_LAYER = CI_IN + CI_Q + CI_KV + 3 * CI_BR1 + CI_O + CI_1 + CI_2;
constexpr int CONV_CHUNK = 128, CONV_NCHUNK = (CONV_PER_LAYER + CONV_CHUNK - 1) / CONV_CHUNK;
constexpr int CONV_NDEP = CI_Q + CI_KV + 3 * CI_BR1 + CI_O + CI_2;
__device__ __forceinline__ ConvDesc conv_desc(const Args& a, unsigned char* ws, int l, int r, int lane) {
    unsigned char* wl = ws + WS_W + (size_t)l * W_LAYER;
    if (r < CI_Q) return conv_make(a.in[I_WQUP] + (size_t)l * 512 * 1536, 512, 1536, (bf16*)(wl + W_QUP), 0, r, lane, 512, a.in[I_MQG] + l * 512); r -= CI_Q;
    if (r < CI_KV) return conv_make(a.in[I_WKVUP] + (size_t)l * 256 * 2048, 256, 2048, (bf16*)(wl + W_KVUP), 0, r, lane, 256, a.in[I_MKVG] + l * 256); r -= CI_KV;
    if (r < 3 * CI_BR1) { const int n = r / CI_BR1; r -= n * CI_BR1;
        return conv_make(a.in[I_WBR] + ((size_t)l * 3 + n) * 1024 * 2048, 1024, 2048, (bf16*)(wl + W_BR) + (size_t)n * 1024, 0, r, lane, 3072); } r -= 3 * CI_BR1;
    if (r < CI_O) return conv_make(a.in[I_WOUT] + (size_t)l * DM * DM, DM, DM, (bf16*)(wl + W_OUT), 0, r, lane, DM); r -= CI_O;
    return conv_make(a.in[I_WM2] + (size_t)l * DFF * DM, DFF, DM, (bf16*)(wl + W_M2), 0, r, lane, DFF);
}
__device__ __forceinline__ void conv_item(const Args& a, unsigned char* ws, int l, int r, LAS float* scr, int lane) {
    const ConvDesc d = conv_desc(a, ws, l, r, lane); f32x4 v[8]; conv_load(d, v); conv_finish(d, v, scr, lane);
}
__device__ __forceinline__ void conv_pair(const Args& a, unsigned char* ws, int l, int r0, int r1, LAS float* scr, int lane) {
    const ConvDesc d0 = conv_desc(a, ws, l, r0, lane), d1 = conv_desc(a, ws, l, r1, lane); f32x4 v0[8], v1[8];
    conv_load(d0, v0); conv_load(d1, v1); conv_finish(d0, v0, scr, lane); conv_finish(d1, v1, scr, lane);
}
__device__ __forceinline__ void conv_quad(const Args& a, unsigned char* ws, int l, int r0, LAS float* scr, int lane) {
    const ConvDesc d0 = conv_desc(a, ws, l, r0, lane), d1 = conv_desc(a, ws, l, r0 + 1, lane), d2 = conv_desc(a, ws, l, r0 + 2, lane), d3 = conv_desc(a, ws, l, r0 + 3, lane);
    f32x4 v0[8], v1[8], v2[8], v3[8];
    conv_load(d0, v0); conv_load(d1, v1); conv_load(d2, v2); conv_load(d3, v3);
    conv_finish(d0, v0, scr, lane); conv_finish(d1, v1, scr, lane); conv_finish(d2, v2, scr, lane); conv_finish(d3, v3, scr, lane);
}
constexpr int CC_IN = IN_COLS / 32, CC_1 = DFF / 32, CONV_COLS = CC_IN + CC_1;
__device__ __forceinline__ void conv_col(const Args& a, unsigned char* ws, int l, int ci, LAS float* scr, int lane) {
    unsigned char* wl = ws + WS_W + (size_t)l * W_LAYER;
    const float* modl = (const float*)(ws + WS_MODF) + (size_t)l * (NMOD * DM);
    const bool first = ci < CC_IN; const int nb = first ? ci : ci - CC_IN, N = first ? IN_COLS : DFF, nblk = N / 32;
    const float* W = first ? a.in[I_WIN] + (size_t)l * DM * IN_COLS : a.in[I_WM1] + (size_t)l * DM * DFF;
    bf16* WT = (bf16*)(wl + (first ? W_IN : W_M1));
    const int roff = (first && 32 * nb >= SRC_PAD_AT) ? PADW : 0;
    const float* g = first ? a.in[I_GMIX] + l * DM : a.in[I_GMLP] + l * DM; const float* sc = modl + (first ? 1 : 4) * DM; const float* sh = modl + (first ? 0 : 3) * DM;
    float bacc[4] = {0.f, 0.f, 0.f, 0.f};
    for (int kb = 0; kb < DM / 64; kb += 4) {
        const ConvDesc d0 = conv_make(W, DM, N, WT, roff, kb * nblk + nb, lane, DM, g, sc), d1 = conv_make(W, DM, N, WT, roff, (kb + 1) * nblk + nb, lane, DM, g, sc);
        const ConvDesc d2 = conv_make(W, DM, N, WT, roff, (kb + 2) * nblk + nb, lane, DM, g, sc), d3 = conv_make(W, DM, N, WT, roff, (kb + 3) * nblk + nb, lane, DM, g, sc);
        f32x4 v0[8], v1[8], v2[8], v3[8];
        conv_load(d0, v0); conv_load(d1, v1); conv_load(d2, v2); conv_load(d3, v3);
        conv_finish(d0, v0, scr, lane, sh + 64 * kb, bacc); conv_finish(d1, v1, scr, lane, sh + 64 * (kb + 1), bacc); conv_finish(d2, v2, scr, lane, sh + 64 * (kb + 2), bacc); conv_finish(d3, v3, scr, lane, sh + 64 * (kb + 3), bacc);
    }
    float* bias = (float*)(ws + WS_CTL + WS_BIAS) + (size_t)l * BIAS_PER_LAYER + (first ? roff : PN) + 32 * nb;
#pragma unroll
    for (int j = 0; j < 4; ++j) { float b = bacc[j]; b += swz<1>(b); b += swz<2>(b); b += swz<4>(b); if ((lane & 7) == 0) bias[(lane >> 3) + 8 * j] = b; }
}
constexpr int PREP_CHUNK = 64, PREP_NCHUNK = (CONV_NDEP + PREP_CHUNK - 1) / PREP_CHUNK, PREP_NCOL = (CONV_COLS + NWAVES - 1) / NWAVES, PREP_ITEMS = 48 + PREP_NCHUNK + PREP_NCOL, PREP_LEAD = 100, PREP_TAIL = 64;
static_assert(PREP_LEAD <= PREP_NCHUNK, "prep order");
__device__ __forceinline__ void prep_item(const Args& a, unsigned char* ws, LAS unsigned char* lds, int l, int idx, int tid) {
    if (idx < 48) { ada_item(a, ws, lds, l, idx, tid); return; }
    int ch = idx - 48; const int lane = tid & 63, wave = tid >> 6; LAS float* scr = (LAS float*)(lds + wave * 16384);
    if (ch >= PREP_LEAD && ch < PREP_LEAD + PREP_NCOL) { wait_ada(ws, l, tid); const int ci = (ch - PREP_LEAD) * NWAVES + wave; if (ci < CONV_COLS) conv_col(a, ws, l, ci, scr, lane); __syncthreads(); return; }
    if (ch >= PREP_LEAD + PREP_NCOL) ch -= PREP_NCOL;
    const int beg = ch * PREP_CHUNK, end = (beg + PREP_CHUNK < CONV_NDEP) ? beg + PREP_CHUNK : CONV_NDEP;
    for (int r = beg + 4 * wave; r < end; r += 4 * NWAVES) { if (r + 3 < end) conv_quad(a, ws, l, r, scr, lane); else for (int q = r; q < end && q < r + 4; ++q) conv_item(a, ws, l, q, scr, lane); }
    __syncthreads();
}

__device__ __forceinline__ void prologue(const Args& a, LAS unsigned char* lds, int G, const int wv) {
    int tid = MYTID(wv); asm volatile("" : "+v"(tid));
    const int lane = tid & 63, wave = tid >> 6;
    GAS unsigned char* wsg_ = (GAS unsigned char*)a.ws; asm volatile("" : "+s"(wsg_)); unsigned char* ws = (unsigned char*)wsg_;
    for (int it = blockIdx.x; it < 48; it += G) ada_item(a, ws, lds, 0, it, tid);
    {
        float* rc = (float*)(ws + WS_ROPE); float* rs = rc + S * 32;
        for (int e = blockIdx.x * NTHR + tid; e < S * 32; e += G * NTHR) {
            const int pos = e >> 5, i = e & 31;
            const float inv = exp2f(-(float)i * (13.287712379549449f / 32.0f));
            const float ang = (float)pos * inv;
            const double rev = (double)ang * 0.15915494309189535; const float fr = (float)(rev - rint(rev));
            rc[e] = __builtin_amdgcn_cosf(fr); rs[e] = __builtin_amdgcn_sinf(fr);
        }
    }
    {
        const float* x = a.in[I_X]; bf16* XB = (bf16*)(ws + WS_ACT + A_XB); float* RQ = (float*)(ws + WS_ACT + A_RSQA);
        for (int row = blockIdx.x * NWAVES + wave; row < S; row += G * NWAVES) {
            const f32x4* xr = (const f32x4*)(x + (size_t)row * DM) + lane; f32x4 v[8]; float sq = 0.f;
#pragma unroll
            for (int j = 0; j < 8; ++j) v[j] = xr[64 * j];
            u32x2* o8 = (u32x2*)(XB + (size_t)row * DM) + lane;
#pragma unroll
            for (int j = 0; j < 8; ++j) { sq += (v[j].x * v[j].x + v[j].y * v[j].y) + (v[j].z * v[j].z + v[j].w * v[j].w);
                u32x2 w; w.x = cvt_pk_bf16(v[j].x, v[j].y); w.y = cvt_pk_bf16(v[j].z, v[j].w); o8[64 * j] = w; }
            sq = wave_sum(sq);
            if (lane < 8) RQ[(size_t)row * 8 + lane] = (lane == 0) ? sq : 0.f;
        }
    }
    {
        LAS float* scr = (LAS float*)(lds + wave * 16384);
        const int NA = 48, X = (G > NA) ? (G - NA) * NWAVES * 2 : 0;
        if ((int)blockIdx.x >= NA) for (int it = ((int)blockIdx.x - NA) * NWAVES + wave; it < X; it += (G - NA) * NWAVES) conv_item(a, ws, 0, it, scr, lane);
        for (int it = X + (int)blockIdx.x * NWAVES + wave; it < CONV_NDEP; it += G * NWAVES) conv_item(a, ws, 0, it, scr, lane);
        __syncthreads();
        wait_ada(ws, 0, tid);
        for (int ci = (int)blockIdx.x + G * wave; ci < CONV_COLS; ci += G * NWAVES) conv_col(a, ws, 0, ci, scr, lane);
    }
}

__device__ __forceinline__ void ld16f(const bf16* p, float* x) {
    const u32x4 a = *(const u32x4*)p, b = *(const u32x4*)(p + 8);
    x[0] = bf_lo(a.x); x[1] = bf_hi(a.x); x[2] = bf_lo(a.y); x[3] = bf_hi(a.y); x[4] = bf_lo(a.z); x[5] = bf_hi(a.z); x[6] = bf_lo(a.w); x[7] = bf_hi(a.w);
    x[8] = bf_lo(b.x); x[9] = bf_hi(b.x); x[10] = bf_lo(b.y); x[11] = bf_hi(b.y); x[12] = bf_lo(b.z); x[13] = bf_hi(b.z); x[14] = bf_lo(b.w); x[15] = bf_hi(b.w);
}
__device__ __forceinline__ void st16f(bf16* p, const float* x) {
    u32x4 a, b; a.x = cvt_pk_bf16(x[0], x[1]); a.y = cvt_pk_bf16(x[2], x[3]); a.z = cvt_pk_bf16(x[4], x[5]); a.w = cvt_pk_bf16(x[6], x[7]);
    b.x = cvt_pk_bf16(x[8], x[9]); b.y = cvt_pk_bf16(x[10], x[11]); b.z = cvt_pk_bf16(x[12], x[13]); b.w = cvt_pk_bf16(x[14], x[15]);
    *(u32x4*)p = a; *(u32x4*)(p + 8) = b;
}
__device__ __forceinline__ void ld8f(const bf16* p, float* x) {
    const u32x4 a = *(const u32x4*)p;
    x[0] = bf_lo(a.x); x[1] = bf_hi(a.x); x[2] = bf_lo(a.y); x[3] = bf_hi(a.y); x[4] = bf_lo(a.z); x[5] = bf_hi(a.z); x[6] = bf_lo(a.w); x[7] = bf_hi(a.w);
}
__device__ __forceinline__ void st8f(bf16* p, const float* x) {
    u32x4 a; a.x = cvt_pk_bf16(x[0], x[1]); a.y = cvt_pk_bf16(x[2], x[3]); a.z = cvt_pk_bf16(x[4], x[5]); a.w = cvt_pk_bf16(x[6], x[7]); *(u32x4*)p = a;
}

__device__ __forceinline__ void post1_phase(const Args& a, int l, int G, const int wv) {
    int tid = MYTID(wv); asm volatile("" : "+v"(tid));
    const int lane = tid & 63, wave = tid >> 6;
    GAS unsigned char* wsg_ = (GAS unsigned char*)a.ws; asm volatile("" : "+s"(wsg_)); unsigned char* ws = (unsigned char*)wsg_;
    const bf16* proj = (const bf16*)(ws + WS_ACT + A_PROJ);
    bf16* QA = (bf16*)(ws + WS_ACT + A_QA); bf16* KA = (bf16*)(ws + WS_ACT + A_KA); bf16* KPE = (bf16*)(ws + WS_ACT + A_KPE);
    const float* rc = (const float*)(ws + WS_ROPE); const float* rs = rc + S * 32;
    const float* gq = a.in[I_DQKG] + l * 128; const float* gk = gq + 64;
    const float* gkpe = a.in[I_MQKG] + l * 384 + 192 + 128;
    float gqv[16], gkv[16];
#pragma unroll
    for (int e = 0; e < 16; ++e) { gqv[e] = gq[16 * (lane & 3) + e] * SC_DA; gkv[e] = gk[16 * (lane & 3) + e]; }
    const float gpe = gkpe[lane];
    int rbeg = (int)blockIdx.x * NWAVES + wave, rend = S, rstep = G * NWAVES;
    if (G == 256) { const int b_ = (int)blockIdx.x; const int r0_ = b_ < 192 ? 26 * b_ : 4992 + 50 * (b_ - 192), nr_ = b_ < 192 ? 26 : 50; rbeg = r0_ + wave; rend = r0_ + nr_; rstep = NWAVES; }
    for (int row = rbeg; row < rend; row += rstep) {
        const bf16* P = proj + (size_t)row * PN;
        float x[16];
        { ld16f(P + C_DAQ + 16 * lane, x); float s = 0.f;
#pragma unroll
          for (int e = 0; e < 16; ++e) s += x[e] * x[e];
          s += swz<1>(s); s += swz<2>(s); const float r = rsq(s * (1.f / 64.f) + EPS);
#pragma unroll
          for (int e = 0; e < 16; ++e) x[e] = x[e] * r * gqv[e];
          st16f(QA + (size_t)row * 1024 + 16 * lane, x); }
        { ld16f(P + C_DAK + 16 * lane, x); float s = 0.f;
#pragma unroll
          for (int e = 0; e < 16; ++e) s += x[e] * x[e];
          s += swz<1>(s); s += swz<2>(s); const float r = rsq(s * (1.f / 64.f) + EPS);
#pragma unroll
          for (int e = 0; e < 16; ++e) x[e] = x[e] * r * gkv[e];
          st16f(KA + (size_t)row * 1024 + 16 * lane, x); }
        { const float v = bf1(P[C_KPE + lane]); const float r = rsq(wave_sum(v * v) * (1.f / 64.f) + EPS);
          const float y = v * r * gpe; float yp; { auto rr = __builtin_amdgcn_permlane32_swap(__float_as_uint(y), __float_as_uint(y), false, false); yp = __uint_as_float(lane < 32 ? rr[1] : rr[0]); }
          const int i = lane & 31; const float c = rc[row * 32 + i], sn = rs[row * 32 + i];
          const float o = (lane < 32) ? (y * c - yp * sn) : (yp * sn + y * c);
          KPE[(size_t)row * 64 + lane] = (bf16)(cvt_pk_bf16(o, o) & 0xffffu); }
    }
}


#ifndef ATT_MASK
#define ATT_MASK 7
#endif
__device__ __forceinline__ void attn_phase(const Args& a, int l, int layer, LAS unsigned char* ldsl, volatile LAS unsigned* MISC, const int wv) {
    GAS unsigned char* wsg_ = (GAS unsigned char*)a.ws; asm volatile("" : "+s"(wsg_)); unsigned char* ws = (unsigned char*)wsg_;
    LAS char* lds = (LAS char*)ldsl;
    const bf16* proj = (const bf16*)(ws + WS_ACT + A_PROJ);
    const bf16* QA = (const bf16*)(ws + WS_ACT + A_QA); const bf16* KA = (const bf16*)(ws + WS_ACT + A_KA); const bf16* KPE = (const bf16*)(ws + WS_ACT + A_KPE);
    const bf16* KVRAW = (const bf16*)(ws + WS_ACT + A_KVRAW); const bf16* QRAW = (const bf16*)(ws + WS_ACT + A_QRAW); const bf16* KNOPE = (const bf16*)(ws + WS_ACT + A_KNOPE);
    float* OD = (float*)(ws + WS_ACT + A_OD); bf16* YA = (bf16*)(ws + WS_ACT + A_YA); bf16* YB = YA + 1024; bf16* YC = YA + 2048;
    unsigned* qhead = (unsigned*)(ws + WS_CTL) + CW_QUEUE + 28 * 64 * l;
    const int xcd = (int)(xb_xcc_id() & 7u);
#define CLAIMP(qp) ({ if (MYTID(wv) == 0) MISC[16] = __hip_atomic_fetch_add((qp), 1u, RLX_AGENT); __syncthreads(); const int v_ = (int)MISC[16]; __syncthreads(); v_; })
#define CLAIMX(t_, N_, qsel) ({ \
        if (wv == 0) { const int ln_ = lane_id(); int res_ = -1, qx_ = 0; \
            for (;;) { const unsigned hv_ = (ln_ < 8) ? __hip_atomic_load(qhead + 64 * ((t_) * 8 + ((xcd + ln_) & 7)), RLX_AGENT) : 0xffffffffu; \
                const unsigned long long mk_ = __ballot(hv_ < (unsigned)(N_)); if (mk_ == 0ull) break; \
                const int i_ = __builtin_ctzll(mk_); qx_ = (xcd + i_) & 7; unsigned tk_ = 0u; \
                if (ln_ == 0) tk_ = __hip_atomic_fetch_add(qhead + 64 * ((t_) * 8 + qx_), 1u, RLX_AGENT); \
                tk_ = (unsigned)__builtin_amdgcn_readfirstlane((int)tk_); if (tk_ < (unsigned)(N_)) { res_ = (int)tk_; break; } } \
            if (ln_ == 0) { MISC[16] = (unsigned)res_; MISC[17] = (unsigned)qx_; } } \
        __syncthreads(); const int v_ = (int)MISC[16]; qsel = (int)MISC[17]; __syncthreads(); v_; })
#define CLAIM(qi) CLAIMP(qhead + 64 * (24 + (qi) - 3))
    bool prep_left = (layer + 1 < DEPTH);
#define PREP_ONE() do { if (prep_left) { const int pi_ = CLAIM(4); if (pi_ < PREP_ITEMS - PREP_TAIL) prep_item(a, ws, ldsl, layer + 1, pi_, MYTID(wv)); else prep_left = false; } } while (0)
    if (ATT_MASK & 1) { for (;;) { int h;
        const int ui = CLAIMX(0, 32, h); if (ui < 0) break;
        const int qb = 31 - ui, q0 = qb * 256;
        att::KVSrc kv{KNOPE + h * 128, 1024, KPE, 64, KVRAW + h * 256 + 128, 2048};
        const att::QPrep qp{a.in[I_MQKG] + layer * 384, (const float*)(ws + WS_ROPE), (const float*)(ws + WS_ROPE) + S * 32};
        bool nomax;
        { const float* g0_ = a.in[I_MQKG] + layer * 384; const float* g1_ = g0_ + 192; const int ln2_ = lane_id();
          const float q_n = wave_max(fmaxf(fabsf(g0_[ln2_]), fabsf(g0_[64 + ln2_]))), q_p = wave_max(fabsf(g0_[128 + ln2_]));
          const float k_n = wave_max(fmaxf(fabsf(g1_[ln2_]), fabsf(g1_[64 + ln2_]))), k_p = wave_max(fabsf(g1_[128 + ln2_]));
          const float bnd = 1.02f * SC_MLA * sqrtf(128.f * q_n * q_n + 64.f * q_p * q_p) * sqrtf(128.f * k_n * k_n + 64.f * k_p * k_p);
          nomax = __builtin_amdgcn_readfirstlane((int)(bnd <= SMAX_BOUND)) != 0; }
        if (nomax) att::softmax_unit_v3<192, 128, false, false, false, false, true, true>(lds, QRAW + (size_t)q0 * 1536 + h * 192, 1536, kv, q0, nullptr, YB + (size_t)q0 * 3072 + h * 128, 3072, wv, att::DaFin{}, qp);
        else att::softmax_unit_v3<192, 128, false, false, false, false, false, true>(lds, QRAW + (size_t)q0 * 1536 + h * 192, 1536, kv, q0, nullptr, YB + (size_t)q0 * 3072 + h * 128, 3072, wv, att::DaFin{}, qp);
        PREP_ONE();
      } }
    int npass = 2; asm volatile("" : "+s"(npass));
    for (int pass = 0; pass < npass; ++pass) {
    if (ATT_MASK & 2) { for (;;) { int h, hc, qb;
        if (pass == 0) { const int ui = CLAIMX(1, 56, h); if (ui < 0) break; hc = 2 * h + (ui & 1); qb = 31 - (ui >> 1); }
        else { const int u_ = CLAIM(6); if (u_ >= 64) break; hc = u_ & 15; qb = 3 - (u_ >> 4); h = hc >> 1; }
        const int q0 = qb * 256;
        { const int tid = MYTID(wv); if (tid < 256) { const int rel = 64 - tid, n = rel < 0 ? -rel : rel;
            int large = 8 + (int)(logf((float)(n < 1 ? 1 : n) / 8.0f) / 2.772588722239781f * 8.0f); large = large < 15 ? large : 15;
            const int bucket = (rel > 0 ? 16 : 0) + (n < 8 ? n : large);
            ((LAS float*)(lds + att::L_BIAS))[tid] = (a.in[I_T5][bucket * 8 + h] - a.in[I_T5][15 * 8 + h]) * LOG2E; } }
        __syncthreads();
        att::KVSrc kv{KA + hc * 64, 1024, KA, 1024, proj + C_DAV + h * 128, PN};
        const float* lp = a.in[I_DLAM] + layer * 256; const int ln_ = lane_id();
        const float lam_init = 0.8f - 0.6f * expf(-0.3f * (float)layer);
        float lam = expf(wave_sum(lp[ln_] * lp[64 + ln_])) - expf(wave_sum(lp[128 + ln_] * lp[192 + ln_])) + lam_init;
        lam = __int_as_float(__builtin_amdgcn_readfirstlane(__float_as_int(lam))); const float omli = __int_as_float(__builtin_amdgcn_readfirstlane(__float_as_int(1.f - lam_init)));
        att::DaFin fin{OD + (size_t)(((hc ^ 1) * 32 + qb) * 8) * 4096, (unsigned*)(ws + WS_CTL) + CW_DAC + (l * 8 + h) * 32 + qb, lam, a.in[I_DSUB] + layer * 128, omli, (hc & 1) == 0};
        bool nomax;
        { const float* gq_ = a.in[I_DQKG] + layer * 128; const float gqm = wave_max(fabsf(gq_[ln_])), gkm = wave_max(fabsf(gq_[64 + ln_]));
          const float tm = wave_max(ln_ < 32 ? fabsf(a.in[I_T5][ln_ * 8 + h]) : 0.f);
          const float bnd = 1.02f * SC_DA * 64.f * gqm * gkm + 2.f * LOG2E * tm;
          nomax = __builtin_amdgcn_readfirstlane((int)(bnd <= SMAX_BOUND)) != 0; }
        if (nomax) att::softmax_unit_v3<64, 64, true, true, true, false, true>(lds, QA + (size_t)q0 * 1024 + hc * 64, 1024, kv, q0, OD + (size_t)((hc * 32 + qb) * 8) * 4096, YA + (size_t)q0 * 3072 + h * 128, 3072, wv, fin);
        else att::softmax_unit_v3<64, 64, true, true, true, false>(lds, QA + (size_t)q0 * 1024 + hc * 64, 1024, kv, q0, OD + (size_t)((hc * 32 + qb) * 8) * 4096, YA + (size_t)q0 * 3072 + h * 128, 3072, wv, fin);
        PREP_ONE();
      } }
    if (pass == 0) {
    if (ATT_MASK & 4) { for (;;) { int h;
        const int ui = CLAIMX(2, 32, h); if (ui < 0) break;
        const int qb = 31 - ui, q0 = qb * 256;
        att::KVSrc kv{proj + C_SBK + h * 128, PN, proj, PN, proj + C_SBV + h * 128, PN};
        att::sb_unit(lds, proj + (size_t)q0 * PN + C_SBQ + h * 128, PN, kv, q0, YC + (size_t)q0 * 3072 + h * 128, 3072, wv);
      } }
    {
        __syncthreads();
        const bf16* Hh = (const bf16*)(ws + WS_ACT + A_XB); const bf16* Wi = (const bf16*)(ws + WS_W + (size_t)layer * W_LAYER + W_IN); bf16* PJ = (bf16*)(ws + WS_ACT + A_PROJ);
        const float* RQ = (const float*)(ws + WS_ACT + A_RSQA); const float* B1 = (const float*)(ws + WS_CTL + WS_BIAS) + (size_t)layer * BIAS_PER_LAYER;
        constexpr int NFILL = (PN / 256 - GIN_TILES) * (S / 256);
        for (;;) { const int ui = CLAIM(3); if (ui >= NFILL) break;
            pg8::Gemm g{Hh, Wi, S, PN, DM, DM}; pg8::OneUnit So; So.u0.pm = ui & 31; So.u0.pn = GIN_TILES + (ui >> 5);
            pg8::EpiBf16N<3> E{PJ, PN, C_GATE / 256, RQ, B1, 1.f / DM, nullptr, nullptr}; pg8::gemm_phase(ldsl, g, So, E, wv); }
    }
    while (prep_left) PREP_ONE();
    } }
    if (layer + 1 < DEPTH) for (;;) { const int pi_ = CLAIM(5); if (pi_ >= PREP_TAIL) break; prep_item(a, ws, ldsl, layer + 1, PREP_ITEMS - PREP_TAIL + pi_, MYTID(wv)); }
    __syncthreads();
#undef PREP_ONE
#undef CLAIM
#undef CLAIMP
#undef CLAIMX
}

__global__ void __launch_bounds__(NTHR, 2) mk_fwd(Args args) {
    extern __shared__ __attribute__((aligned(16))) unsigned char lds_raw[];
    LAS unsigned char* lds = (LAS unsigned char*)lds_raw;
    volatile LAS unsigned* MISC = (volatile LAS unsigned*)(lds + MISC_OFF);
    const int wv = __builtin_amdgcn_readfirstlane((int)threadIdx.x >> 6);
    const int tid = MYTID(wv), G = gridDim.x;
    unsigned char* ws = args.ws;
    for (int u = tid; u < (LDS_BYTES - LDSCTL_OFF) / 4; u += NTHR) ((LAS unsigned*)(lds + LDSCTL_OFF))[u] = 0u;
    __syncthreads();
    XcdBarrier bar; bar.bar = (unsigned*)(ws + WS_CTL) + CW_BAR; bar.x = 0; bar.st = nullptr;
    if (!MK_SPLIT) bar = xcd_barrier_post((unsigned*)(ws + WS_CTL) + CW_BAR, MISC + 8, wv);
    const int lo = args.ph_lo, hi = args.ph_hi;
#ifndef PH_MASK
#define PH_MASK 0x1FFF
#endif
#if MK_SPLIT
#define IN(k) (lo <= (k) && (k) < hi)
#else
#define IN(k) true
#endif
#define INL(c) (((PH_MASK >> (1 + (c))) & 1) && IN(pb + (c)))
#define SEAM(k) do { if (IN((k) + 1)) xcd_barrier(bar, wv); } while (0)
#if DUP_MASK
#define REP(c) for (int rep_ = ((args.dup >> (c)) & 1); rep_ >= 0; --rep_)
#else
#define REP(c) for (int rep_ = 0; rep_ >= 0; --rep_)
#endif
#define RSEAM() do { if (rep_ > 0) xcd_barrier(bar, wv); } while (0)

    if ((PH_MASK & 1) && IN(0)) { REP(12) { prologue(args, lds, G, wv); RSEAM(); } SEAM(0); }

    for (int l = 0; l < DEPTH; ++l) {
        const int pb = 1 + l * PH_PER_LAYER;
        LAS float* PART = (LAS float*)(lds + RS_OFF);
        {
        GAS unsigned char* wsg_ = (GAS unsigned char*)args.ws; asm volatile("" : "+s"(wsg_)); unsigned char* ws = (unsigned char*)wsg_;
        bf16* PROJ = (bf16*)(ws + WS_ACT + A_PROJ); bf16* XB = (bf16*)(ws + WS_ACT + A_XB);
        float* RQA = (float*)(ws + WS_ACT + A_RSQA); float* RQCQ = (float*)(ws + WS_ACT + A_RSQCQ); float* RQCKV = (float*)(ws + WS_ACT + A_RSQCKV); const float* BIAS = (const float*)(ws + WS_CTL + WS_BIAS) + (size_t)l * BIAS_PER_LAYER;
        bf16* QRAW = (bf16*)(ws + WS_ACT + A_QRAW); bf16* KVRAW = (bf16*)(ws + WS_ACT + A_KVRAW);
        unsigned char* wl = ws + WS_W + (size_t)l * W_LAYER;
        if (INL(1)) { pg8::Gemm g{XB, (const bf16*)(wl + W_IN), S, GIN_TILES * 256, DM, DM}; pg8::StaticOrder So; So.init(S, GIN_TILES * 256, G, (int)blockIdx.x);
            pg8::EpiBf16N<3, true> E{PROJ, PN, C_GATE / 256, RQA, BIAS, 1.f / DM, RQCQ, RQCKV}; REP(1) { pg8::gemm_phase(lds, g, So, E, wv); RSEAM(); } SEAM(pb + 1); }
        if (INL(2)) { REP(2) {
            const float* ZERO = (const float*)(ws + WS_CTL + WS_ZERO);
            if ((blockIdx.x & 1) == 0) post1_phase(args, l, G, wv);
            { pg8::Gemm g{PROJ + C_CQ, (const bf16*)(wl + W_QUP), S, 1536, 512, PN}; pg8::StaticOrder So; So.init(S, 1536, G, (int)blockIdx.x);
              pg8::EpiBf16N<0> E{QRAW, 1536, 0, RQCQ, ZERO, 1.f / 512.f, nullptr, nullptr}; pg8::gemm_phase(lds, g, So, E, wv); }
            { pg8::Gemm g{PROJ + C_CKV, (const bf16*)(wl + W_KVUP), S, 2048, 256, PN}; pg8::StaticOrder So; So.init(S, 2048, G, (int)blockIdx.x);
              pg8::EpiKvUp E{(bf16*)(ws + WS_ACT + A_KNOPE), args.in[I_MQKG] + l * 384 + 192, RQCKV}; pg8::gemm_phase(lds, g, So, E, wv); }
            if ((blockIdx.x & 1) != 0) post1_phase(args, l, G, wv);
            RSEAM(); } SEAM(pb + 3); }
        if (INL(5)) { REP(5) { attn_phase(args, 2 * l + rep_, l, lds, MISC, wv); RSEAM(); } SEAM(pb + 5); }
        }
        {
        GAS unsigned char* wsg_ = (GAS unsigned char*)args.ws; asm volatile("" : "+s"(wsg_)); unsigned char* ws = (unsigned char*)wsg_;
        bf16* PROJ = (bf16*)(ws + WS_ACT + A_PROJ); bf16* XB = (bf16*)(ws + WS_ACT + A_XB); bf16* XB2 = (bf16*)(ws + WS_ACT + A_XB2);
        float* RQA = (float*)(ws + WS_ACT + A_RSQA); float* RQB = (float*)(ws + WS_ACT + A_RSQB); const float* BIAS = (const float*)(ws + WS_CTL + WS_BIAS) + (size_t)l * BIAS_PER_LAYER;
        bf16* YA = (bf16*)(ws + WS_ACT + A_YA); float* MF = (float*)(ws + WS_ACT + A_MF); bf16* MG = (bf16*)(ws + WS_ACT + A_MG); bf16* U = (bf16*)(ws + WS_ACT + A_U);
        const float* modl = (const float*)(ws + WS_MODF) + l * (NMOD * DM);
        unsigned char* wl = ws + WS_W + (size_t)l * W_LAYER;
        if (INL(7)) { REP(7) {
            pg8::Gemm g{YA, (const bf16*)(wl + W_BR), S, DM, 3072, 3072}; pg8::StaticOrder So; So.init(S, DM, G, (int)blockIdx.x);
            pg8::EpiBranchRatio E{PROJ + C_GATE, PN, MG}; pg8::gemm_phase(lds, g, So, E, wv);
            RSEAM(); } SEAM(pb + 7); }
        if (INL(8)) { pg8::Gemm g{MG, (const bf16*)(wl + W_OUT), S, DM, DM, DM}; pg8::StaticOrder So; So.init(S, DM, G, (int)blockIdx.x);
            REP(8) { if (l == 0) { pg8::EpiResid<false, true> E{args.in[I_X], rep_ ? (void*)MF : (void*)XB2, modl + 2 * DM, RQB, PART}; pg8::gemm_phase(lds, g, So, E, wv); }
                     else { pg8::EpiResid<true, true> E{XB, rep_ ? (void*)MF : (void*)XB2, modl + 2 * DM, RQB, PART}; pg8::gemm_phase(lds, g, So, E, wv); } RSEAM(); } SEAM(pb + 8); }
        if (INL(10)) { pg8::Gemm g{XB2, (const bf16*)(wl + W_M1), S, DFF, DM, DM}; pg8::StaticOrder So; So.init(S, DFF, G, (int)blockIdx.x);
            pg8::EpiBf16N<2> E{U, DFF, 0, RQB, BIAS + PN, 1.f / DM, nullptr, nullptr}; REP(10) { pg8::gemm_phase(lds, g, So, E, wv); RSEAM(); } SEAM(pb + 10); }
        if (INL(11)) { pg8::Gemm g{U, (const bf16*)(wl + W_M2), S, DM, DFF, DFF}; pg8::StaticOrder So; So.init(S, DM, G, (int)blockIdx.x);
            REP(11) { if (l == DEPTH - 1) { pg8::EpiResid<true, false> E{XB2, rep_ ? (void*)MF : (void*)args.out, modl + 5 * DM, nullptr, PART}; pg8::gemm_phase(lds, g, So, E, wv); }
                      else { pg8::EpiResid<true, true> E{XB2, rep_ ? (void*)MF : (void*)XB, modl + 5 * DM, RQA, PART}; pg8::gemm_phase(lds, g, So, E, wv); } RSEAM(); } SEAM(pb + 11); }
        }
    }
#undef IN
#undef INL
#undef SEAM
#undef REP
#undef RSEAM
}

extern "C" void kernel_launch(void* const* d_in, const int* in_sizes, int n_in, void* d_out, int out_size, void* d_ws, size_t ws_size, hipStream_t stream) {
    static int grid = 0;
    if (grid == 0) {
        if (n_in != 20 || in_sizes[0] != S * DM || out_size != S * DM || ws_size < WS_END) {
            fprintf(stderr, "kernel_launch: shape mismatch: n_in %d in0 %d out %d ws %zu (need %zu)\n", n_in, n_in > 0 ? in_sizes[0] : -1, out_size, ws_size, (size_t)WS_END); grid = -1; return; }
        int dev = 0, cus = 0, per_cu = 0;
        if (hipGetDevice(&dev) != hipSuccess || hipDeviceGetAttribute(&cus, hipDeviceAttributeMultiprocessorCount, dev) != hipSuccess) { grid = -1; return; }
        if (hipFuncSetAttribute((const void*)mk_fwd, hipFuncAttributeMaxDynamicSharedMemorySize, LDS_BYTES) != hipSuccess) { fprintf(stderr, "kernel_launch: hipFuncSetAttribute failed\n"); grid = -1; return; }
        if (hipOccupancyMaxActiveBlocksPerMultiprocessor(&per_cu, (const void*)mk_fwd, NTHR, LDS_BYTES) != hipSuccess || per_cu < 1)
            fprintf(stderr, "kernel_launch: note: occupancy query reports %d workgroups per CU\n", per_cu);
        (void)hipGetLastError();
        grid = cus;
    }
    if (grid < 0) return;
    if (hipMemsetAsync((char*)d_ws + WS_CTL, 0, CTL_ZERO_BYTES, stream) != hipSuccess) { fprintf(stderr, "kernel_launch: memset failed\n"); return; }
    Args a{};
    for (int i = 0; i < 20; ++i) a.in[i] = (const float*)d_in[i];
    a.out = (float*)d_out; a.ws = (unsigned char*)d_ws; a.dup = DUP_MASK;
#if MK_SPLIT
    for (int p = 0; p < NPHASE; ++p) { a.ph_lo = p; a.ph_hi = p + 1; hipLaunchKernelGGL(mk_fwd, dim3(grid), dim3(NTHR), LDS_BYTES, stream, a); }
#else
    a.ph_lo = 0; a.ph_hi = NPHASE;
    hipLaunchKernelGGL(mk_fwd, dim3(grid), dim3(NTHR), LDS_BYTES, stream, a);
#endif
    const hipError_t le = hipPeekAtLastError();
    if (le != hipSuccess) fprintf(stderr, "kernel_launch: launch failed: %s\n", hipGetErrorName(le));
}
```

```cpp
#include <hip/hip_runtime.h>
#include <cstdio>
#include <cstdint>

#ifndef DUP_MASK
#define DUP_MASK 0
#endif
#ifndef MK_SPLIT
#define MK_SPLIT 0
#endif

#define GAS __attribute__((address_space(1)))
#define LAS __attribute__((address_space(3)))
typedef unsigned short bf16;
typedef short bf16x8 __attribute__((ext_vector_type(8)));
typedef short s16x4 __attribute__((ext_vector_type(4)));
typedef float f32x4 __attribute__((ext_vector_type(4)));
typedef float f32x2 __attribute__((ext_vector_type(2)));
typedef float f32x16 __attribute__((ext_vector_type(16)));
typedef unsigned u32x4 __attribute__((ext_vector_type(4)));
typedef unsigned u32x2 __attribute__((ext_vector_type(2)));

constexpr int S = 8192, DM = 2048, DEPTH = 4, DFF = 8192, NMOD = 6;
constexpr int IN_COLS = 13120, PN = 13312;
constexpr int C_DAQ = 0, C_DAK = 1024, C_DAV = 2048, C_CQ = 3072, C_CKV = 3584, C_KPE = 3840, C_SBQ = 4096, C_SBK = 5120, C_SBV = 6144, C_GATE = 7168;
constexpr int SRC_PAD_AT = 3904, PADW = 192;
constexpr float EPS = 1e-6f;
constexpr float LOG2E = 1.4426950408889634f;
constexpr float SC_DA = 0.125f * LOG2E;
constexpr float SC_MLA = 0.07216878364870323f * LOG2E;
constexpr float SC_SB = 0.08838834764831845f * LOG2E;
constexpr int GIN_TILES = 32;
constexpr float SB_DEAD = -150.0f;

constexpr size_t MiB = 1u << 20;
constexpr size_t WS_CTL = 0, CTL_ZERO_BYTES = 1 * MiB;
constexpr size_t WS_MODF = 1 * MiB;
constexpr size_t WS_ROPE = 2 * MiB;
constexpr size_t WS_W = 4 * MiB;
constexpr size_t W_IN = 0, W_QUP = W_IN + (size_t)PN * DM * 2, W_KVUP = W_QUP + (size_t)1536 * 512 * 2, W_BR = W_KVUP + (size_t)2048 * 256 * 2,
                 W_OUT = W_BR + (size_t)3 * 2048 * 1024 * 2, W_M1 = W_OUT + (size_t)DM * DM * 2, W_M2 = W_M1 + (size_t)DFF * DM * 2, W_LAYER = W_M2 + (size_t)DM * DFF * 2;
constexpr size_t WS_ACT = WS_W + DEPTH * W_LAYER;
constexpr size_t A_H = 0, A_PROJ = A_H + (size_t)S * DM * 2, A_QA = A_PROJ + (size_t)S * PN * 2, A_KA = A_QA + (size_t)S * 1024 * 2,
                 A_CQN = A_KA + (size_t)S * 1024 * 2, A_CKVN = A_CQN + (size_t)S * 512 * 2, A_KPE = A_CKVN + (size_t)S * 256 * 2,
                 A_QRAW = A_KPE + (size_t)S * 64 * 2, A_KVRAW = A_QRAW + (size_t)S * 1536 * 2, A_QH = A_KVRAW + (size_t)S * 2048 * 2,
                 A_KNOPE = A_QH + (size_t)S * 1536 * 2, A_OD = A_KNOPE + (size_t)S * 1024 * 2, A_YA = A_OD + (size_t)S * 2048 * 4,
                 A_YB = A_YA + (size_t)S * 1024 * 2, A_YC = A_YB + (size_t)S * 1024 * 2, A_MF = A_YC + (size_t)S * 1024 * 2,
                 A_MG = A_MF + (size_t)S * DM * 4, A_U = A_MG + (size_t)S * DM * 2, A_XB = A_U + (size_t)S * DFF * 2, A_XB2 = A_XB + (size_t)S * DM * 2, A_END = A_XB2 + (size_t)S * DM * 2;
constexpr size_t WS_END = WS_ACT + A_END;
constexpr int CW_BAR = 4096;
constexpr int CW_QUEUE = 16384;
constexpr int CW_DAC = 32768;
constexpr int CW_ADA = 8192;
constexpr size_t WS_BIAS = 512 * 1024;
constexpr int BIAS_PER_LAYER = PN + DFF;
constexpr size_t A_RSQA = A_H, A_RSQB = A_H + (size_t)1 * MiB;
constexpr size_t A_RSQCQ = A_H + (size_t)2 * MiB, A_RSQCKV = A_H + (size_t)3 * MiB;
constexpr size_t WS_ZERO = 256 * 1024;

constexpr int RING_BYTES = 131072;
constexpr int LDSCTL_OFF = RING_BYTES, MISC_OFF = LDSCTL_OFF + 320;
constexpr int LDS_BYTES = 147456;
constexpr int RS_OFF = MISC_OFF + 256;

__device__ __forceinline__ unsigned cvt_pk_bf16(float lo, float hi) { unsigned r; asm volatile("v_cvt_pk_bf16_f32 %0, %1, %2" : "=v"(r) : "v"(lo), "v"(hi)); return r; }
__device__ __forceinline__ float bf_lo(unsigned w) { return __uint_as_float(w << 16); }
__device__ __forceinline__ float bf_hi(unsigned w) { return __uint_as_float(w & 0xffff0000u); }
__device__ __forceinline__ float bf1(bf16 h) { return __uint_as_float((unsigned)h << 16); }
template <int M> __device__ __forceinline__ float swz(float v) {
    return __int_as_float(__builtin_amdgcn_ds_swizzle(__float_as_int(v), (M << 10) | 0x1F));
}
__device__ __forceinline__ float half_sum(float v) {
    auto rr = __builtin_amdgcn_permlane32_swap(__float_as_uint(v), __float_as_uint(v), false, false);
    return __uint_as_float(rr[0]) + __uint_as_float(rr[1]);
}
__device__ __forceinline__ float wave_sum(float v) {
    v += swz<1>(v); v += swz<2>(v); v += swz<4>(v); v += swz<8>(v); v += swz<16>(v);
    return half_sum(v);
}
__device__ __forceinline__ float rsq(float x) { return 1.0f / sqrtf(x); }
__device__ __forceinline__ float wave_max(float v) {
    v = fmaxf(v, swz<1>(v)); v = fmaxf(v, swz<2>(v)); v = fmaxf(v, swz<4>(v)); v = fmaxf(v, swz<8>(v)); v = fmaxf(v, swz<16>(v));
    auto rr = __builtin_amdgcn_permlane32_swap(__float_as_uint(v), __float_as_uint(v), false, false);
    return fmaxf(__uint_as_float(rr[0]), __uint_as_float(rr[1]));
}
constexpr float SMAX_BOUND = 40.f;

__device__ __forceinline__ int lane_id() { int l; asm volatile("v_mbcnt_lo_u32_b32 %0, -1, 0\n\tv_mbcnt_hi_u32_b32 %0, -1, %0" : "=v"(l)); return l; }
#define MYTID(wv) ((wv) * 64 + lane_id())

namespace pg8 {
constexpr int BM = 256, BK = 64, HALF = 128, HTB = HALF * BK * 2, STAGE_BYTES = 8 * HTB, NXCD = 8, WGM = 8;
__host__ __device__ __forceinline__ int lds_byte(int r, int c) { const int st = (r >> 4) * 2 + (c >> 5), rr = r & 15, cc = c & 31, ob = rr * 64 + cc * 2; return st * 1024 + (ob ^ (((ob >> 9) & 1) << 5)); }
__host__ __device__ __forceinline__ void stage_rc(int b, int& R, int& C) { const int st = b / 1024, sb = b % 1024, swz = sb ^ (((sb >> 9) & 1) << 5); R = (st >> 1) * 16 + swz / 64; C = (st & 1) * 32 + (swz % 64) / 2; }
__host__ __device__ __forceinline__ int perm32(int rho) { const int n = rho >> 4, i = rho & 15; return 8 * (i >> 2) + 4 * n + (i & 3); }

struct Unit { int pm, pn; };
struct Gemm { const bf16* A; const bf16* Bt; int M, N, K, lda; };

struct StaticOrder {
    int nM, nN, nwg, G, c;
    __device__ void init(int M, int N, int G_, int c_) { nM = M / BM; nN = N / BM; nwg = nM * nN; G = G_; c = c_; }
    __device__ bool next(int i, Unit& u) const {
        const long L = (long)i * G + c; if (L >= nwg) return false;
        int wgid = (int)L; { const int q = nwg / NXCD, r = nwg % NXCD, xcd = wgid % NXCD, off = wgid / NXCD; wgid = (xcd < r ? xcd * (q + 1) : r * (q + 1) + (xcd - r) * q) + off; }
        const int nig = WGM * nN, gid = wgid / nig, fm = gid * WGM, gsz = (nM - fm) < WGM ? (nM - fm) : WGM;
        u.pm = fm + ((wgid % nig) % gsz); u.pn = (wgid % nig) / gsz; return true;
    }
    __device__ __forceinline__ void a_ready(const Unit&) const {}
    __device__ __forceinline__ void done(const Unit&) const {}
};

struct OneUnit {
    Unit u0;
    __device__ bool next(int i, Unit& u) const { if (i > 0) return false; u = u0; return true; }
    __device__ __forceinline__ void a_ready(const Unit&) const {}
    __device__ __forceinline__ void done(const Unit&) const {}
};
template <int ACT  > struct EpiBf16 {
    static constexpr bool PERM = true, HAS_MID = false, RS = false, RSQ_OUT = false;
    bf16* O; int ldc; int sig_pn0;
    __device__ __forceinline__ void operator()(const f32x4 (&acc)[2][2][4][2], const Unit& u, int wr, int wc, int fr, int fq) const {
        const int row0 = u.pm * BM + wr * 64 + fr; const int col0 = u.pn * BM + wc * 32 + 8 * fq;
#pragma unroll
        for (int ai = 0; ai < 2; ++ai)
#pragma unroll
            for (int m = 0; m < 4; ++m) { bf16* rowp = O + (size_t)(row0 + ai * HALF + m * 16) * ldc + col0;
#pragma unroll
                for (int bj = 0; bj < 2; ++bj) { f32x4 v0 = acc[ai][bj][m][0], v1 = acc[ai][bj][m][1];
                    if (ACT == 2) {
#pragma unroll
                        for (int e = 0; e < 4; ++e) { const float a = fmaxf(v0[e], 0.f), b = fmaxf(v1[e], 0.f); v0[e] = a * a; v1[e] = b * b; } }
                    if (ACT == 3) { if (u.pn >= sig_pn0) {
#pragma unroll
                        for (int e = 0; e < 4; ++e) { v0[e] = __builtin_amdgcn_rcpf(1.f + __builtin_amdgcn_exp2f(-LOG2E * v0[e])); v1[e] = __builtin_amdgcn_rcpf(1.f + __builtin_amdgcn_exp2f(-LOG2E * v1[e])); } } }
                    u32x4 w; w.x = cvt_pk_bf16(v0[0], v0[1]); w.y = cvt_pk_bf16(v0[2], v0[3]); w.z = cvt_pk_bf16(v1[0], v1[1]); w.w = cvt_pk_bf16(v1[2], v1[3]);
                    *(u32x4*)(rowp + bj * HALF) = w; } }
    }
};
template <int ACT, bool RSO_ = false> struct EpiBf16N {
    static constexpr bool PERM = true, HAS_MID = false, RS = true, RSQ_OUT = false, RSO = RSO_, NO_BIAS = false;
    bf16* O; int ldc; int sig_pn0; const float* rsqp; const float* bias; float inv_n; float* rq_cq; float* rq_ckv;
    __device__ __forceinline__ void operator()(const f32x4 (&acc)[2][2][4][2], const Unit& u, int wr, int wc, int fr, int fq, const LAS float* raw, const LAS float* bl, LAS float* part) const {
        const int row0 = u.pm * BM + wr * 64 + fr; const int col0 = u.pn * BM + wc * 32 + 8 * fq;
        const bool want = RSO && u.pn >= C_CQ / 256 && u.pn <= C_CKV / 256;
        f32x4 bv[2][2];
#pragma unroll
        for (int bj = 0; bj < 2; ++bj)
#pragma unroll
            for (int n = 0; n < 2; ++n) bv[bj][n] = *(const LAS f32x4*)(bl + bj * HALF + wc * 32 + 8 * fq + 4 * n);
#pragma unroll
        for (int ai = 0; ai < 2; ++ai)
#pragma unroll
            for (int m = 0; m < 4; ++m) { bf16* rowp = O + (size_t)(row0 + ai * HALF + m * 16) * ldc + col0;
                const LAS float* rp = raw + (ai * HALF + wr * 64 + m * 16 + fr) * 8;
                const f32x4 p0 = *(const LAS f32x4*)rp, p1 = *(const LAS f32x4*)(rp + 4);
                const float rstd = __builtin_amdgcn_rsqf(((p0[0] + p0[1]) + (p0[2] + p0[3]) + (p1[0] + p1[1]) + (p1[2] + p1[3])) * inv_n + EPS);
                float ss = 0.f;
#pragma unroll
                for (int bj = 0; bj < 2; ++bj) { f32x4 v0 = acc[ai][bj][m][0] * rstd + bv[bj][0], v1 = acc[ai][bj][m][1] * rstd + bv[bj][1];
                    if (RSO) ss += ((v0[0] * v0[0] + v0[1] * v0[1]) + (v0[2] * v0[2] + v0[3] * v0[3])) + ((v1[0] * v1[0] + v1[1] * v1[1]) + (v1[2] * v1[2] + v1[3] * v1[3]));
                    if (ACT == 2) {
#pragma unroll
                        for (int e = 0; e < 4; ++e) { const float a = fmaxf(v0[e], 0.f), b = fmaxf(v1[e], 0.f); v0[e] = a * a; v1[e] = b * b; } }
                    if (ACT == 3) { if (u.pn >= sig_pn0) {
#pragma unroll
                        for (int e = 0; e < 4; ++e) { v0[e] = __builtin_amdgcn_rcpf(1.f + __builtin_amdgcn_exp2f(-LOG2E * v0[e])); v1[e] = __builtin_amdgcn_rcpf(1.f + __builtin_amdgcn_exp2f(-LOG2E * v1[e])); } } }
                    u32x4 w; w.x = cvt_pk_bf16(v0[0], v0[1]); w.y = cvt_pk_bf16(v0[2], v0[3]); w.z = cvt_pk_bf16(v1[0], v1[1]); w.w = cvt_pk_bf16(v1[2], v1[3]);
                    *(u32x4*)(rowp + bj * HALF) = w; }
                if (RSO) { if (want) { ss += swz<16>(ss); ss = half_sum(ss); if (fq == 0) part[wc * BM + ai * HALF + wr * 64 + m * 16 + fr] = ss; } } }
    }
};
struct EpiKvUp {
    static constexpr bool PERM = true, HAS_MID = false, RS = true, RSQ_OUT = false, RSO = false, NO_BIAS = true;
    bf16* KN; const float* gk; const float* rsqp;
    static constexpr float inv_n = 1.f / 256.f;
    __device__ __forceinline__ void operator()(const f32x4 (&acc)[2][2][4][2], const Unit& u, int wr, int wc, int fr_, int fq_, const LAS float* raw, const LAS float* bl, LAS float* part) const {
        const int ln_ = lane_id(), fr = ln_ & 15, fq = ln_ >> 4;
        const int row0 = u.pm * BM + wr * 64 + fr; const int cl = wc * 32 + 8 * fq;
        float rl[2][4];
#pragma unroll
        for (int ai = 0; ai < 2; ++ai)
#pragma unroll
            for (int m = 0; m < 4; ++m) { const int rloc = ai * HALF + wr * 64 + m * 16 + fr; const LAS float* rp = raw + rloc * 8;
                const f32x4 p0 = *(const LAS f32x4*)rp, p1 = *(const LAS f32x4*)(rp + 4);
                const float rstd = __builtin_amdgcn_rsqf(((p0[0] + p0[1]) + (p0[2] + p0[3]) + (p1[0] + p1[1]) + (p1[2] + p1[3])) * inv_n + EPS); rl[ai][m] = rstd;
                const f32x4 v0 = acc[ai][0][m][0] * rstd, v1 = acc[ai][0][m][1] * rstd;
                float ss = ((v0[0] * v0[0] + v0[1] * v0[1]) + (v0[2] * v0[2] + v0[3] * v0[3])) + ((v1[0] * v1[0] + v1[1] * v1[1]) + (v1[2] * v1[2] + v1[3] * v1[3]));
                ss += swz<16>(ss); ss = half_sum(ss);
                if (fq == 0) part[wc * BM + rloc] = ss; }
        asm volatile("s_waitcnt lgkmcnt(0)" ::: "memory"); __builtin_amdgcn_s_barrier();
        const f32x4 g0 = *(const f32x4*)(gk + cl), g1 = *(const f32x4*)(gk + cl + 4);
#pragma unroll
        for (int ai = 0; ai < 2; ++ai)
#pragma unroll
            for (int m = 0; m < 4; ++m) { const int rloc = ai * HALF + wr * 64 + m * 16 + fr; const size_t row = (size_t)(row0 + ai * HALF + m * 16);
                const float rk = __builtin_amdgcn_rsqf(((part[rloc] + part[BM + rloc]) + (part[2 * BM + rloc] + part[3 * BM + rloc])) * (1.f / 128.f) + EPS) * rl[ai][m];
                { const f32x4 v0 = acc[ai][0][m][0] * rk * g0, v1 = acc[ai][0][m][1] * rk * g1;
                  u32x4 w; w.x = cvt_pk_bf16(v0[0], v0[1]); w.y = cvt_pk_bf16(v0[2], v0[3]); w.z = cvt_pk_bf16(v1[0], v1[1]); w.w = cvt_pk_bf16(v1[2], v1[3]);
                  *(u32x4*)(KN + row * 1024 + u.pn * 128 + cl) = w; }
                { const f32x4 v0 = acc[ai][1][m][0] * rl[ai][m], v1 = acc[ai][1][m][1] * rl[ai][m];
                  u32x4 w; w.x = cvt_pk_bf16(v0[0], v0[1]); w.y = cvt_pk_bf16(v0[2], v0[3]); w.z = cvt_pk_bf16(v1[0], v1[1]); w.w = cvt_pk_bf16(v1[2], v1[3]);
                  *(u32x4*)((bf16*)((char*)KN + ((ptrdiff_t)A_KVRAW - (ptrdiff_t)A_KNOPE)) + row * 2048 + u.pn * 256 + 128 + cl) = w; } }
    }
};
template <int PASS> struct EpiBranch {
    static constexpr bool PERM = true;
    const bf16* G; int ldg; float* MF; bf16* MG;
    __device__ __forceinline__ void operator()(const f32x4 (&acc)[2][2][4][2], const Unit& u, int wr, int wc, int fr, int fq) const {
        const int row0 = u.pm * BM + wr * 64 + fr; const int col0 = u.pn * BM + wc * 32 + 8 * fq;
#pragma unroll
        for (int ai = 0; ai < 2; ++ai)
#pragma unroll
            for (int m = 0; m < 4; ++m) { const size_t row = (size_t)(row0 + ai * HALF + m * 16);
#pragma unroll
                for (int bj = 0; bj < 2; ++bj) { const int col = col0 + bj * HALF;
                    const u32x4 gw = *(const u32x4*)(G + row * ldg + col);
                    float g[8] = {bf_lo(gw.x), bf_hi(gw.x), bf_lo(gw.y), bf_hi(gw.y), bf_lo(gw.z), bf_hi(gw.z), bf_lo(gw.w), bf_hi(gw.w)};
                    f32x4 v0, v1;
#pragma unroll
                    for (int e = 0; e < 4; ++e) { v0[e] = acc[ai][bj][m][0][e] * __builtin_amdgcn_rcpf(1.f + __builtin_amdgcn_exp2f(-LOG2E * g[e]));
                                                  v1[e] = acc[ai][bj][m][1][e] * __builtin_amdgcn_rcpf(1.f + __builtin_amdgcn_exp2f(-LOG2E * g[4 + e])); }
                    float* mp = MF + row * DM + col;
                    if (PASS > 0) { v0 += *(const f32x4*)mp; v1 += *(const f32x4*)(mp + 4); }
                    if (PASS < 2) { *(f32x4*)mp = v0; *(f32x4*)(mp + 4) = v1; }
                    else { u32x4 w; w.x = cvt_pk_bf16(v0[0], v0[1]); w.y = cvt_pk_bf16(v0[2], v0[3]); w.z = cvt_pk_bf16(v1[0], v1[1]); w.w = cvt_pk_bf16(v1[2], v1[3]);
                           *(u32x4*)(MG + row * DM + col) = w; } } }
    }
};
struct EpiBranchRatio {
    static constexpr bool PERM = true, HAS_MID = true, RS = false, RSQ_OUT = false;
    const bf16* G; int ldg; bf16* MG;
    __device__ __forceinline__ void mid(f32x4 (&acc)[2][2][4][2], const Unit& u, int seg, int wr, int wc, int fr, int fq) const {
        const int row0 = u.pm * BM + wr * 64 + fr; const int col0 = u.pn * BM + wc * 32 + 8 * fq;
        const bf16* Ga = G + (seg - 1) * DM; const bf16* Gb = G + seg * DM;
#pragma unroll
        for (int ai = 0; ai < 2; ++ai)
#pragma unroll
            for (int mp = 0; mp < 2; ++mp) {
                u32x4 ga[2][2], gb[2][2];
#pragma unroll
                for (int mm = 0; mm < 2; ++mm)
#pragma unroll
                    for (int bj = 0; bj < 2; ++bj) { const size_t off = (size_t)(row0 + ai * HALF + (2 * mp + mm) * 16) * ldg + col0 + bj * HALF;
                        ga[mm][bj] = *(const u32x4*)(Ga + off); gb[mm][bj] = *(const u32x4*)(Gb + off); }
#pragma unroll
                for (int mm = 0; mm < 2; ++mm)
#pragma unroll
                    for (int bj = 0; bj < 2; ++bj) { const int m = 2 * mp + mm; const u32x4 a_ = ga[mm][bj], b_ = gb[mm][bj];
                        const float sa[8] = {bf_lo(a_.x), bf_hi(a_.x), bf_lo(a_.y), bf_hi(a_.y), bf_lo(a_.z), bf_hi(a_.z), bf_lo(a_.w), bf_hi(a_.w)};
                        const float sb[8] = {bf_lo(b_.x), bf_hi(b_.x), bf_lo(b_.y), bf_hi(b_.y), bf_lo(b_.z), bf_hi(b_.z), bf_lo(b_.w), bf_hi(b_.w)};
#pragma unroll
                        for (int e = 0; e < 4; ++e) { acc[ai][bj][m][0][e] *= sa[e] * __builtin_amdgcn_rcpf(fmaxf(sb[e], 1e-30f)); acc[ai][bj][m][1][e] *= sa[4 + e] * __builtin_amdgcn_rcpf(fmaxf(sb[4 + e], 1e-30f)); } }
            }
    }
    __device__ __forceinline__ void operator()(const f32x4 (&acc)[2][2][4][2], const Unit& u, int wr, int wc, int fr, int fq) const {
        const int row0 = u.pm * BM + wr * 64 + fr; const int col0 = u.pn * BM + wc * 32 + 8 * fq;
        const bf16* Gc = G + 2 * DM;
#pragma unroll
        for (int ai = 0; ai < 2; ++ai)
#pragma unroll
            for (int mp = 0; mp < 2; ++mp) {
                u32x4 gc[2][2];
#pragma unroll
                for (int mm = 0; mm < 2; ++mm)
#pragma unroll
                    for (int bj = 0; bj < 2; ++bj) gc[mm][bj] = *(const u32x4*)(Gc + (size_t)(row0 + ai * HALF + (2 * mp + mm) * 16) * ldg + col0 + bj * HALF);
#pragma unroll
                for (int mm = 0; mm < 2; ++mm)
#pragma unroll
                    for (int bj = 0; bj < 2; ++bj) { const int m = 2 * mp + mm; const u32x4 c_ = gc[mm][bj];
                        const float sc[8] = {bf_lo(c_.x), bf_hi(c_.x), bf_lo(c_.y), bf_hi(c_.y), bf_lo(c_.z), bf_hi(c_.z), bf_lo(c_.w), bf_hi(c_.w)};
                        f32x4 v0, v1;
#pragma unroll
                        for (int e = 0; e < 4; ++e) { v0[e] = acc[ai][bj][m][0][e] * sc[e]; v1[e] = acc[ai][bj][m][1][e] * sc[4 + e]; }
                        u32x4 w; w.x = cvt_pk_bf16(v0[0], v0[1]); w.y = cvt_pk_bf16(v0[2], v0[3]); w.z = cvt_pk_bf16(v1[0], v1[1]); w.w = cvt_pk_bf16(v1[2], v1[3]);
                        *(u32x4*)(MG + (size_t)(row0 + ai * HALF + m * 16) * DM + col0 + bj * HALF) = w; }
            }
    }
};
template <bool XIN16, bool XOUT16> struct EpiResid {
    static constexpr bool PERM = true, HAS_MID = false, RS = false, RSQ_OUT = XOUT16;
    const void* xin; void* out; const float* gvec; float* rsqp; LAS float* part;
    __device__ __forceinline__ void operator()(const f32x4 (&acc)[2][2][4][2], const Unit& u, int wr, int wc, int fr, int fq) const {
        const int row0 = u.pm * BM + wr * 64 + fr; const int col0 = u.pn * BM + wc * 32 + 8 * fq;
        f32x4 gv[2][2];
#pragma unroll
        for (int bj = 0; bj < 2; ++bj)
#pragma unroll
            for (int n = 0; n < 2; ++n) gv[bj][n] = *(const f32x4*)(gvec + col0 + bj * HALF + n * 4);
#pragma unroll
        for (int ai = 0; ai < 2; ++ai)
#pragma unroll
            for (int mp = 0; mp < 2; ++mp) {
                f32x4 xv[2][2][2];
#pragma unroll
                for (int mm = 0; mm < 2; ++mm) { const size_t off = (size_t)(row0 + ai * HALF + (2 * mp + mm) * 16) * DM + col0;
#pragma unroll
                    for (int bj = 0; bj < 2; ++bj) {
                        if (XIN16) { const u32x4 w_ = *(const u32x4*)((const bf16*)xin + off + bj * HALF);
                            xv[mm][bj][0] = (f32x4){bf_lo(w_.x), bf_hi(w_.x), bf_lo(w_.y), bf_hi(w_.y)}; xv[mm][bj][1] = (f32x4){bf_lo(w_.z), bf_hi(w_.z), bf_lo(w_.w), bf_hi(w_.w)}; }
                        else { xv[mm][bj][0] = *(const f32x4*)((const float*)xin + off + bj * HALF); xv[mm][bj][1] = *(const f32x4*)((const float*)xin + off + bj * HALF + 4); } } }
#pragma unroll
                for (int mm = 0; mm < 2; ++mm) { const int m = 2 * mp + mm; const size_t off = (size_t)(row0 + ai * HALF + m * 16) * DM + col0; float ss = 0.f;
#pragma unroll
                    for (int bj = 0; bj < 2; ++bj) { const f32x4 v0 = xv[mm][bj][0] + gv[bj][0] * acc[ai][bj][m][0], v1 = xv[mm][bj][1] + gv[bj][1] * acc[ai][bj][m][1];
                        if (XOUT16) ss += ((v0[0] * v0[0] + v0[1] * v0[1]) + (v0[2] * v0[2] + v0[3] * v0[3])) + ((v1[0] * v1[0] + v1[1] * v1[1]) + (v1[2] * v1[2] + v1[3] * v1[3]));
                        if (XOUT16) { u32x4 w; w.x = cvt_pk_bf16(v0[0], v0[1]); w.y = cvt_pk_bf16(v0[2], v0[3]); w.z = cvt_pk_bf16(v1[0], v1[1]); w.w = cvt_pk_bf16(v1[2], v1[3]);
                            *(u32x4*)((bf16*)out + off + bj * HALF) = w; }
                        else { *(f32x4*)((float*)out + off + bj * HALF) = v0; *(f32x4*)((float*)out + off + bj * HALF + 4) = v1; } }
                    if (XOUT16) { ss += swz<16>(ss); ss = half_sum(ss);
                        if (fq == 0) part[wc * BM + ai * HALF + wr * 64 + m * 16 + fr] = ss; } }
            }
    }
};

template <class Epi, class Sched>
__device__ __forceinline__ void gemm_phase(LAS unsigned char* lds, const Gemm g, const Sched& S, const Epi& E, const int wv) {
    int tid = MYTID(wv); asm volatile("" : "+v"(tid));
    const int wid = __builtin_amdgcn_readfirstlane(tid >> 6), lane = tid & 63, wr = wid >> 2, wc = wid & 3, fr = lane & 15, fq = lane >> 4;
    const int K = g.K, nt = K / BK, lda = g.lda;
    const int thook = nt >= 6 ? 4 : nt - 2;
    unsigned voffA[2], voffB[2];
#pragma unroll
    for (int i = 0; i < 2; ++i) { int R, C; stage_rc(tid * 16 + i * 8192, R, C); const int Rb = Epi::PERM ? ((R & ~31) + perm32(R & 31)) : R;
        voffA[i] = (unsigned)(R * lda + C) * 2u; voffB[i] = (unsigned)(Rb * K + C) * 2u; }
    const size_t kstep = (size_t)(BK * 2);
    const size_t hsA = (size_t)HALF * lda * 2, hsB = (size_t)HALF * K * 2;
    const size_t tsA = 2 * hsA, tsB = 2 * hsB;
    const unsigned ldsw = (unsigned)wid * 1024u;
    const int aoff = lds_byte(wr * 64 + fr, fq * 8), boff = lds_byte(wc * 32 + fr, fq * 8);
#define PG8_SA(b, h) (((b) * 2 + (h)) * HTB)
#define PG8_SB(b, h) ((4 + (b) * 2 + (h)) * HTB)
#define PG8_STAGE(bufoff, gbase, voff) do { _Pragma("unroll") for (int _i = 0; _i < 2; ++_i) \
        __builtin_amdgcn_global_load_lds((const unsigned*)((const char*)(gbase) + (voff)[_i]), (LAS unsigned*)(lds + (bufoff) + ldsw + _i * 8192), 16, 0, 0); } while (0)
#define PG8_LDA(dst, b, h) do { _Pragma("unroll") for (int m = 0; m < 4; ++m) _Pragma("unroll") for (int k = 0; k < 2; ++k) dst[m][k] = *(const LAS bf16x8*)(lds + PG8_SA(b, h) + aoff + m * 2048 + k * 1024); } while (0)
#define PG8_LDB(dst, b, h) do { _Pragma("unroll") for (int n = 0; n < 2; ++n) _Pragma("unroll") for (int k = 0; k < 2; ++k) dst[n][k] = *(const LAS bf16x8*)(lds + PG8_SB(b, h) + boff + n * 2048 + k * 1024); } while (0)
#define PG8_MMA(ai, bj, At, Bt) do { __builtin_amdgcn_s_setprio(1); _Pragma("unroll") for (int m = 0; m < 4; ++m) _Pragma("unroll") for (int n = 0; n < 2; ++n) _Pragma("unroll") for (int k = 0; k < 2; ++k) \
        acc[ai][bj][m][n] = __builtin_amdgcn_mfma_f32_16x16x32_bf16(Bt[n][k], At[m][k], acc[ai][bj][m][n], 0, 0, 0); __builtin_amdgcn_s_setprio(0); } while (0)
#define PG8_WAIT_V(n) asm volatile("s_waitcnt vmcnt(" #n ")" ::: "memory")
#define PG8_WAIT_L(n) asm volatile("s_waitcnt lgkmcnt(" #n ")" ::: "memory")
#define PG8_BAR __builtin_amdgcn_s_barrier()
#define PG8_SCHED __builtin_amdgcn_sched_barrier(0)
    Unit cur, nxt; int ui = 0;
    if (!S.next(0, cur)) return;
    f32x4 acc[2][2][4][2];
#pragma unroll
    for (int a = 0; a < 2; ++a)
#pragma unroll
        for (int b = 0; b < 2; ++b)
#pragma unroll
            for (int m = 0; m < 4; ++m)
#pragma unroll
                for (int n = 0; n < 2; ++n) acc[a][b][m][n] = (f32x4){0.f, 0.f, 0.f, 0.f};
    bf16x8 At[4][2], B0[2][2], B1[2][2];
    const char* cA = (const char*)g.A + (size_t)cur.pm * tsA; const char* cB = (const char*)g.Bt + (size_t)cur.pn * tsB;
    S.a_ready(cur);
    PG8_STAGE(PG8_SB(0, 0), cB, voffB); PG8_STAGE(PG8_SB(0, 1), cB + hsB, voffB); PG8_STAGE(PG8_SA(0, 0), cA, voffA); PG8_STAGE(PG8_SA(0, 1), cA + hsA, voffA);
    if (wr == 1) PG8_BAR;
    PG8_WAIT_V(2); PG8_BAR;
    PG8_STAGE(PG8_SB(1, 0), cB + kstep, voffB); PG8_STAGE(PG8_SA(1, 0), cA + kstep, voffA); PG8_STAGE(PG8_SB(1, 1), cB + hsB + kstep, voffB);
    PG8_WAIT_V(6); PG8_BAR;
    for (;;) {
        const bool has_next = S.next(ui + 1, nxt);
        const char* nA = has_next ? (const char*)g.A + (size_t)nxt.pm * tsA : cA; const char* nB = has_next ? (const char*)g.Bt + (size_t)nxt.pn * tsB : cB;
        for (int t = 0; t < nt; t += 2) {
            const bool last = (t == nt - 2);
            const char* a1 = cA + (size_t)(t + 1) * kstep;
            const char* a2 = last ? nA : cA + (size_t)(t + 2) * kstep; const char* b2 = last ? nB : cB + (size_t)(t + 2) * kstep;
            const char* a3 = a2 + kstep; const char* b3 = b2 + kstep;
            if (last && has_next) S.a_ready(nxt);
            if constexpr (Epi::HAS_MID) { if (t > 0 && (t & 15) == 0) E.mid(acc, cur, t >> 4, wr, wc, fr, fq); }
            if constexpr (Epi::RS) { if (t == thook) {
                const int ln_ = lane_id();
                __builtin_amdgcn_global_load_lds((const unsigned*)((const char*)(E.rsqp + (size_t)cur.pm * BM * 8) + ldsw + ln_ * 16), (LAS unsigned*)(lds + RS_OFF + ldsw), 16, 0, 0);
                if constexpr (!Epi::NO_BIAS) { if (wid == 0) __builtin_amdgcn_global_load_lds((const unsigned*)((const char*)(E.bias + cur.pn * BM) + ln_ * 16), (LAS unsigned*)(lds + RS_OFF + 8192), 16, 0, 0); } } }
            PG8_LDB(B0, 0, 0); PG8_LDB(B1, 0, 1); PG8_SCHED; PG8_LDA(At, 0, 0); PG8_STAGE(PG8_SA(1, 1), a1 + hsA, voffA);
            PG8_WAIT_V(8); PG8_WAIT_L(0); PG8_BAR; PG8_MMA(0, 0, At, B0); PG8_MMA(0, 1, At, B1); PG8_BAR; PG8_SCHED;
            PG8_LDA(At, 0, 1); PG8_STAGE(PG8_SB(0, 0), b2, voffB); PG8_STAGE(PG8_SB(0, 1), b2 + hsB, voffB); PG8_STAGE(PG8_SA(0, 0), a2, voffA);
            PG8_WAIT_V(8); PG8_WAIT_L(0); PG8_BAR; PG8_MMA(1, 0, At, B0); PG8_MMA(1, 1, At, B1); PG8_BAR; PG8_SCHED;
            PG8_LDB(B0, 1, 0); PG8_LDB(B1, 1, 1); PG8_SCHED; PG8_LDA(At, 1, 0); PG8_STAGE(PG8_SA(0, 1), a2 + hsA, voffA);
            PG8_WAIT_V(8); PG8_WAIT_L(0); PG8_BAR; PG8_MMA(0, 0, At, B0); PG8_MMA(0, 1, At, B1); PG8_BAR; PG8_SCHED;
            PG8_LDA(At, 1, 1); PG8_STAGE(PG8_SB(1, 0), b3, voffB); PG8_STAGE(PG8_SB(1, 1), b3 + hsB, voffB); PG8_STAGE(PG8_SA(1, 0), a3, voffA);
            PG8_WAIT_V(8); PG8_WAIT_L(0); PG8_BAR; PG8_MMA(1, 0, At, B0); PG8_MMA(1, 1, At, B1); PG8_BAR; PG8_SCHED;
        }
        if (wr == 0) PG8_BAR;
        if constexpr (Epi::RS) E(acc, cur, wr, wc, fr, fq, (const LAS float*)(lds + RS_OFF), (const LAS float*)(lds + RS_OFF + 8192), (LAS float*)(lds + RS_OFF + 9216)); else E(acc, cur, wr, wc, fr, fq);
        S.done(cur);
        if constexpr (Epi::RS) { if constexpr (Epi::RSO) { if (cur.pn >= C_CQ / 256 && cur.pn <= C_CKV / 256) {
            asm volatile("s_waitcnt lgkmcnt(0)" ::: "memory"); PG8_BAR;
            const int t2 = wid * 64 + lane_id();
            if (t2 < BM) { const LAS float* pp = (const LAS float*)(lds + RS_OFF + 9216) + t2; const float sm = (pp[0] + pp[BM]) + (pp[2 * BM] + pp[3 * BM]);
                const bool ckv = cur.pn == C_CKV / 256; const int slot = ckv ? 0 : cur.pn - C_CQ / 256; float* rq = (ckv ? E.rq_ckv : E.rq_cq) + (size_t)(cur.pm * BM + t2) * 8;
                rq[slot] = sm;
                if (slot == 0) {
                    float zf; asm volatile("v_mov_b32 %0, 0" : "=v"(zf));
                    if (ckv) rq[1] = zf;
#pragma unroll
                    for (int z = 2; z < 8; ++z) rq[z] = zf; } } } } }
        if constexpr (Epi::RSQ_OUT) {
            asm volatile("s_waitcnt lgkmcnt(0)" ::: "memory"); PG8_BAR;
            const int t2 = wid * 64 + lane_id();
            if (t2 < BM) { const LAS float* pp = (const LAS float*)(lds + RS_OFF) + t2; E.rsqp[(size_t)(cur.pm * BM + t2) * 8 + cur.pn] = (pp[0] + pp[BM]) + (pp[2 * BM] + pp[3 * BM]); } }
        if (!has_next) break;
#pragma unroll
        for (int a = 0; a < 2; ++a)
#pragma unroll
            for (int b = 0; b < 2; ++b)
#pragma unroll
                for (int m = 0; m < 4; ++m)
#pragma unroll
                    for (int n = 0; n < 2; ++n) acc[a][b][m][n] = (f32x4){0.f, 0.f, 0.f, 0.f};
        cur = nxt; cA = nA; cB = nB; ++ui;
        if (wr == 1) PG8_BAR;
    }
    PG8_WAIT_V(0);
    PG8_BAR;
#undef PG8_SA
#undef PG8_SB
#undef PG8_STAGE
#undef PG8_LDA
#undef PG8_LDB
#undef PG8_MMA
#undef PG8_WAIT_V
#undef PG8_WAIT_L
#undef PG8_BAR
#undef PG8_SCHED
}
}

namespace att {
constexpr int NW = 8, QBLK = 32, KVBLK = 64, QB = 256;
constexpr int SHM_V = KVBLK * 128 * 2;
constexpr int NSLOT = 3, KSLOT = 64 * 192 * 2;
constexpr int L_V = 0, L_K = NSLOT * SHM_V, L_WS = L_K + NSLOT * KSLOT, L_BIAS = L_WS + NW * 64 * 4, L_FLAG = L_BIAS + 1024, L_QT = 0, L_END = L_FLAG + 256;
static_assert(L_END <= RING_BYTES, "attention LDS");
#define SBAR() __builtin_amdgcn_sched_barrier(0)
__device__ __forceinline__ int crow(int r, int hi) { return (r & 3) + 8 * (r >> 2) + 4 * hi; }
template <int RB> __device__ __forceinline__ int kaddr(int row, int blk, int c8) {
    const int sw = (RB == 256) ? (row & 7) : ((row >> 1) & 7);
    return row * RB + blk * 128 + ((c8 ^ sw) << 4);
}
template <int RB> __device__ __forceinline__ int kswz(int row, int colB) { return kaddr<RB>(row, colB >> 7, (colB >> 4) & 7); }
constexpr float THR = 11.0f;
__device__ __forceinline__ void partialSM(f32x16& p0, f32x16& p1, float& m_reg, float& mn, float& alpha) {
    float pmax = p0[0];
#pragma unroll
    for (int r = 1; r < 16; ++r) pmax = fmaxf(pmax, p0[r]);
#pragma unroll
    for (int r = 0; r < 16; ++r) pmax = fmaxf(pmax, p1[r]);
    { auto rr = __builtin_amdgcn_permlane32_swap(__float_as_uint(pmax), __float_as_uint(pmax), false, false);
      pmax = fmaxf(__uint_as_float(rr[0]), __uint_as_float(rr[1])); }
    if (__builtin_expect(__all(pmax - m_reg <= THR), 1)) { mn = m_reg; alpha = 1.f; }
    else { mn = fmaxf(m_reg, pmax); alpha = __builtin_amdgcn_exp2f(m_reg - mn); m_reg = mn; }
#pragma unroll
    for (int r = 0; r < 16; ++r) p0[r] = p0[r] - mn;
#pragma unroll
    for (int r = 0; r < 16; ++r) p1[r] = p1[r] - mn;
#pragma unroll
    for (int r = 0; r < 16; ++r) p0[r] = __builtin_amdgcn_exp2f(p0[r]);
}
#define PK4(P, BASE, OUT) do { unsigned a0 = cvt_pk_bf16(P[BASE + 0], P[BASE + 1]), a1 = cvt_pk_bf16(P[BASE + 2], P[BASE + 3]);   \
    unsigned b0 = cvt_pk_bf16(P[BASE + 4], P[BASE + 5]), b1 = cvt_pk_bf16(P[BASE + 6], P[BASE + 7]);                              \
    auto r0 = __builtin_amdgcn_permlane32_swap(a0, b0, false, false); auto r1 = __builtin_amdgcn_permlane32_swap(a1, b1, false, false); \
    u32x4 w = {r0[0], r1[0], r0[1], r1[1]}; OUT = *reinterpret_cast<bf16x8*>(&w); } while (0)
__device__ __forceinline__ void finishSM(f32x16& p0, f32x16& p1, float alpha, float& l_reg, bf16x8& pa0, bf16x8& pa1, bf16x8& pa2, bf16x8& pa3) {
#pragma unroll
    for (int r = 0; r < 16; ++r) p1[r] = __builtin_amdgcn_exp2f(p1[r]);
    float ps = 0;
#pragma unroll
    for (int r = 0; r < 16; ++r) ps += p0[r];
#pragma unroll
    for (int r = 0; r < 16; ++r) ps += p1[r];
    { auto rr = __builtin_amdgcn_permlane32_swap(__float_as_uint(ps), __float_as_uint(ps), false, false);
      ps = __uint_as_float(rr[0]) + __uint_as_float(rr[1]); }
    l_reg = l_reg * alpha + ps;
    PK4(p0, 0, pa0); PK4(p0, 8, pa1); PK4(p1, 0, pa2); PK4(p1, 8, pa3);
}
template <int DK, int QREG> __device__ __forceinline__ void qkt(f32x16& p0, f32x16& p1, const LAS char* Ks, const bf16x8* qr, const LAS char* qt, int r32, int hi) {
    constexpr int RB = DK * 2;
    p0 = f32x16{}; p1 = f32x16{};
#pragma unroll
    for (int d0 = 0; d0 < DK / 16; ++d0) { const int ka = kaddr<RB>(r32, d0 >> 2, 4 * hi + (d0 & 3));
        const bf16x8 b0 = *(const LAS bf16x8*)(Ks + ka);
        const bf16x8 b1 = *(const LAS bf16x8*)(Ks + ka + 32 * RB);
        bf16x8 qf;
        if (d0 < QREG) qf = qr[d0]; else qf = *(const LAS bf16x8*)(qt + kaddr<128>(r32, (d0 - QREG) >> 2, 4 * hi + (d0 & 3)));
        p0 = __builtin_amdgcn_mfma_f32_32x32x16_bf16(b0, qf, p0, 0, 0, 0);
        p1 = __builtin_amdgcn_mfma_f32_32x32x16_bf16(b1, qf, p1, 0, 0, 0); }
}
__device__ __forceinline__ int v_st(int k, int c) { const int kk = (k & ~0xC) | ((k & 4) << 1) | ((k & 8) >> 1); return ((kk >> 3) * 4 + (c >> 5)) * 512 + ((kk & 7) * 32 + (c & 31)) * 2; }
__device__ __forceinline__ int v_rd_base(int lane) { return ((lane & 3) << 3) | (((lane >> 2) & 3) << 6) | (((lane >> 4) & 1) << 5) | (((lane >> 5) & 1) << 8); }
constexpr int v_rd_off(int d0, int ks, int half) { return d0 * 512 + ks * 4096 + half * 2048; }
template <int OFF> __device__ __forceinline__ s16x4 tr_read(int vb) {
    s16x4 r; asm volatile("ds_read_b64_tr_b16 %0, %1 offset:%2" : "=&v"(r) : "v"(vb), "i"(OFF) : "memory"); return r;
}
template <int D0> __device__ __forceinline__ void pv_one(f32x16& od, int vb, bf16x8 pa0, bf16x8 pa1, bf16x8 pa2, bf16x8 pa3) {
    const s16x4 l0 = tr_read<v_rd_off(D0, 0, 0)>(vb), h0 = tr_read<v_rd_off(D0, 0, 1)>(vb), l1 = tr_read<v_rd_off(D0, 1, 0)>(vb), h1 = tr_read<v_rd_off(D0, 1, 1)>(vb);
    const s16x4 l2 = tr_read<v_rd_off(D0, 2, 0)>(vb), h2 = tr_read<v_rd_off(D0, 2, 1)>(vb), l3 = tr_read<v_rd_off(D0, 3, 0)>(vb), h3 = tr_read<v_rd_off(D0, 3, 1)>(vb);
    asm volatile("s_waitcnt lgkmcnt(0)" ::: "memory"); SBAR();
#define PKV(L, H) (bf16x8){L[0], L[1], L[2], L[3], H[0], H[1], H[2], H[3]}
    od = __builtin_amdgcn_mfma_f32_32x32x16_bf16(pa0, PKV(l0, h0), od, 0, 0, 0);
    od = __builtin_amdgcn_mfma_f32_32x32x16_bf16(pa1, PKV(l1, h1), od, 0, 0, 0);
    od = __builtin_amdgcn_mfma_f32_32x32x16_bf16(pa2, PKV(l2, h2), od, 0, 0, 0);
    od = __builtin_amdgcn_mfma_f32_32x32x16_bf16(pa3, PKV(l3, h3), od, 0, 0, 0);
#undef PKV
}
__device__ __forceinline__ void pv_d0(f32x16* o, int vb, bf16x8 pa0, bf16x8 pa1, bf16x8 pa2, bf16x8 pa3) {
    pv_one<0>(o[0], vb, pa0, pa1, pa2, pa3); pv_one<1>(o[1], vb, pa0, pa1, pa2, pa3); pv_one<2>(o[2], vb, pa0, pa1, pa2, pa3); pv_one<3>(o[3], vb, pa0, pa1, pa2, pa3);
}

struct KVSrc { const bf16* k0; int ldk0; const bf16* k1; int ldk1; const bf16* v; int ldv; };

template <int DK, int DK0> struct Stager {
    static constexpr int NK0 = DK0 / 64, NK1 = (DK - DK0) / 64, NKC = NK0 + NK1;
    static constexpr int CPR0 = DK0 / 8, CPR1 = (DK - DK0) / 8 > 0 ? (DK - DK0) / 8 : 1;
    const bf16* kb[NKC]; int kstride[NKC];
    int koff[NKC]; int klds[NKC];
    const bf16* vb; int vstride; int voff0, voff1, vst0, vst1;
    __device__ __forceinline__ void init(const KVSrc& s, int tid) {
#pragma unroll
        for (int i = 0; i < NK0; ++i) { const int c = tid + 512 * i, row = c / CPR0, ch = c % CPR0;
            kb[i] = s.k0; kstride[i] = 64 * s.ldk0; koff[i] = row * s.ldk0 + ch * 8; klds[i] = kswz<DK * 2>(row, ch * 16); }
#pragma unroll
        for (int i = 0; i < NK1; ++i) { const int c = tid + 512 * i, row = c / CPR1, ch = c % CPR1;
            kb[NK0 + i] = s.k1; kstride[NK0 + i] = 64 * s.ldk1; koff[NK0 + i] = row * s.ldk1 + ch * 8; klds[NK0 + i] = kswz<DK * 2>(row, DK0 * 2 + ch * 16); }
        const int sr = tid >> 4, sc = (tid & 15) * 8;
        vb = s.v; vstride = 64 * s.ldv; voff0 = sr * s.ldv + sc; voff1 = (32 + sr) * s.ldv + sc;
        vst0 = v_st(sr, sc); vst1 = v_st(32 + sr, sc);
    }
    __device__ __forceinline__ bf16x8 ldk(int i, int t) const { return *reinterpret_cast<const bf16x8*>(kb[i] + (size_t)t * kstride[i] + koff[i]); }
    __device__ __forceinline__ bf16x8 ldv0(int t) const { return *reinterpret_cast<const bf16x8*>(vb + (size_t)t * vstride + voff0); }
    __device__ __forceinline__ bf16x8 ldv1(int t) const { return *reinterpret_cast<const bf16x8*>(vb + (size_t)t * vstride + voff1); }
};

template <bool F32> __device__ __forceinline__ void store_o_staged(const f32x16 (&o)[4], const float* rl, LAS char* stg, float* Of, bf16* Ob, int ldo, int le) {
    const int r32e = le & 31, hie = le >> 5, rr0 = le >> 4, ch = le & 15;
    if constexpr (!F32) {
        LAS bf16* st = (LAS bf16*)stg;
#pragma unroll
        for (int r = 0; r < 16; ++r) { const int ro = (r & 3) + 8 * (r >> 2) + 4 * hie;
#pragma unroll
            for (int d0 = 0; d0 < 4; ++d0) { const float v = rl ? o[d0][r] * rl[r] : o[d0][r]; st[ro * 128 + d0 * 32 + r32e] = (bf16)(cvt_pk_bf16(v, v) & 0xffffu); } }
#pragma unroll
        for (int i = 0; i < 8; ++i) { const int row = i * 4 + rr0; const u32x4 v = *(const LAS u32x4*)(stg + row * 256 + ch * 16); *(u32x4*)(Ob + (size_t)row * ldo + ch * 8) = v; }
    } else {
        LAS float* st = (LAS float*)stg;
#pragma unroll
        for (int p = 0; p < 2; ++p) {
#pragma unroll
            for (int r = 0; r < 16; ++r) { const int ro = (r & 3) + 8 * (r >> 2) + 4 * hie;
#pragma unroll
                for (int dd = 0; dd < 2; ++dd) { const float v = rl ? o[2 * p + dd][r] * rl[r] : o[2 * p + dd][r]; st[ro * 64 + dd * 32 + r32e] = v; } }
#pragma unroll
            for (int i = 0; i < 8; ++i) { const int row = i * 4 + rr0; const f32x4 v = *(const LAS f32x4*)(stg + row * 256 + ch * 16); *(f32x4*)(Of + (size_t)row * ldo + p * 64 + ch * 4) = v; }
        }
    }
}
typedef short v4i16_t __attribute__((ext_vector_type(4)));
__device__ __forceinline__ s16x4 vtr(const LAS char* p) { return __builtin_bit_cast(s16x4, __builtin_amdgcn_ds_read_tr16_b64_v4i16((LAS v4i16_t*)p)); }
struct DaFin { const float* other; unsigned* cnt; float lam; const float* gsub; float omli; bool own_first; };
struct QPrep { const float* g; const float* rc; const float* rs; };
template <int DK, int DK0, bool BIAS, bool OUTF32, bool NEGM_, bool ILB, bool NOMAX = false, bool QPREP = false>
__device__ __forceinline__ void softmax_unit_v3(LAS char* lds, const bf16* Qb, int ldq, const KVSrc kv, int q0, float* Of, bf16* Ob, int ldo, const int wv, const DaFin fin = DaFin{}, const QPrep qp = QPrep{}) {
    constexpr int RB = DK * 2, NKCH = DK / 64, NQ = DK / 16, NM = 2 * NQ;
    constexpr bool NEGM = NEGM_ && !NOMAX;
    int tid = MYTID(wv); asm volatile("" : "+v"(tid));
    const int lane = tid & 63, r32 = lane & 31, hi = lane >> 5; const int wid = __builtin_amdgcn_readfirstlane(tid >> 6);
    LAS char* V_lds = lds + L_V; LAS char* K_lds = lds + L_K;
    LAS float* ws = (LAS float*)(lds + L_WS) + wid * 64; LAS float* li_l = ws; LAS float* al_l = ws + 32;
    const LAS float* tbl = (const LAS float*)(lds + L_BIAS);
    const bf16* kptr[NKCH]; int kstr[NKCH]; const bf16* vptr[2]; const int vstr = 64 * kv.ldv;
#pragma unroll
    for (int i = 0; i < NKCH; ++i) { const int p = (wid + 8 * i) * 1024 + lane * 16, row = p / RB, within = p - row * RB, blk = within >> 7;
        const int sw = (RB == 256) ? (row & 7) : ((row >> 1) & 7); const int c8 = ((within >> 4) & 7) ^ sw, col = (blk * 8 + c8) * 8;
        if (col < DK0) { kptr[i] = kv.k0 + (size_t)row * kv.ldk0 + col; kstr[i] = 64 * kv.ldk0; }
        else { kptr[i] = kv.k1 + (size_t)row * kv.ldk1 + (col - DK0); kstr[i] = 64 * kv.ldk1; } }
#pragma unroll
    for (int i = 0; i < 2; ++i) { const int p = (wid + 8 * i) * 1024 + lane * 16, sub = p >> 9, within = p & 511;
        const int kk = (sub >> 2) * 8 + (within >> 6), c = (sub & 3) * 32 + ((within & 63) >> 1);
        vptr[i] = kv.v + (size_t)kk * kv.ldv + c; }

#define DMA_TILE(slot) do { \
    _Pragma("unroll") for (int i_ = 0; i_ < NKCH; ++i_) { __builtin_amdgcn_global_load_lds((const unsigned*)kptr[i_], (LAS unsigned*)(K_lds + (slot) * KSLOT + (wid + 8 * i_) * 1024), 16, 0, 0); kptr[i_] += kstr[i_]; } \
    _Pragma("unroll") for (int i_ = 0; i_ < 2; ++i_) { __builtin_amdgcn_global_load_lds((const unsigned*)vptr[i_], (LAS unsigned*)(V_lds + (slot) * SHM_V + (wid + 8 * i_) * 1024), 16, 0, 0); vptr[i_] += vstr; } } while (0)
#define WAIT_BAR() asm volatile("s_waitcnt vmcnt(0) lgkmcnt(0)\n\ts_barrier" ::: "memory")
    DMA_TILE(0); DMA_TILE(1);
    float m_reg, l_reg = 0.f; f32x16 o[4] = {}; bf16x8 qr[NQ];
    const bf16* Qw = Qb + (size_t)(wid * QBLK + r32) * ldq + hi * 32;
#pragma unroll
    for (int d0 = 0; d0 < NQ; ++d0) qr[d0] = *reinterpret_cast<const bf16x8*>(Qw + (d0 >> 2) * 64 + (d0 & 3) * 8);
    if constexpr (QPREP) {
        static_assert(!QPREP || DK == 192, "QPREP: MLA head layout");
        float ssn = 0.f, ssp = 0.f;
#pragma unroll
        for (int d0 = 0; d0 < 12; ++d0)
#pragma unroll
            for (int e = 0; e < 8; ++e) { const float x = bf1((bf16)qr[d0][e]); if (d0 < 8) ssn += x * x; else ssp += x * x; }
        const float rn = rsq(half_sum(ssn) * (1.f / 128.f) + EPS) * SC_MLA, rp = rsq(half_sum(ssp) * (1.f / 64.f) + EPS) * SC_MLA;
        const int prow = q0 + wid * QBLK + r32;
#pragma unroll
        for (int d0 = 0; d0 < 12; ++d0) { const int col = (d0 >> 2) * 64 + hi * 32 + (d0 & 3) * 8;
            const f32x4 ga = *(const f32x4*)(qp.g + col), gb = *(const f32x4*)(qp.g + col + 4);
            float y[8];
#pragma unroll
            for (int e = 0; e < 8; ++e) y[e] = bf1((bf16)qr[d0][e]) * (d0 < 8 ? rn : rp) * (e < 4 ? ga[e] : gb[e - 4]);
            if (d0 >= 8) { const int i0 = (d0 & 3) * 8;
                const f32x4 ca = *(const f32x4*)(qp.rc + (size_t)prow * 32 + i0), cb = *(const f32x4*)(qp.rc + (size_t)prow * 32 + i0 + 4);
                const f32x4 sa = *(const f32x4*)(qp.rs + (size_t)prow * 32 + i0), sb = *(const f32x4*)(qp.rs + (size_t)prow * 32 + i0 + 4);
#pragma unroll
                for (int e = 0; e < 8; ++e) { auto rr = __builtin_amdgcn_permlane32_swap(__float_as_uint(y[e]), __float_as_uint(y[e]), false, false);
                    const float yp = __uint_as_float(hi ? rr[0] : rr[1]); const float c = e < 4 ? ca[e] : cb[e - 4], sn = e < 4 ? sa[e] : sb[e - 4];
                    y[e] = hi ? (yp * sn + y[e] * c) : (y[e] * c - yp * sn); } }
            u32x4 w; w.x = cvt_pk_bf16(y[0], y[1]); w.y = cvt_pk_bf16(y[2], y[3]); w.z = cvt_pk_bf16(y[4], y[5]); w.w = cvt_pk_bf16(y[6], y[7]);
            qr[d0] = __builtin_bit_cast(bf16x8, w); }
    }
    const LAS char* vrd = V_lds + v_rd_base(lane);
    const LAS char* krd[4];
#pragma unroll
    for (int j = 0; j < 4; ++j) krd[j] = K_lds + kaddr<RB>(r32, 0, 4 * hi + j);
    const int NT = q0 / KVBLK + 4;
    const int cw = q0 / KVBLK + (wid >> 1);
    const int tq = q0 + wid * QBLK + r32 + 64 - 4 * hi;
#define POST(P0, P1, jj) do { if ((jj) > cw) { float ni_ = -1e30f; asm volatile("" : "+v"(ni_));     \
        _Pragma("unroll") for (int r = 0; r < 16; ++r) { P0[r] = ni_; P1[r] = ni_; } } \
    else if (BIAS && (jj) >= cw - 2) { const int tb_ = tq - 64 * (jj); \
        _Pragma("unroll") for (int r = 0; r < 16; ++r) { const int kk_ = (r & 3) + 8 * (r >> 2); P0[r] += tbl[tb_ - kk_]; P1[r] += tbl[tb_ - kk_ - 32]; } } } while (0)
#define ROWMAX(P0, P1) ({ float a_ = fmaxf(fmaxf(P0[0], P0[1]), P1[0]), b_ = fmaxf(fmaxf(P0[2], P0[3]), P1[1]); a_ = fmaxf(fmaxf(a_, P1[2]), P1[3]); \
    _Pragma("unroll") for (int r = 4; r < 16; r += 4) { a_ = fmaxf(fmaxf(a_, P0[r]), P0[r + 1]); b_ = fmaxf(fmaxf(b_, P0[r + 2]), P0[r + 3]); a_ = fmaxf(fmaxf(a_, P1[r]), P1[r + 1]); b_ = fmaxf(fmaxf(b_, P1[r + 2]), P1[r + 3]); } \
    float m_ = fmaxf(a_, b_); auto rr_ = __builtin_amdgcn_permlane32_swap(__float_as_uint(m_), __float_as_uint(m_), false, false); fmaxf(__uint_as_float(rr_[0]), __uint_as_float(rr_[1])); })
    f32x16 pA0, pA1, pB0, pB1; u32x4 pw[4];
    WAIT_BAR();
    { pA0 = f32x16{}; pA1 = f32x16{};
#pragma unroll
      for (int d0 = 0; d0 < NQ; ++d0) { const bf16x8 b0 = *(const LAS bf16x8*)(krd[d0 & 3] + (d0 >> 2) * 128), b1 = *(const LAS bf16x8*)(krd[d0 & 3] + (d0 >> 2) * 128 + 32 * RB);
          pA0 = __builtin_amdgcn_mfma_f32_32x32x16_bf16(b0, qr[d0], pA0, 0, 0, 0); pA1 = __builtin_amdgcn_mfma_f32_32x32x16_bf16(b1, qr[d0], pA1, 0, 0, 0); }
      POST(pA0, pA1, 0);
      if constexpr (NOMAX) m_reg = 0.f; else m_reg = ROWMAX(pA0, pA1);
#pragma unroll
      for (int r = 0; r < 16; ++r) { pA0[r] = __builtin_amdgcn_exp2f(NOMAX ? pA0[r] : pA0[r] - m_reg); pA1[r] = __builtin_amdgcn_exp2f(NOMAX ? pA1[r] : pA1[r] - m_reg); } }
    f32x16 negm;
    if constexpr (NEGM) {
#pragma unroll
        for (int r = 0; r < 16; ++r) negm[r] = -m_reg;
        asm volatile("" : "+v"(negm)); }
    int s_prev = 0, s_cur = 1, s_next = 2;
#define ROT() do { const int t_ = s_prev; s_prev = s_cur; s_cur = s_next; s_next = t_; } while (0)
    unsigned ta0, ta1;
#define SLICE(Y0, Y1, s_) do { constexpr int g_ = (s_) >> 1, bs_ = (g_ & 1) * 8 + ((s_) & 1) * 4; \
        const float y0_ = (g_ < 2) ? Y0[bs_] : Y1[bs_], y1_ = (g_ < 2) ? Y0[bs_ + 1] : Y1[bs_ + 1], y2_ = (g_ < 2) ? Y0[bs_ + 2] : Y1[bs_ + 2], y3_ = (g_ < 2) ? Y0[bs_ + 3] : Y1[bs_ + 3]; \
        sacc0 += y0_; sacc1 += y1_; sacc0 += y2_; sacc1 += y3_; \
        if (((s_) & 1) == 0) { ta0 = cvt_pk_bf16(y0_, y1_); ta1 = cvt_pk_bf16(y2_, y3_); } \
        else { const unsigned tb0_ = cvt_pk_bf16(y0_, y1_), tb1_ = cvt_pk_bf16(y2_, y3_); \
               pw[g_] = (u32x4){ta0, ta1, tb0_, tb1_}; } } while (0)
#define PIN(x) asm volatile("" : "+v"(x))
#define KFRAG(i_) (*(const LAS bf16x8*)(krd[((i_) >> 1) & 3] + kso_ + ((i_) >> 3) * 128 + ((i_) & 1) * 32 * RB))
#define VLO(i_) vtr(vb_ + v_rd_off((i_) & 3, (i_) >> 2, 0))
#define VHI(i_) vtr(vb_ + v_rd_off((i_) & 3, (i_) >> 2, 1))
#define EXPX(XV, e_) XV[e_] = __builtin_amdgcn_exp2f((NEGM || NOMAX) ? XV[e_] : XV[e_] - m_reg)
#define PVX(D0, XV, B_, vba) do { \
        const s16x4 l0_ = tr_read<v_rd_off(D0, 0, 0)>(vba), h0_ = tr_read<v_rd_off(D0, 0, 1)>(vba), l1_ = tr_read<v_rd_off(D0, 1, 0)>(vba), h1_ = tr_read<v_rd_off(D0, 1, 1)>(vba); \
        const s16x4 l2_ = tr_read<v_rd_off(D0, 2, 0)>(vba), h2_ = tr_read<v_rd_off(D0, 2, 1)>(vba), l3_ = tr_read<v_rd_off(D0, 3, 0)>(vba), h3_ = tr_read<v_rd_off(D0, 3, 1)>(vba); \
        asm volatile("s_waitcnt lgkmcnt(0)" ::: "memory"); SBAR(); \
        o[D0] = __builtin_amdgcn_mfma_f32_32x32x16_bf16(__builtin_bit_cast(bf16x8, pw[0]), (bf16x8){l0_[0], l0_[1], l0_[2], l0_[3], h0_[0], h0_[1], h0_[2], h0_[3]}, o[D0], 0, 0, 0); EXPX(XV, B_ + 0); EXPX(XV, B_ + 1); PIN(XV); SBAR(); \
        o[D0] = __builtin_amdgcn_mfma_f32_32x32x16_bf16(__builtin_bit_cast(bf16x8, pw[1]), (bf16x8){l1_[0], l1_[1], l1_[2], l1_[3], h1_[0], h1_[1], h1_[2], h1_[3]}, o[D0], 0, 0, 0); EXPX(XV, B_ + 2); EXPX(XV, B_ + 3); PIN(XV); SBAR(); \
        o[D0] = __builtin_amdgcn_mfma_f32_32x32x16_bf16(__builtin_bit_cast(bf16x8, pw[2]), (bf16x8){l2_[0], l2_[1], l2_[2], l2_[3], h2_[0], h2_[1], h2_[2], h2_[3]}, o[D0], 0, 0, 0); EXPX(XV, B_ + 4); EXPX(XV, B_ + 5); PIN(XV); SBAR(); \
        o[D0] = __builtin_amdgcn_mfma_f32_32x32x16_bf16(__builtin_bit_cast(bf16x8, pw[3]), (bf16x8){l3_[0], l3_[1], l3_[2], l3_[3], h3_[0], h3_[1], h3_[2], h3_[3]}, o[D0], 0, 0, 0); EXPX(XV, B_ + 6); EXPX(XV, B_ + 7); PIN(XV); SBAR(); } while (0)
#define TRF(i_, vba) do { tl_[i_] = tr_read<v_rd_off((i_) >> 2, (i_) & 3, 0)>(vba); th_[i_] = tr_read<v_rd_off((i_) >> 2, (i_) & 3, 1)>(vba); } while (0)
#define PVM(i_, XV, B_, vba) do { \
        if ((i_) + 2 < 16) { TRF(((i_) + 2 < 16 ? (i_) + 2 : 15), vba); asm volatile("s_waitcnt lgkmcnt(4)" ::: "memory"); } \
        else if ((i_) + 1 < 16) asm volatile("s_waitcnt lgkmcnt(2)" ::: "memory"); else asm volatile("s_waitcnt lgkmcnt(0)" ::: "memory"); \
        SBAR(); \
        o[(i_) >> 2] = __builtin_amdgcn_mfma_f32_32x32x16_bf16(__builtin_bit_cast(bf16x8, pw[(i_) & 3]), (bf16x8){tl_[i_][0], tl_[i_][1], tl_[i_][2], tl_[i_][3], th_[i_][0], th_[i_][1], th_[i_][2], th_[i_][3]}, o[(i_) >> 2], 0, 0, 0); \
        EXPX(XV, B_); EXPX(XV, B_ + 1); PIN(XV); SBAR(); } while (0)
#define STEP(X0, X1, Y0, Y1, jj, HASNEXT) do { \
        const int kso_ = s_cur * KSLOT; const LAS char* vb_ = vrd + s_prev * SHM_V; \
        float sacc0 = 0.f, sacc1 = 0.f; \
        bf16x8 kf_[NM]; s16x4 vl_[16], vh_[16]; \
        SBAR(); \
        kf_[0] = KFRAG(0); kf_[1] = KFRAG(1); kf_[2] = KFRAG(2); SBAR(); \
          \
        _Pragma("unroll") for (int i_ = 0; i_ < NM; ++i_) { const int d0_ = i_ >> 1; \
            if (i_ + 3 < NM) kf_[i_ + 3] = KFRAG(i_ + 3); \
            if ((i_ & 1) == 0) X0 = __builtin_amdgcn_mfma_f32_32x32x16_bf16(kf_[i_], qr[d0_], (d0_ == 0) ? (NEGM ? negm : f32x16{}) : X0, 0, 0, 0); \
            else               X1 = __builtin_amdgcn_mfma_f32_32x32x16_bf16(kf_[i_], qr[d0_], (d0_ == 0) ? (NEGM ? negm : f32x16{}) : X1, 0, 0, 0); \
            if ((0 * NM) / 8 == i_) SLICE(Y0, Y1, 0); if ((1 * NM) / 8 == i_) SLICE(Y0, Y1, 1); if ((2 * NM) / 8 == i_) SLICE(Y0, Y1, 2); if ((3 * NM) / 8 == i_) SLICE(Y0, Y1, 3); \
            if ((4 * NM) / 8 == i_) SLICE(Y0, Y1, 4); if ((5 * NM) / 8 == i_) SLICE(Y0, Y1, 5); if ((6 * NM) / 8 == i_) SLICE(Y0, Y1, 6); if ((7 * NM) / 8 == i_) SLICE(Y0, Y1, 7); \
            PIN(sacc0); PIN(sacc1); SBAR(); } \
        l_reg += sacc0 + sacc1; \
        POST(X0, X1, jj); \
          \
        bool resc_ = false; \
        if constexpr (!NOMAX) { const float rm_ = ROWMAX(X0, X1); \
          if constexpr (NEGM) {              \
            if (__builtin_expect(__any(rm_ > THR), 0)) { const float dl_ = fmaxf(rm_, 0.f); const float al_ = __builtin_amdgcn_exp2f(-dl_); m_reg += dl_; l_reg *= al_; \
                _Pragma("unroll") for (int r = 0; r < 16; ++r) { X0[r] -= dl_; X1[r] -= dl_; negm[r] = -m_reg; } \
                { const int l2_ = lane_id(); if ((l2_ >> 5) == 0) al_l[l2_ & 31] = al_; } resc_ = true; } \
          } else { \
            if (__builtin_expect(__any(rm_ - m_reg > THR), 0)) { const float mn_ = fmaxf(m_reg, rm_); const float al_ = __builtin_amdgcn_exp2f(m_reg - mn_); m_reg = mn_; l_reg *= al_; \
                { const int l2_ = lane_id(); if ((l2_ >> 5) == 0) al_l[l2_ & 31] = al_; } resc_ = true; } } } \
        if (HASNEXT) DMA_TILE(s_next);     \
        PIN(X0); PIN(X1); SBAR(); \
        if constexpr (ILB) { \
        vl_[0] = VLO(0); vh_[0] = VHI(0); vl_[1] = VLO(1); vh_[1] = VHI(1); vl_[2] = VLO(2); vh_[2] = VHI(2); SBAR(); \
          \
        _Pragma("unroll") for (int i_ = 0; i_ < 16; ++i_) { const int ks_ = i_ >> 2, d0_ = i_ & 3; \
            if (i_ + 3 < 16) { vl_[i_ + 3] = VLO(i_ + 3); vh_[i_ + 3] = VHI(i_ + 3); } \
            const bf16x8 vf_ = (bf16x8){vl_[i_][0], vl_[i_][1], vl_[i_][2], vl_[i_][3], vh_[i_][0], vh_[i_][1], vh_[i_][2], vh_[i_][3]}; \
            o[d0_] = __builtin_amdgcn_mfma_f32_32x32x16_bf16(__builtin_bit_cast(bf16x8, pw[ks_]), vf_, o[d0_], 0, 0, 0); \
            if (i_ < 8) { X0[2 * i_] = __builtin_amdgcn_exp2f(NEGM ? X0[2 * i_] : X0[2 * i_] - m_reg); X0[2 * i_ + 1] = __builtin_amdgcn_exp2f(NEGM ? X0[2 * i_ + 1] : X0[2 * i_ + 1] - m_reg); PIN(X0); } \
            else { X1[2 * i_ - 16] = __builtin_amdgcn_exp2f(NEGM ? X1[2 * i_ - 16] : X1[2 * i_ - 16] - m_reg); X1[2 * i_ - 15] = __builtin_amdgcn_exp2f(NEGM ? X1[2 * i_ - 15] : X1[2 * i_ - 15] - m_reg); PIN(X1); } \
            SBAR(); } \
        } else { \
        const int vba_ = (int)(unsigned)(uintptr_t)vrd + s_prev * SHM_V; \
        s16x4 tl_[16], th_[16]; \
        TRF(0, vba_); TRF(1, vba_); \
        PVM(0, X0, 0, vba_); PVM(1, X0, 2, vba_); PVM(2, X0, 4, vba_); PVM(3, X0, 6, vba_); PVM(4, X0, 8, vba_); PVM(5, X0, 10, vba_); PVM(6, X0, 12, vba_); PVM(7, X0, 14, vba_); \
        PVM(8, X1, 0, vba_); PVM(9, X1, 2, vba_); PVM(10, X1, 4, vba_); PVM(11, X1, 6, vba_); PVM(12, X1, 8, vba_); PVM(13, X1, 10, vba_); PVM(14, X1, 12, vba_); PVM(15, X1, 14, vba_); } \
        if (resc_) { asm volatile("s_waitcnt lgkmcnt(0)" ::: "memory"); \
            const int h2_ = lane_id() >> 5;     \
            _Pragma("unroll") for (int d = 0; d < 4; ++d) _Pragma("unroll") for (int r = 0; r < 16; ++r) o[d][r] *= al_l[crow(r, h2_)]; } \
        WAIT_BAR(); ROT(); } while (0)
    for (int j = 1; j + 1 < NT; j += 2) {
        STEP(pB0, pB1, pA0, pA1, j, true);
        STEP(pA0, pA1, pB0, pB1, j + 1, true);
    }
    STEP(pB0, pB1, pA0, pA1, NT - 1, false);
    { float sacc0 = 0.f, sacc1 = 0.f;
      SLICE(pB0, pB1, 0); SLICE(pB0, pB1, 1); SLICE(pB0, pB1, 2); SLICE(pB0, pB1, 3); SLICE(pB0, pB1, 4); SLICE(pB0, pB1, 5); SLICE(pB0, pB1, 6); SLICE(pB0, pB1, 7);
      l_reg += sacc0 + sacc1;
      const LAS char* vb_ = vrd + s_prev * SHM_V;
#pragma unroll
      for (int i_ = 0; i_ < 16; ++i_) { const int ks_ = i_ >> 2, d0_ = i_ & 3;
          const s16x4 vl_ = vtr(vb_ + v_rd_off(d0_, ks_, 0)), vh_ = vtr(vb_ + v_rd_off(d0_, ks_, 1));
          const bf16x8 vf_ = (bf16x8){vl_[0], vl_[1], vl_[2], vl_[3], vh_[0], vh_[1], vh_[2], vh_[3]};
          o[d0_] = __builtin_amdgcn_mfma_f32_32x32x16_bf16(__builtin_bit_cast(bf16x8, pw[ks_]), vf_, o[d0_], 0, 0, 0); } }
    l_reg = half_sum(l_reg);
    { const int l3_ = lane_id(); if ((l3_ >> 5) == 0) li_l[l3_ & 31] = l_reg; } asm volatile("s_waitcnt lgkmcnt(0)" ::: "memory");
    { const int le = lane_id(), hie = le >> 5;
      float rl[16];
#pragma unroll
      for (int r = 0; r < 16; ++r) rl[r] = __builtin_amdgcn_rcpf(li_l[(r & 3) + 8 * (r >> 2) + 4 * hie]);
      if constexpr (!OUTF32) store_o_staged<false>(o, rl, K_lds + wid * 8192, nullptr, Ob + (size_t)(wid * QBLK) * ldo, ldo, le);
      else {
#pragma unroll
        for (int d0 = 0; d0 < 4; ++d0)
#pragma unroll
            for (int r = 0; r < 16; ++r) o[d0][r] *= rl[r];
        float* so = Of + (size_t)wid * 4096 + le * 4;
#pragma unroll
        for (int d0 = 0; d0 < 4; ++d0)
#pragma unroll
            for (int rq = 0; rq < 4; ++rq) *(f32x4*)(so + (4 * d0 + rq) * 256) = (f32x4){o[d0][4 * rq], o[d0][4 * rq + 1], o[d0][4 * rq + 2], o[d0][4 * rq + 3]};
        volatile LAS unsigned* flg = (volatile LAS unsigned*)(lds + L_FLAG);
        asm volatile("s_waitcnt vmcnt(0)" ::: "memory");
        __syncthreads();
        if (wid == 0 && le == 0) { __builtin_amdgcn_fence(__ATOMIC_RELEASE, "agent");
            const unsigned old = __hip_atomic_fetch_add(fin.cnt, 1u, __ATOMIC_RELAXED, __HIP_MEMORY_SCOPE_AGENT);
            if (old & 1u) __builtin_amdgcn_fence(__ATOMIC_ACQUIRE, "agent");
            flg[8] = old & 1u; }
        __syncthreads();
        if (flg[8]) {
            const float* po = fin.other + (size_t)wid * 4096 + le * 4;
            f32x4 pv[4][4];
#pragma unroll
            for (int d0 = 0; d0 < 4; ++d0)
#pragma unroll
                for (int rq = 0; rq < 4; ++rq) pv[d0][rq] = *(const f32x4*)(po + (4 * d0 + rq) * 256);
            float gs[4];
#pragma unroll
            for (int d0 = 0; d0 < 4; ++d0) gs[d0] = fin.gsub[32 * d0 + (le & 31)] * fin.omli;
#pragma unroll
            for (int r = 0; r < 16; ++r) { float ss = 0.f;
#pragma unroll
                for (int d0 = 0; d0 < 4; ++d0) { const float pp = pv[d0][r >> 2][r & 3]; const float dv = fin.own_first ? o[d0][r] - fin.lam * pp : pp - fin.lam * o[d0][r]; o[d0][r] = dv; ss += dv * dv; }
                ss += swz<1>(ss); ss += swz<2>(ss); ss += swz<4>(ss); ss += swz<8>(ss); ss += swz<16>(ss);
                const float rn = rsq(ss * (1.f / 128.f) + EPS);
#pragma unroll
                for (int d0 = 0; d0 < 4; ++d0) o[d0][r] = o[d0][r] * rn * gs[d0]; }
            store_o_staged<false>(o, nullptr, K_lds + wid * 8192, nullptr, Ob + (size_t)(wid * QBLK) * ldo, ldo, le);
        }
      } }
    asm volatile("s_waitcnt lgkmcnt(0)\n\ts_barrier" ::: "memory");
#undef DMA_TILE
#undef WAIT_BAR
#undef POST
#undef ROWMAX
#undef ROT
#undef SLICE
#undef STEP
#undef PVX
#undef PVM
#undef TRF
#undef EXPX
#undef PIN
#undef KFRAG
#undef VLO
#undef VHI
}

__device__ __forceinline__ void sb_unit(LAS char* lds, const bf16* Qb, int ldq, const KVSrc kv, int q0, bf16* Ob, int ldo, const int wv) {
    constexpr int DK = 128, SHM_K = 64 * DK * 2;
    int tid = MYTID(wv); asm volatile("" : "+v"(tid));
    const int lane = tid & 63, r32 = lane & 31, hi = lane >> 5; const int wid = __builtin_amdgcn_readfirstlane(tid >> 6);
    LAS char* V_lds = lds + L_V; LAS char* K_lds = lds + L_K;
    volatile LAS unsigned* flags = (volatile LAS unsigned*)(lds + L_FLAG);
    f32x16 o[4] = {}; bf16x8 qr[8];
    const bf16* Qw = Qb + (size_t)(wid * QBLK + r32) * ldq + hi * 32;
#pragma unroll
    for (int d0 = 0; d0 < 8; ++d0) qr[d0] = *reinterpret_cast<const bf16x8*>(Qw + (d0 >> 2) * 64 + (d0 & 3) * 8);
    Stager<128, 128> st; st.init(kv, tid);
    const int vb0 = (int)(unsigned)(uintptr_t)V_lds + v_rd_base(lane);
    const int cw = q0 / KVBLK + (wid >> 1);
    const int lim = 32 * (wid & 1) + r32;
    float R = 0.f; bool alive = true;
    bf16x8 vs0, vs1, ks0, ks1;
    int j = q0 / KVBLK + 3;
    vs0 = st.ldv0(j); vs1 = st.ldv1(j); ks0 = st.ldk(0, j); ks1 = st.ldk(1, j);
    for (; j >= 0; --j) {
        __syncthreads();
        *(LAS bf16x8*)(V_lds + st.vst0) = vs0; *(LAS bf16x8*)(V_lds + st.vst1) = vs1; *(LAS bf16x8*)(K_lds + st.klds[0]) = ks0; *(LAS bf16x8*)(K_lds + st.klds[1]) = ks1;
        __syncthreads();
        if (j > 0) { const int jn = j - 1;
            vs0 = st.ldv0(jn); vs1 = st.ldv1(jn); ks0 = st.ldk(0, jn); ks1 = st.ldk(1, jn); }
        if (j <= cw && alive) {
            f32x16 z0, z1, m0, m1;
            qkt<128, 8>(z0, z1, K_lds, qr, K_lds, r32, hi);
#pragma unroll
            for (int r = 0; r < 16; ++r) { z0[r] *= SC_SB; z1[r] *= SC_SB; }
            const bool diag = (j == cw);
#pragma unroll
            for (int r = 0; r < 16; ++r) {
                { const float zl = z0[r], e = __builtin_amdgcn_exp2f(-fabsf(zl)); const float l1p = __builtin_amdgcn_logf(1.f + e);
                  m0[r] = -(fmaxf(zl, 0.f) + l1p); }
                { const float zl = z1[r], e = __builtin_amdgcn_exp2f(-fabsf(zl)); const float l1p = __builtin_amdgcn_logf(1.f + e);
                  m1[r] = -(fmaxf(zl, 0.f) + l1p); }
            }
            if (diag) {
#pragma unroll
                for (int r = 0; r < 16; ++r) { const int kk = crow(r, hi);
                    if (!(kk < lim)) { m0[r] = 0.f; z0[r] = -1e30f; }
                    if (!(kk + 32 < lim)) { m1[r] = 0.f; z1[r] = -1e30f; } }
            }
            float Glo[8], Ghi[8];
#pragma unroll
            for (int i = 0; i < 8; ++i) { const float gs = (i < 4) ? (m0[4 * i] + m0[4 * i + 1]) + (m0[4 * i + 2] + m0[4 * i + 3])
                                                                   : (m1[4 * (i - 4)] + m1[4 * (i - 4) + 1]) + (m1[4 * (i - 4) + 2] + m1[4 * (i - 4) + 3]);
                auto rr = __builtin_amdgcn_permlane32_swap(__float_as_uint(gs), __float_as_uint(gs), false, false);
                Glo[i] = __uint_as_float(rr[0]); Ghi[i] = __uint_as_float(rr[1]); }
            float sa_odd = 0.f, sa_even = Ghi[7]; float base[8];
            base[7] = R + (hi ? sa_odd : sa_even);
#pragma unroll
            for (int i = 6; i >= 0; --i) { sa_odd = sa_even + Glo[i + 1]; sa_even = sa_odd + Ghi[i]; base[i] = R + (hi ? sa_odd : sa_even); }
            const float total = sa_even + Glo[0];
#pragma unroll
            for (int i = 0; i < 8; ++i) {
                if (i < 4) { const int b = 4 * i; float bt = base[i];
                    const float w3 = __builtin_amdgcn_exp2f(z0[b + 3] + m0[b + 3] + bt); bt += m0[b + 3];
                    const float w2 = __builtin_amdgcn_exp2f(z0[b + 2] + m0[b + 2] + bt); bt += m0[b + 2];
                    const float w1 = __builtin_amdgcn_exp2f(z0[b + 1] + m0[b + 1] + bt); bt += m0[b + 1];
                    const float w0 = __builtin_amdgcn_exp2f(z0[b] + m0[b] + bt);
                    z0[b] = w0; z0[b + 1] = w1; z0[b + 2] = w2; z0[b + 3] = w3; }
                else { const int b = 4 * (i - 4); float bt = base[i];
                    const float w3 = __builtin_amdgcn_exp2f(z1[b + 3] + m1[b + 3] + bt); bt += m1[b + 3];
                    const float w2 = __builtin_amdgcn_exp2f(z1[b + 2] + m1[b + 2] + bt); bt += m1[b + 2];
                    const float w1 = __builtin_amdgcn_exp2f(z1[b + 1] + m1[b + 1] + bt); bt += m1[b + 1];
                    const float w0 = __builtin_amdgcn_exp2f(z1[b] + m1[b] + bt);
                    z1[b] = w0; z1[b + 1] = w1; z1[b + 2] = w2; z1[b + 3] = w3; }
            }
            R += total;
            bf16x8 pa0, pa1, pa2, pa3;
            PK4(z0, 0, pa0); PK4(z0, 8, pa1); PK4(z1, 0, pa2); PK4(z1, 8, pa3);
            SBAR();
            pv_d0(o, vb0, pa0, pa1, pa2, pa3);
            alive = __any(R > SB_DEAD);
        }
        if (lane == 0) flags[wid] = alive ? 1u : 0u;
        __syncthreads();
        unsigned any_alive = 0;
#pragma unroll
        for (int w = 0; w < NW; ++w) any_alive |= flags[w];
        if (!any_alive) break;
    }
    { const int le = lane_id(); store_o_staged<false>(o, nullptr, K_lds + wid * 8192, nullptr, Ob + (size_t)(wid * QBLK) * ldo, ldo, le); }
    __syncthreads();
}
#undef PK4
#undef SBAR
}

typedef GAS unsigned gu32;
#define RLX_AGENT __ATOMIC_RELAXED, __HIP_MEMORY_SCOPE_AGENT
#define XB_TMO      128
#define XB_XCNT(j)  (256  + 64 * (j))
#define XB_XSUB(j)  (1280 + 64 * (j))
#define XB_XGEN(j)  (2304 + 64 * (j))
#define XB_TOP      3328
#define XB_TOPGEN   3392
#define XCD_BAR_WORDS 3456
#define XB_SPIN_CAP (1u << 18)
__device__ __forceinline__ unsigned xb_ld(unsigned* p)              { return __hip_atomic_load(p, __ATOMIC_RELAXED, __HIP_MEMORY_SCOPE_AGENT); }
__device__ __forceinline__ unsigned xb_add(unsigned* p, unsigned v) { return __hip_atomic_fetch_add(p, v, __ATOMIC_RELAXED, __HIP_MEMORY_SCOPE_AGENT); }
__device__ __forceinline__ unsigned xb_xcc_id() { return (unsigned)__builtin_amdgcn_s_getreg((3 << 11) | 20) & 0xFu; }
#define XB_SPIN(cond, bar) do { unsigned _sp = 0; while (cond) { __builtin_amdgcn_s_sleep(1); \
    if ((++_sp & 255u) == 0u) { if (xb_ld(&(bar)[XB_TMO])) break; if (_sp > XB_SPIN_CAP) { atomicAdd(&(bar)[XB_TMO], 1u); break; } } } } while (0)
struct XcdBarrier { unsigned* bar; unsigned x; volatile LAS unsigned* st; };
__device__ __forceinline__ XcdBarrier xcd_barrier_post(unsigned* bar, volatile LAS unsigned* st, const int wv) {
    XcdBarrier b; b.bar = bar; b.x = xb_xcc_id(); b.st = st;
    if (MYTID(wv) == 0) (void)xb_add(&bar[XB_XCNT(b.x)], 1u);
    return b;
}
__device__ __forceinline__ void xcd_barrier_complete(unsigned* bar, unsigned x, unsigned& nloc, unsigned& nx) {
    const unsigned G = gridDim.x * gridDim.y * gridDim.z;
    unsigned sum, cnt, mine, sp = 0u;
    for (;;) {
        sum = 0u; cnt = 0u; mine = 0u;
#pragma unroll
        for (unsigned j = 0; j < 16; ++j) { const unsigned c = xb_ld(&bar[XB_XCNT(j)]); sum += c; cnt += (c > 0u) ? 1u : 0u; mine = (j == x) ? c : mine; }
        if (sum == G) break;
        __builtin_amdgcn_s_sleep(1);
        if ((++sp & 255u) == 0u) { if (xb_ld(&bar[XB_TMO])) break; if (sp > XB_SPIN_CAP) { atomicAdd(&bar[XB_TMO], 1u); break; } }
    }
    nloc = mine > 0u ? mine : 1u; nx = cnt > 0u ? cnt : 1u;
}
__device__ __forceinline__ void xcd_barrier(const XcdBarrier& b, const int wv) {
    asm volatile("s_waitcnt vmcnt(0)" ::: "memory");
    __syncthreads();
    if (MYTID(wv) == 0) {
        GAS unsigned* barg_ = (GAS unsigned*)b.bar; asm volatile("" : "+s"(barg_)); unsigned* bar = (unsigned*)barg_; unsigned bx_ = b.x; asm volatile("" : "+s"(bx_));
        __builtin_amdgcn_s_waitcnt(0);
        unsigned nloc = b.st[0], nx = b.st[1];
        if (nloc == 0u) { xcd_barrier_complete(bar, bx_, nloc, nx); b.st[0] = nloc; b.st[1] = nx; }
        const unsigned old = xb_add(&bar[XB_XSUB(bx_)], 1u);
        const unsigned gen = old / nloc;
        if (old + 1u == (gen + 1u) * nloc) {
            __builtin_amdgcn_fence(__ATOMIC_RELEASE, "agent");
            asm volatile("s_waitcnt vmcnt(0)" ::: "memory");
            const unsigned og = xb_add(&bar[XB_TOP], 1u);
            const unsigned tg = og / nx;
            if (og + 1u == (tg + 1u) * nx) xb_add(&bar[XB_TOPGEN], 1u);
            else XB_SPIN(xb_ld(&bar[XB_TOPGEN]) == tg, bar);
            __builtin_amdgcn_fence(__ATOMIC_ACQUIRE, "agent");
            xb_add(&bar[XB_XGEN(bx_)], 1u);
            asm volatile("s_waitcnt vmcnt(0)" ::: "memory");
        } else {
            XB_SPIN(xb_ld(&bar[XB_XGEN(bx_)]) == gen, bar);
            __builtin_amdgcn_fence(__ATOMIC_ACQUIRE, "agent");
            asm volatile("s_waitcnt vmcnt(0)" ::: "memory");
        }
    }
    __syncthreads();
}

struct Args { const float* in[20]; float* out; unsigned char* ws; int ph_lo, ph_hi, dup, pad; };
enum { I_X = 0, I_C, I_WADA, I_BADA, I_GMIX, I_GMLP, I_WIN, I_DQKG, I_DLAM, I_DSUB, I_T5, I_MQG, I_MKVG, I_WQUP, I_WKVUP, I_MQKG, I_WBR, I_WOUT, I_WM1, I_WM2 };
constexpr int NWAVES = 8, NTHR = 512;
constexpr int PH_PER_LAYER = 12, NPHASE = 1 + DEPTH * PH_PER_LAYER;

struct ConvDesc { const float* src; int N; bf16* dst; int ldk; const float* gk; const float* sk; };
__device__ __forceinline__ ConvDesc conv_make(const float* W, int K, int N, bf16* WT, int row_off, int item, int lane, int ldk, const float* g = nullptr, const float* sc = nullptr) {
    const int nblk = N / 32, kb = item / nblk, nb = item % nblk, k0 = 64 * kb, n0 = 32 * nb;
    ConvDesc d; d.src = W + (size_t)(k0 + (lane >> 3)) * N + n0 + 4 * (lane & 7); d.N = N; d.dst = WT + (size_t)(row_off + n0) * ldk + k0; d.ldk = ldk;
    d.gk = g ? g + k0 : nullptr; d.sk = sc ? sc + k0 : nullptr; return d;
}
__device__ __forceinline__ void conv_load(const ConvDesc& d, f32x4 (&v)[8]) {
#pragma unroll
    for (int i = 0; i < 8; ++i) v[i] = __builtin_nontemporal_load((const f32x4*)(d.src + (size_t)(8 * i) * d.N));
}
__device__ __forceinline__ void conv_finish(const ConvDesc& d, const f32x4 (&v)[8], LAS float* scr, int lane, const float* shk = nullptr, float* bacc = nullptr) {
#pragma unroll
    for (int i = 0; i < 8; ++i) { LAS float* p = scr + (8 * i + (lane >> 3)) * 33 + 4 * (lane & 7); p[0] = v[i].x; p[1] = v[i].y; p[2] = v[i].z; p[3] = v[i].w; }
    asm volatile("s_waitcnt lgkmcnt(0)" ::: "memory");
    const int c = lane & 7;
    float gm[8] = {1.f, 1.f, 1.f, 1.f, 1.f, 1.f, 1.f, 1.f};
    if (d.gk) { const f32x4 g0 = *(const f32x4*)(d.gk + 8 * c), g1 = *(const f32x4*)(d.gk + 8 * c + 4); f32x4 s0 = {0.f, 0.f, 0.f, 0.f}, s1 = {0.f, 0.f, 0.f, 0.f};
        if (d.sk) { s0 = *(const f32x4*)(d.sk + 8 * c); s1 = *(const f32x4*)(d.sk + 8 * c + 4); }
#pragma unroll
        for (int e = 0; e < 4; ++e) { gm[e] = g0[e] * (1.f + s0[e]); gm[4 + e] = g1[e] * (1.f + s1[e]); } }
    float sh8[8] = {0.f, 0.f, 0.f, 0.f, 0.f, 0.f, 0.f, 0.f};
    if (bacc) { const f32x4 h0 = *(const f32x4*)(shk + 8 * c), h1 = *(const f32x4*)(shk + 8 * c + 4);
#pragma unroll
        for (int e = 0; e < 4; ++e) { sh8[e] = h0[e]; sh8[4 + e] = h1[e]; } }
#pragma unroll
    for (int j = 0; j < 4; ++j) { const int n = (lane >> 3) + 8 * j; const LAS float* sp = scr + (8 * c) * 33 + n;
        if (bacc) bacc[j] += ((sp[0 * 33] * sh8[0] + sp[1 * 33] * sh8[1]) + (sp[2 * 33] * sh8[2] + sp[3 * 33] * sh8[3])) + ((sp[4 * 33] * sh8[4] + sp[5 * 33] * sh8[5]) + (sp[6 * 33] * sh8[6] + sp[7 * 33] * sh8[7]));
        u32x4 o; o.x = cvt_pk_bf16(sp[0 * 33] * gm[0], sp[1 * 33] * gm[1]); o.y = cvt_pk_bf16(sp[2 * 33] * gm[2], sp[3 * 33] * gm[3]); o.z = cvt_pk_bf16(sp[4 * 33] * gm[4], sp[5 * 33] * gm[5]); o.w = cvt_pk_bf16(sp[6 * 33] * gm[6], sp[7 * 33] * gm[7]);
        *(u32x4*)(d.dst + (size_t)n * d.ldk + 8 * c) = o; }
    asm volatile("s_waitcnt lgkmcnt(0)" ::: "memory");
}

__device__ __forceinline__ void ada_item(const Args& a, unsigned char* ws, LAS unsigned char* lds, int l, int cb, int tid) {
    const int lane = tid & 63, wave = tid >> 6;
    LAS float* red = (LAS float*)lds;
    const float* cvec = a.in[I_C];
    float* modf = (float*)(ws + WS_MODF);
    const float* W = a.in[I_WADA] + (size_t)l * DM * (NMOD * DM) + cb * 256 + 4 * lane;
    f32x4 acc = {0.f, 0.f, 0.f, 0.f};
    const int kbeg = wave * 256;
#pragma unroll 32
    for (int k = 0; k < 256; ++k) { const f32x4 w = __builtin_nontemporal_load((const f32x4*)(W + (size_t)(kbeg + k) * (NMOD * DM))); const float cv = cvec[kbeg + k]; acc += w * cv; }
    *(LAS f32x4*)(red + wave * 256 + 4 * lane) = acc;
    __syncthreads();
    if (tid < 256) { float s = 0.f;
#pragma unroll
        for (int w = 0; w < 8; ++w) s += red[w * 256 + tid];
        const int j = cb * 256 + tid; modf[l * (NMOD * DM) + j] = s + a.in[I_BADA][l * (NMOD * DM) + j]; }
    asm volatile("s_waitcnt vmcnt(0)" ::: "memory");
    __syncthreads();
    if (tid == 0) { __builtin_amdgcn_fence(__ATOMIC_RELEASE, "agent"); (void)__hip_atomic_fetch_add((unsigned*)(ws + WS_CTL) + CW_ADA + 64 * l, 1u, __ATOMIC_RELAXED, __HIP_MEMORY_SCOPE_AGENT); }
}
__device__ __forceinline__ void wait_ada(unsigned char* ws, int l, int tid) {
    if (tid == 0) { unsigned* p = (unsigned*)(ws + WS_CTL) + CW_ADA + 64 * l;
        while (__hip_atomic_load(p, __ATOMIC_RELAXED, __HIP_MEMORY_SCOPE_AGENT) < 48u) __builtin_amdgcn_s_sleep(4);
        __builtin_amdgcn_fence(__ATOMIC_ACQUIRE, "agent"); }
    __syncthreads();
}
constexpr int CI_IN = (DM / 64) * (IN_COLS / 32), CI_Q = (512 / 64) * (1536 / 32), CI_KV = (256 / 64) * (2048 / 32), CI_BR1 = (1024 / 64) * (2048 / 32),
              CI_O = (DM / 64) * (DM / 32), CI_1 = (DM / 64) * (DFF / 32), CI_2 = (DFF / 64) * (DM / 32);
constexpr int CONV_PER_LAYER = CI_IN + CI_Q + CI_KV + 3 * CI_BR1 + CI_O + CI_1 + CI_2;
constexpr int CONV_CHUNK = 128, CONV_NCHUNK = (CONV_PER_LAYER + CONV_CHUNK - 1) / CONV_CHUNK;
constexpr int CONV_NDEP = CI_Q + CI_KV + 3 * CI_BR1 + CI_O + CI_2;
__device__ __forceinline__ ConvDesc conv_desc(const Args& a, unsigned char* ws, int l, int r, int lane) {
    unsigned char* wl = ws + WS_W + (size_t)l * W_LAYER;
    if (r < CI_Q) return conv_make(a.in[I_WQUP] + (size_t)l * 512 * 1536, 512, 1536, (bf16*)(wl + W_QUP), 0, r, lane, 512, a.in[I_MQG] + l * 512); r -= CI_Q;
    if (r < CI_KV) return conv_make(a.in[I_WKVUP] + (size_t)l * 256 * 2048, 256, 2048, (bf16*)(wl + W_KVUP), 0, r, lane, 256, a.in[I_MKVG] + l * 256); r -= CI_KV;
    if (r < 3 * CI_BR1) { const int n = r / CI_BR1; r -= n * CI_BR1;
        return conv_make(a.in[I_WBR] + ((size_t)l * 3 + n) * 1024 * 2048, 1024, 2048, (bf16*)(wl + W_BR) + (size_t)n * 1024, 0, r, lane, 3072); } r -= 3 * CI_BR1;
    if (r < CI_O) return conv_make(a.in[I_WOUT] + (size_t)l * DM * DM, DM, DM, (bf16*)(wl + W_OUT), 0, r, lane, DM); r -= CI_O;
    return conv_make(a.in[I_WM2] + (size_t)l * DFF * DM, DFF, DM, (bf16*)(wl + W_M2), 0, r, lane, DFF);
}
__device__ __forceinline__ void conv_item(const Args& a, unsigned char* ws, int l, int r, LAS float* scr, int lane) {
    const ConvDesc d = conv_desc(a, ws, l, r, lane); f32x4 v[8]; conv_load(d, v); conv_finish(d, v, scr, lane);
}
__device__ __forceinline__ void conv_pair(const Args& a, unsigned char* ws, int l, int r0, int r1, LAS float* scr, int lane) {
    const ConvDesc d0 = conv_desc(a, ws, l, r0, lane), d1 = conv_desc(a, ws, l, r1, lane); f32x4 v0[8], v1[8];
    conv_load(d0, v0); conv_load(d1, v1); conv_finish(d0, v0, scr, lane); conv_finish(d1, v1, scr, lane);
}
__device__ __forceinline__ void conv_quad(const Args& a, unsigned char* ws, int l, int r0, LAS float* scr, int lane) {
    const ConvDesc d0 = conv_desc(a, ws, l, r0, lane), d1 = conv_desc(a, ws, l, r0 + 1, lane), d2 = conv_desc(a, ws, l, r0 + 2, lane), d3 = conv_desc(a, ws, l, r0 + 3, lane);
    f32x4 v0[8], v1[8], v2[8], v3[8];
    conv_load(d0, v0); conv_load(d1, v1); conv_load(d2, v2); conv_load(d3, v3);
    conv_finish(d0, v0, scr, lane); conv_finish(d1, v1, scr, lane); conv_finish(d2, v2, scr, lane); conv_finish(d3, v3, scr, lane);
}
constexpr int CC_IN = IN_COLS / 32, CC_1 = DFF / 32, CONV_COLS = CC_IN + CC_1;
__device__ __forceinline__ void conv_col(const Args& a, unsigned char* ws, int l, int ci, LAS float* scr, int lane) {
    unsigned char* wl = ws + WS_W + (size_t)l * W_LAYER;
    const float* modl = (const float*)(ws + WS_MODF) + (size_t)l * (NMOD * DM);
    const bool first = ci < CC_IN; const int nb = first ? ci : ci - CC_IN, N = first ? IN_COLS : DFF, nblk = N / 32;
    const float* W = first ? a.in[I_WIN] + (size_t)l * DM * IN_COLS : a.in[I_WM1] + (size_t)l * DM * DFF;
    bf16* WT = (bf16*)(wl + (first ? W_IN : W_M1));
    const int roff = (first && 32 * nb >= SRC_PAD_AT) ? PADW : 0;
    const float* g = first ? a.in[I_GMIX] + l * DM : a.in[I_GMLP] + l * DM; const float* sc = modl + (first ? 1 : 4) * DM; const float* sh = modl + (first ? 0 : 3) * DM;
    float bacc[4] = {0.f, 0.f, 0.f, 0.f};
    for (int kb = 0; kb < DM / 64; kb += 4) {
        const ConvDesc d0 = conv_make(W, DM, N, WT, roff, kb * nblk + nb, lane, DM, g, sc), d1 = conv_make(W, DM, N, WT, roff, (kb + 1) * nblk + nb, lane, DM, g, sc);
        const ConvDesc d2 = conv_make(W, DM, N, WT, roff, (kb + 2) * nblk + nb, lane, DM, g, sc), d3 = conv_make(W, DM, N, WT, roff, (kb + 3) * nblk + nb, lane, DM, g, sc);
        f32x4 v0[8], v1[8], v2[8], v3[8];
        conv_load(d0, v0); conv_load(d1, v1); conv_load(d2, v2); conv_load(d3, v3);
        conv_finish(d0, v0, scr, lane, sh + 64 * kb, bacc); conv_finish(d1, v1, scr, lane, sh + 64 * (kb + 1), bacc); conv_finish(d2, v2, scr, lane, sh + 64 * (kb + 2), bacc); conv_finish(d3, v3, scr, lane, sh + 64 * (kb + 3), bacc);
    }
    float* bias = (float*)(ws + WS_CTL + WS_BIAS) + (size_t)l * BIAS_PER_LAYER + (first ? roff : PN) + 32 * nb;
#pragma unroll
    for (int j = 0; j < 4; ++j) { float b = bacc[j]; b += swz<1>(b); b += swz<2>(b); b += swz<4>(b); if ((lane & 7) == 0) bias[(lane >> 3) + 8 * j] = b; }
}
constexpr int PREP_CHUNK = 64, PREP_NCHUNK = (CONV_NDEP + PREP_CHUNK - 1) / PREP_CHUNK, PREP_NCOL = (CONV_COLS + NWAVES - 1) / NWAVES, PREP_ITEMS = 48 + PREP_NCHUNK + PREP_NCOL, PREP_LEAD = 100, PREP_TAIL = 64;
static_assert(PREP_LEAD <= PREP_NCHUNK, "prep order");
__device__ __forceinline__ void prep_item(const Args& a, unsigned char* ws, LAS unsigned char* lds, int l, int idx, int tid) {
    if (idx < 48) { ada_item(a, ws, lds, l, idx, tid); return; }
    int ch = idx - 48; const int lane = tid & 63, wave = tid >> 6; LAS float* scr = (LAS float*)(lds + wave * 16384);
    if (ch >= PREP_LEAD && ch < PREP_LEAD + PREP_NCOL) { wait_ada(ws, l, tid); const int ci = (ch - PREP_LEAD) * NWAVES + wave; if (ci < CONV_COLS) conv_col(a, ws, l, ci, scr, lane); __syncthreads(); return; }
    if (ch >= PREP_LEAD + PREP_NCOL) ch -= PREP_NCOL;
    const int beg = ch * PREP_CHUNK, end = (beg + PREP_CHUNK < CONV_NDEP) ? beg + PREP_CHUNK : CONV_NDEP;
    for (int r = beg + 4 * wave; r < end; r += 4 * NWAVES) { if (r + 3 < end) conv_quad(a, ws, l, r, scr, lane); else for (int q = r; q < end && q < r + 4; ++q) conv_item(a, ws, l, q, scr, lane); }
    __syncthreads();
}

__device__ __forceinline__ void prologue(const Args& a, LAS unsigned char* lds, int G, const int wv) {
    int tid = MYTID(wv); asm volatile("" : "+v"(tid));
    const int lane = tid & 63, wave = tid >> 6;
    GAS unsigned char* wsg_ = (GAS unsigned char*)a.ws; asm volatile("" : "+s"(wsg_)); unsigned char* ws = (unsigned char*)wsg_;
    for (int it = blockIdx.x; it < 48; it += G) ada_item(a, ws, lds, 0, it, tid);
    {
        float* rc = (float*)(ws + WS_ROPE); float* rs = rc + S * 32;
        for (int e = blockIdx.x * NTHR + tid; e < S * 32; e += G * NTHR) {
            const int pos = e >> 5, i = e & 31;
            const float inv = exp2f(-(float)i * (13.287712379549449f / 32.0f));
            const float ang = (float)pos * inv;
            const double rev = (double)ang * 0.15915494309189535; const float fr = (float)(rev - rint(rev));
            rc[e] = __builtin_amdgcn_cosf(fr); rs[e] = __builtin_amdgcn_sinf(fr);
        }
    }
    {
        const float* x = a.in[I_X]; bf16* XB = (bf16*)(ws + WS_ACT + A_XB); float* RQ = (float*)(ws + WS_ACT + A_RSQA);
        for (int row = blockIdx.x * NWAVES + wave; row < S; row += G * NWAVES) {
            const f32x4* xr = (const f32x4*)(x + (size_t)row * DM) + lane; f32x4 v[8]; float sq = 0.f;
#pragma unroll
            for (int j = 0; j < 8; ++j) v[j] = xr[64 * j];
            u32x2* o8 = (u32x2*)(XB + (size_t)row * DM) + lane;
#pragma unroll
            for (int j = 0; j < 8; ++j) { sq += (v[j].x * v[j].x + v[j].y * v[j].y) + (v[j].z * v[j].z + v[j].w * v[j].w);
                u32x2 w; w.x = cvt_pk_bf16(v[j].x, v[j].y); w.y = cvt_pk_bf16(v[j].z, v[j].w); o8[64 * j] = w; }
            sq = wave_sum(sq);
            if (lane < 8) RQ[(size_t)row * 8 + lane] = (lane == 0) ? sq : 0.f;
        }
    }
    {
        LAS float* scr = (LAS float*)(lds + wave * 16384);
        const int NA = 48, X = (G > NA) ? (G - NA) * NWAVES * 2 : 0;
        if ((int)blockIdx.x >= NA) for (int it = ((int)blockIdx.x - NA) * NWAVES + wave; it < X; it += (G - NA) * NWAVES) conv_item(a, ws, 0, it, scr, lane);
        for (int it = X + (int)blockIdx.x * NWAVES + wave; it < CONV_NDEP; it += G * NWAVES) conv_item(a, ws, 0, it, scr, lane);
        __syncthreads();
        wait_ada(ws, 0, tid);
        for (int ci = (int)blockIdx.x + G * wave; ci < CONV_COLS; ci += G * NWAVES) conv_col(a, ws, 0, ci, scr, lane);
    }
}

__device__ __forceinline__ void ld16f(const bf16* p, float* x) {
    const u32x4 a = *(const u32x4*)p, b = *(const u32x4*)(p + 8);
    x[0] = bf_lo(a.x); x[1] = bf_hi(a.x); x[2] = bf_lo(a.y); x[3] = bf_hi(a.y); x[4] = bf_lo(a.z); x[5] = bf_hi(a.z); x[6] = bf_lo(a.w); x[7] = bf_hi(a.w);
    x[8] = bf_lo(b.x); x[9] = bf_hi(b.x); x[10] = bf_lo(b.y); x[11] = bf_hi(b.y); x[12] = bf_lo(b.z); x[13] = bf_hi(b.z); x[14] = bf_lo(b.w); x[15] = bf_hi(b.w);
}
__device__ __forceinline__ void st16f(bf16* p, const float* x) {
    u32x4 a, b; a.x = cvt_pk_bf16(x[0], x[1]); a.y = cvt_pk_bf16(x[2], x[3]); a.z = cvt_pk_bf16(x[4], x[5]); a.w = cvt_pk_bf16(x[6], x[7]);
    b.x = cvt_pk_bf16(x[8], x[9]); b.y = cvt_pk_bf16(x[10], x[11]); b.z = cvt_pk_bf16(x[12], x[13]); b.w = cvt_pk_bf16(x[14], x[15]);
    *(u32x4*)p = a; *(u32x4*)(p + 8) = b;
}
__device__ __forceinline__ void ld8f(const bf16* p, float* x) {
    const u32x4 a = *(const u32x4*)p;
    x[0] = bf_lo(a.x); x[1] = bf_hi(a.x); x[2] = bf_lo(a.y); x[3] = bf_hi(a.y); x[4] = bf_lo(a.z); x[5] = bf_hi(a.z); x[6] = bf_lo(a.w); x[7] = bf_hi(a.w);
}
__device__ __forceinline__ void st8f(bf16* p, const float* x) {
    u32x4 a; a.x = cvt_pk_bf16(x[0], x[1]); a.y = cvt_pk_bf16(x[2], x[3]); a.z = cvt_pk_bf16(x[4], x[5]); a.w = cvt_pk_bf16(x[6], x[7]); *(u32x4*)p = a;
}

__device__ __forceinline__ void post1_phase(const Args& a, int l, int G, const int wv) {
    int tid = MYTID(wv); asm volatile("" : "+v"(tid));
    const int lane = tid & 63, wave = tid >> 6;
    GAS unsigned char* wsg_ = (GAS unsigned char*)a.ws; asm volatile("" : "+s"(wsg_)); unsigned char* ws = (unsigned char*)wsg_;
    const bf16* proj = (const bf16*)(ws + WS_ACT + A_PROJ);
    bf16* QA = (bf16*)(ws + WS_ACT + A_QA); bf16* KA = (bf16*)(ws + WS_ACT + A_KA); bf16* KPE = (bf16*)(ws + WS_ACT + A_KPE);
    const float* rc = (const float*)(ws + WS_ROPE); const float* rs = rc + S * 32;
    const float* gq = a.in[I_DQKG] + l * 128; const float* gk = gq + 64;
    const float* gkpe = a.in[I_MQKG] + l * 384 + 192 + 128;
    float gqv[16], gkv[16];
#pragma unroll
    for (int e = 0; e < 16; ++e) { gqv[e] = gq[16 * (lane & 3) + e] * SC_DA; gkv[e] = gk[16 * (lane & 3) + e]; }
    const float gpe = gkpe[lane];
    int rbeg = (int)blockIdx.x * NWAVES + wave, rend = S, rstep = G * NWAVES;
    if (G == 256) { const int b_ = (int)blockIdx.x; const int r0_ = b_ < 192 ? 26 * b_ : 4992 + 50 * (b_ - 192), nr_ = b_ < 192 ? 26 : 50; rbeg = r0_ + wave; rend = r0_ + nr_; rstep = NWAVES; }
    for (int row = rbeg; row < rend; row += rstep) {
        const bf16* P = proj + (size_t)row * PN;
        float x[16];
        { ld16f(P + C_DAQ + 16 * lane, x); float s = 0.f;
#pragma unroll
          for (int e = 0; e < 16; ++e) s += x[e] * x[e];
          s += swz<1>(s); s += swz<2>(s); const float r = rsq(s * (1.f / 64.f) + EPS);
#pragma unroll
          for (int e = 0; e < 16; ++e) x[e] = x[e] * r * gqv[e];
          st16f(QA + (size_t)row * 1024 + 16 * lane, x); }
        { ld16f(P + C_DAK + 16 * lane, x); float s = 0.f;
#pragma unroll
          for (int e = 0; e < 16; ++e) s += x[e] * x[e];
          s += swz<1>(s); s += swz<2>(s); const float r = rsq(s * (1.f / 64.f) + EPS);
#pragma unroll
          for (int e = 0; e < 16; ++e) x[e] = x[e] * r * gkv[e];
          st16f(KA + (size_t)row * 1024 + 16 * lane, x); }
        { const float v = bf1(P[C_KPE + lane]); const float r = rsq(wave_sum(v * v) * (1.f / 64.f) + EPS);
          const float y = v * r * gpe; float yp; { auto rr = __builtin_amdgcn_permlane32_swap(__float_as_uint(y), __float_as_uint(y), false, false); yp = __uint_as_float(lane < 32 ? rr[1] : rr[0]); }
          const int i = lane & 31; const float c = rc[row * 32 + i], sn = rs[row * 32 + i];
          const float o = (lane < 32) ? (y * c - yp * sn) : (yp * sn + y * c);
          KPE[(size_t)row * 64 + lane] = (bf16)(cvt_pk_bf16(o, o) & 0xffffu); }
    }
}


#ifndef ATT_MASK
#define ATT_MASK 7
#endif
__device__ __forceinline__ void attn_phase(const Args& a, int l, int layer, LAS unsigned char* ldsl, volatile LAS unsigned* MISC, const int wv) {
    GAS unsigned char* wsg_ = (GAS unsigned char*)a.ws; asm volatile("" : "+s"(wsg_)); unsigned char* ws = (unsigned char*)wsg_;
    LAS char* lds = (LAS char*)ldsl;
    const bf16* proj = (const bf16*)(ws + WS_ACT + A_PROJ);
    const bf16* QA = (const bf16*)(ws + WS_ACT + A_QA); const bf16* KA = (const bf16*)(ws + WS_ACT + A_KA); const bf16* KPE = (const bf16*)(ws + WS_ACT + A_KPE);
    const bf16* KVRAW = (const bf16*)(ws + WS_ACT + A_KVRAW); const bf16* QRAW = (const bf16*)(ws + WS_ACT + A_QRAW); const bf16* KNOPE = (const bf16*)(ws + WS_ACT + A_KNOPE);
    float* OD = (float*)(ws + WS_ACT + A_OD); bf16* YA = (bf16*)(ws + WS_ACT + A_YA); bf16* YB = YA + 1024; bf16* YC = YA + 2048;
    unsigned* qhead = (unsigned*)(ws + WS_CTL) + CW_QUEUE + 28 * 64 * l;
    const int xcd = (int)(xb_xcc_id() & 7u);
#define CLAIMP(qp) ({ if (MYTID(wv) == 0) MISC[16] = __hip_atomic_fetch_add((qp), 1u, RLX_AGENT); __syncthreads(); const int v_ = (int)MISC[16]; __syncthreads(); v_; })
#define CLAIMX(t_, N_, qsel) ({ \
        if (wv == 0) { const int ln_ = lane_id(); int res_ = -1, qx_ = 0; \
            for (;;) { const unsigned hv_ = (ln_ < 8) ? __hip_atomic_load(qhead + 64 * ((t_) * 8 + ((xcd + ln_) & 7)), RLX_AGENT) : 0xffffffffu; \
                const unsigned long long mk_ = __ballot(hv_ < (unsigned)(N_)); if (mk_ == 0ull) break; \
                const int i_ = __builtin_ctzll(mk_); qx_ = (xcd + i_) & 7; unsigned tk_ = 0u; \
                if (ln_ == 0) tk_ = __hip_atomic_fetch_add(qhead + 64 * ((t_) * 8 + qx_), 1u, RLX_AGENT); \
                tk_ = (unsigned)__builtin_amdgcn_readfirstlane((int)tk_); if (tk_ < (unsigned)(N_)) { res_ = (int)tk_; break; } } \
            if (ln_ == 0) { MISC[16] = (unsigned)res_; MISC[17] = (unsigned)qx_; } } \
        __syncthreads(); const int v_ = (int)MISC[16]; qsel = (int)MISC[17]; __syncthreads(); v_; })
#define CLAIM(qi) CLAIMP(qhead + 64 * (24 + (qi) - 3))
    bool prep_left = (layer + 1 < DEPTH);
#define PREP_ONE() do { if (prep_left) { const int pi_ = CLAIM(4); if (pi_ < PREP_ITEMS - PREP_TAIL) prep_item(a, ws, ldsl, layer + 1, pi_, MYTID(wv)); else prep_left = false; } } while (0)
    if (ATT_MASK & 1) { for (;;) { int h;
        const int ui = CLAIMX(0, 32, h); if (ui < 0) break;
        const int qb = 31 - ui, q0 = qb * 256;
        att::KVSrc kv{KNOPE + h * 128, 1024, KPE, 64, KVRAW + h * 256 + 128, 2048};
        const att::QPrep qp{a.in[I_MQKG] + layer * 384, (const float*)(ws + WS_ROPE), (const float*)(ws + WS_ROPE) + S * 32};
        bool nomax;
        { const float* g0_ = a.in[I_MQKG] + layer * 384; const float* g1_ = g0_ + 192; const int ln2_ = lane_id();
          const float q_n = wave_max(fmaxf(fabsf(g0_[ln2_]), fabsf(g0_[64 + ln2_]))), q_p = wave_max(fabsf(g0_[128 + ln2_]));
          const float k_n = wave_max(fmaxf(fabsf(g1_[ln2_]), fabsf(g1_[64 + ln2_]))), k_p = wave_max(fabsf(g1_[128 + ln2_]));
          const float bnd = 1.02f * SC_MLA * sqrtf(128.f * q_n * q_n + 64.f * q_p * q_p) * sqrtf(128.f * k_n * k_n + 64.f * k_p * k_p);
          nomax = __builtin_amdgcn_readfirstlane((int)(bnd <= SMAX_BOUND)) != 0; }
        if (nomax) att::softmax_unit_v3<192, 128, false, false, false, false, true, true>(lds, QRAW + (size_t)q0 * 1536 + h * 192, 1536, kv, q0, nullptr, YB + (size_t)q0 * 3072 + h * 128, 3072, wv, att::DaFin{}, qp);
        else att::softmax_unit_v3<192, 128, false, false, false, false, false, true>(lds, QRAW + (size_t)q0 * 1536 + h * 192, 1536, kv, q0, nullptr, YB + (size_t)q0 * 3072 + h * 128, 3072, wv, att::DaFin{}, qp);
        PREP_ONE();
      } }
    int npass = 2; asm volatile("" : "+s"(npass));
    for (int pass = 0; pass < npass; ++pass) {
    if (ATT_MASK & 2) { for (;;) { int h, hc, qb;
        if (pass == 0) { const int ui = CLAIMX(1, 56, h); if (ui < 0) break; hc = 2 * h + (ui & 1); qb = 31 - (ui >> 1); }
        else { const int u_ = CLAIM(6); if (u_ >= 64) break; hc = u_ & 15; qb = 3 - (u_ >> 4); h = hc >> 1; }
        const int q0 = qb * 256;
        { const int tid = MYTID(wv); if (tid < 256) { const int rel = 64 - tid, n = rel < 0 ? -rel : rel;
            int large = 8 + (int)(logf((float)(n < 1 ? 1 : n) / 8.0f) / 2.772588722239781f * 8.0f); large = large < 15 ? large : 15;
            const int bucket = (rel > 0 ? 16 : 0) + (n < 8 ? n : large);
            ((LAS float*)(lds + att::L_BIAS))[tid] = (a.in[I_T5][bucket * 8 + h] - a.in[I_T5][15 * 8 + h]) * LOG2E; } }
        __syncthreads();
        att::KVSrc kv{KA + hc * 64, 1024, KA, 1024, proj + C_DAV + h * 128, PN};
        const float* lp = a.in[I_DLAM] + layer * 256; const int ln_ = lane_id();
        const float lam_init = 0.8f - 0.6f * expf(-0.3f * (float)layer);
        float lam = expf(wave_sum(lp[ln_] * lp[64 + ln_])) - expf(wave_sum(lp[128 + ln_] * lp[192 + ln_])) + lam_init;
        lam = __int_as_float(__builtin_amdgcn_readfirstlane(__float_as_int(lam))); const float omli = __int_as_float(__builtin_amdgcn_readfirstlane(__float_as_int(1.f - lam_init)));
        att::DaFin fin{OD + (size_t)(((hc ^ 1) * 32 + qb) * 8) * 4096, (unsigned*)(ws + WS_CTL) + CW_DAC + (l * 8 + h) * 32 + qb, lam, a.in[I_DSUB] + layer * 128, omli, (hc & 1) == 0};
        bool nomax;
        { const float* gq_ = a.in[I_DQKG] + layer * 128; const float gqm = wave_max(fabsf(gq_[ln_])), gkm = wave_max(fabsf(gq_[64 + ln_]));
          const float tm = wave_max(ln_ < 32 ? fabsf(a.in[I_T5][ln_ * 8 + h]) : 0.f);
          const float bnd = 1.02f * SC_DA * 64.f * gqm * gkm + 2.f * LOG2E * tm;
          nomax = __builtin_amdgcn_readfirstlane((int)(bnd <= SMAX_BOUND)) != 0; }
        if (nomax) att::softmax_unit_v3<64, 64, true, true, true, false, true>(lds, QA + (size_t)q0 * 1024 + hc * 64, 1024, kv, q0, OD + (size_t)((hc * 32 + qb) * 8) * 4096, YA + (size_t)q0 * 3072 + h * 128, 3072, wv, fin);
        else att::softmax_unit_v3<64, 64, true, true, true, false>(lds, QA + (size_t)q0 * 1024 + hc * 64, 1024, kv, q0, OD + (size_t)((hc * 32 + qb) * 8) * 4096, YA + (size_t)q0 * 3072 + h * 128, 3072, wv, fin);
        PREP_ONE();
      } }
    if (pass == 0) {
    if (ATT_MASK & 4) { for (;;) { int h;
        const int ui = CLAIMX(2, 32, h); if (ui < 0) break;
        const int qb = 31 - ui, q0 = qb * 256;
        att::KVSrc kv{proj + C_SBK + h * 128, PN, proj, PN, proj + C_SBV + h * 128, PN};
        att::sb_unit(lds, proj + (size_t)q0 * PN + C_SBQ + h * 128, PN, kv, q0, YC + (size_t)q0 * 3072 + h * 128, 3072, wv);
      } }
    {
        __syncthreads();
        const bf16* Hh = (const bf16*)(ws + WS_ACT + A_XB); const bf16* Wi = (const bf16*)(ws + WS_W + (size_t)layer * W_LAYER + W_IN); bf16* PJ = (bf16*)(ws + WS_ACT + A_PROJ);
        const float* RQ = (const float*)(ws + WS_ACT + A_RSQA); const float* B1 = (const float*)(ws + WS_CTL + WS_BIAS) + (size_t)layer * BIAS_PER_LAYER;
        constexpr int NFILL = (PN / 256 - GIN_TILES) * (S / 256);
        for (;;) { const int ui = CLAIM(3); if (ui >= NFILL) break;
            pg8::Gemm g{Hh, Wi, S, PN, DM, DM}; pg8::OneUnit So; So.u0.pm = ui & 31; So.u0.pn = GIN_TILES + (ui >> 5);
            pg8::EpiBf16N<3> E{PJ, PN, C_GATE / 256, RQ, B1, 1.f / DM, nullptr, nullptr}; pg8::gemm_phase(ldsl, g, So, E, wv); }
    }
    while (prep_left) PREP_ONE();
    } }
    if (layer + 1 < DEPTH) for (;;) { const int pi_ = CLAIM(5); if (pi_ >= PREP_TAIL) break; prep_item(a, ws, ldsl, layer + 1, PREP_ITEMS - PREP_TAIL + pi_, MYTID(wv)); }
    __syncthreads();
#undef PREP_ONE
#undef CLAIM
#undef CLAIMP
#undef CLAIMX
}

__global__ void __launch_bounds__(NTHR, 2) mk_fwd(Args args) {
    extern __shared__ __attribute__((aligned(16))) unsigned char lds_raw[];
    LAS unsigned char* lds = (LAS unsigned char*)lds_raw;
    volatile LAS unsigned* MISC = (volatile LAS unsigned*)(lds + MISC_OFF);
    const int wv = __builtin_amdgcn_readfirstlane((int)threadIdx.x >> 6);
    const int tid = MYTID(wv), G = gridDim.x;
    unsigned char* ws = args.ws;
    for (int u = tid; u < (LDS_BYTES - LDSCTL_OFF) / 4; u += NTHR) ((LAS unsigned*)(lds + LDSCTL_OFF))[u] = 0u;
    __syncthreads();
    XcdBarrier bar; bar.bar = (unsigned*)(ws + WS_CTL) + CW_BAR; bar.x = 0; bar.st = nullptr;
    if (!MK_SPLIT) bar = xcd_barrier_post((unsigned*)(ws + WS_CTL) + CW_BAR, MISC + 8, wv);
    const int lo = args.ph_lo, hi = args.ph_hi;
#ifndef PH_MASK
#define PH_MASK 0x1FFF
#endif
#if MK_SPLIT
#define IN(k) (lo <= (k) && (k) < hi)
#else
#define IN(k) true
#endif
#define INL(c) (((PH_MASK >> (1 + (c))) & 1) && IN(pb + (c)))
#define SEAM(k) do { if (IN((k) + 1)) xcd_barrier(bar, wv); } while (0)
#if DUP_MASK
#define REP(c) for (int rep_ = ((args.dup >> (c)) & 1); rep_ >= 0; --rep_)
#else
#define REP(c) for (int rep_ = 0; rep_ >= 0; --rep_)
#endif
#define RSEAM() do { if (rep_ > 0) xcd_barrier(bar, wv); } while (0)

    if ((PH_MASK & 1) && IN(0)) { REP(12) { prologue(args, lds, G, wv); RSEAM(); } SEAM(0); }

    for (int l = 0; l < DEPTH; ++l) {
        const int pb = 1 + l * PH_PER_LAYER;
        LAS float* PART = (LAS float*)(lds + RS_OFF);
        {
        GAS unsigned char* wsg_ = (GAS unsigned char*)args.ws; asm volatile("" : "+s"(wsg_)); unsigned char* ws = (unsigned char*)wsg_;
        bf16* PROJ = (bf16*)(ws + WS_ACT + A_PROJ); bf16* XB = (bf16*)(ws + WS_ACT + A_XB);
        float* RQA = (float*)(ws + WS_ACT + A_RSQA); float* RQCQ = (float*)(ws + WS_ACT + A_RSQCQ); float* RQCKV = (float*)(ws + WS_ACT + A_RSQCKV); const float* BIAS = (const float*)(ws + WS_CTL + WS_BIAS) + (size_t)l * BIAS_PER_LAYER;
        bf16* QRAW = (bf16*)(ws + WS_ACT + A_QRAW); bf16* KVRAW = (bf16*)(ws + WS_ACT + A_KVRAW);
        unsigned char* wl = ws + WS_W + (size_t)l * W_LAYER;
        if (INL(1)) { pg8::Gemm g{XB, (const bf16*)(wl + W_IN), S, GIN_TILES * 256, DM, DM}; pg8::StaticOrder So; So.init(S, GIN_TILES * 256, G, (int)blockIdx.x);
            pg8::EpiBf16N<3, true> E{PROJ, PN, C_GATE / 256, RQA, BIAS, 1.f / DM, RQCQ, RQCKV}; REP(1) { pg8::gemm_phase(lds, g, So, E, wv); RSEAM(); } SEAM(pb + 1); }
        if (INL(2)) { REP(2) {
            const float* ZERO = (const float*)(ws + WS_CTL + WS_ZERO);
            if ((blockIdx.x & 1) == 0) post1_phase(args, l, G, wv);
            { pg8::Gemm g{PROJ + C_CQ, (const bf16*)(wl + W_QUP), S, 1536, 512, PN}; pg8::StaticOrder So; So.init(S, 1536, G, (int)blockIdx.x);
              pg8::EpiBf16N<0> E{QRAW, 1536, 0, RQCQ, ZERO, 1.f / 512.f, nullptr, nullptr}; pg8::gemm_phase(lds, g, So, E, wv); }
            { pg8::Gemm g{PROJ + C_CKV, (const bf16*)(wl + W_KVUP), S, 2048, 256, PN}; pg8::StaticOrder So; So.init(S, 2048, G, (int)blockIdx.x);
              pg8::EpiKvUp E{(bf16*)(ws + WS_ACT + A_KNOPE), args.in[I_MQKG] + l * 384 + 192, RQCKV}; pg8::gemm_phase(lds, g, So, E, wv); }
            if ((blockIdx.x & 1) != 0) post1_phase(args, l, G, wv);
            RSEAM(); } SEAM(pb + 3); }
        if (INL(5)) { REP(5) { attn_phase(args, 2 * l + rep_, l, lds, MISC, wv); RSEAM(); } SEAM(pb + 5); }
        }
        {
        GAS unsigned char* wsg_ = (GAS unsigned char*)args.ws; asm volatile("" : "+s"(wsg_)); unsigned char* ws = (unsigned char*)wsg_;
        bf16* PROJ = (bf16*)(ws + WS_ACT + A_PROJ); bf16* XB = (bf16*)(ws + WS_ACT + A_XB); bf16* XB2 = (bf16*)(ws + WS_ACT + A_XB2);
        float* RQA = (float*)(ws + WS_ACT + A_RSQA); float* RQB = (float*)(ws + WS_ACT + A_RSQB); const float* BIAS = (const float*)(ws + WS_CTL + WS_BIAS) + (size_t)l * BIAS_PER_LAYER;
        bf16* YA = (bf16*)(ws + WS_ACT + A_YA); float* MF = (float*)(ws + WS_ACT + A_MF); bf16* MG = (bf16*)(ws + WS_ACT + A_MG); bf16* U = (bf16*)(ws + WS_ACT + A_U);
        const float* modl = (const float*)(ws + WS_MODF) + l * (NMOD * DM);
        unsigned char* wl = ws + WS_W + (size_t)l * W_LAYER;
        if (INL(7)) { REP(7) {
            pg8::Gemm g{YA, (const bf16*)(wl + W_BR), S, DM, 3072, 3072}; pg8::StaticOrder So; So.init(S, DM, G, (int)blockIdx.x);
            pg8::EpiBranchRatio E{PROJ + C_GATE, PN, MG}; pg8::gemm_phase(lds, g, So, E, wv);
            RSEAM(); } SEAM(pb + 7); }
        if (INL(8)) { pg8::Gemm g{MG, (const bf16*)(wl + W_OUT), S, DM, DM, DM}; pg8::StaticOrder So; So.init(S, DM, G, (int)blockIdx.x);
            REP(8) { if (l == 0) { pg8::EpiResid<false, true> E{args.in[I_X], rep_ ? (void*)MF : (void*)XB2, modl + 2 * DM, RQB, PART}; pg8::gemm_phase(lds, g, So, E, wv); }
                     else { pg8::EpiResid<true, true> E{XB, rep_ ? (void*)MF : (void*)XB2, modl + 2 * DM, RQB, PART}; pg8::gemm_phase(lds, g, So, E, wv); } RSEAM(); } SEAM(pb + 8); }
        if (INL(10)) { pg8::Gemm g{XB2, (const bf16*)(wl + W_M1), S, DFF, DM, DM}; pg8::StaticOrder So; So.init(S, DFF, G, (int)blockIdx.x);
            pg8::EpiBf16N<2> E{U, DFF, 0, RQB, BIAS + PN, 1.f / DM, nullptr, nullptr}; REP(10) { pg8::gemm_phase(lds, g, So, E, wv); RSEAM(); } SEAM(pb + 10); }
        if (INL(11)) { pg8::Gemm g{U, (const bf16*)(wl + W_M2), S, DM, DFF, DFF}; pg8::StaticOrder So; So.init(S, DM, G, (int)blockIdx.x);
            REP(11) { if (l == DEPTH - 1) { pg8::EpiResid<true, false> E{XB2, rep_ ? (void*)MF : (void*)args.out, modl + 5 * DM, nullptr, PART}; pg8::gemm_phase(lds, g, So, E, wv); }
                      else { pg8::EpiResid<true, true> E{XB2, rep_ ? (void*)MF : (void*)XB, modl + 5 * DM, RQA, PART}; pg8::gemm_phase(lds, g, So, E, wv); } RSEAM(); } SEAM(pb + 11); }
        }
    }
#undef IN
#undef INL
#undef SEAM
#undef REP
#undef RSEAM
}

extern "C" void kernel_launch(void* const* d_in, const int* in_sizes, int n_in, void* d_out, int out_size, void* d_ws, size_t ws_size, hipStream_t stream) {
    static int grid = 0;
    if (grid == 0) {
        if (n_in != 20 || in_sizes[0] != S * DM || out_size != S * DM || ws_size < WS_END) {
            fprintf(stderr, "kernel_launch: shape mismatch: n_in %d in0 %d out %d ws %zu (need %zu)\n", n_in, n_in > 0 ? in_sizes[0] : -1, out_size, ws_size, (size_t)WS_END); grid = -1; return; }
        int dev = 0, cus = 0, per_cu = 0;
        if (hipGetDevice(&dev) != hipSuccess || hipDeviceGetAttribute(&cus, hipDeviceAttributeMultiprocessorCount, dev) != hipSuccess) { grid = -1; return; }
        if (hipFuncSetAttribute((const void*)mk_fwd, hipFuncAttributeMaxDynamicSharedMemorySize, LDS_BYTES) != hipSuccess) { fprintf(stderr, "kernel_launch: hipFuncSetAttribute failed\n"); grid = -1; return; }
        if (hipOccupancyMaxActiveBlocksPerMultiprocessor(&per_cu, (const void*)mk_fwd, NTHR, LDS_BYTES) != hipSuccess || per_cu < 1)
            fprintf(stderr, "kernel_launch: note: occupancy query reports %d workgroups per CU\n", per_cu);
        (void)hipGetLastError();
        grid = cus;
    }
    if (grid < 0) return;
    if (hipMemsetAsync((char*)d_ws + WS_CTL, 0, CTL_ZERO_BYTES, stream) != hipSuccess) { fprintf(stderr, "kernel_launch: memset failed\n"); return; }
    Args a{};
    for (int i = 0; i < 20; ++i) a.in[i] = (const float*)d_in[i];
    a.out = (float*)d_out; a.ws = (unsigned char*)d_ws; a.dup = DUP_MASK;
#if MK_SPLIT
    for (int p = 0; p < NPHASE; ++p) { a.ph_lo = p; a.ph_hi = p + 1; hipLaunchKernelGGL(mk_fwd, dim3(grid), dim3(NTHR), LDS_BYTES, stream, a); }
#else
    a.ph_lo = 0; a.ph_hi = NPHASE;
    hipLaunchKernelGGL(mk_fwd, dim3(grid), dim3(NTHR), LDS_BYTES, stream, a);
#endif
    const hipError_t le = hipPeekAtLastError();
    if (le != hipSuccess) fprintf(stderr, "kernel_launch: launch failed: %s\n", hipGetErrorName(le));
}
```
